# Optimizing an MI355X kernel written in HIP

```python
import math
import jax, jax.numpy as jnp
from jax import lax
import numpy as np

D_MODEL = 1024
BATCH = 8
SEQ = 4096
DEPTH = 1

MIX_WIDTH = D_MODEL
HEAD_GROUP_DIM = 64
MLA_HEADS = 8
MLA_NOPE_DIM = 64
MLA_ROPE_DIM = 32
MLA_V_DIM = HEAD_GROUP_DIM
MLA_Q_RANK = 256
MLA_KV_RANK = 128
ROPE_THETA = 10000.0
Q_BLOCK = 128
HYENA_CHANNELS = MIX_WIDTH - MLA_HEADS * MLA_V_DIM
HYENA_GROUPS = HYENA_CHANNELS // HEAD_GROUP_DIM
HYENA_ORDER = 2
SHORT_CONV = 3
FILTER_BANDS = 16
FILTER_EMB = 2 * FILTER_BANDS + 1
FILTER_HIDDEN = 64
DECAY_TARGET = 1e-2
FAST_DECAY_PCT = 0.3
SLOW_DECAY_PCT = 1.5
MAX_DECAY = math.log(DECAY_TARGET) / FAST_DECAY_PCT
MIN_DECAY = math.log(DECAY_TARGET) / SLOW_DECAY_PCT
N_GROUPS = MLA_HEADS + HYENA_GROUPS
IN_COLS = MLA_Q_RANK + MLA_KV_RANK + MLA_ROPE_DIM + (HYENA_ORDER + 1) * HYENA_CHANNELS
IN_SPLITS = (MLA_Q_RANK, MLA_Q_RANK + MLA_KV_RANK, MLA_Q_RANK + MLA_KV_RANK + MLA_ROPE_DIM)
FFN_HIDDEN = 2816
FFN_RES = 0.5
EPS = 1e-6

kernel_name = 'hymba_mla_hyena_macaron'


def rmsnorm(x, g):
    xf = x.astype(jnp.float32)
    y = xf * lax.rsqrt(jnp.mean(xf * xf, axis=-1, keepdims=True) + EPS)
    return y.astype(x.dtype) * g


def swiglu(x, w_gate, w_up, w_down):
    return (jax.nn.silu(x @ w_gate) * (x @ w_up)) @ w_down


def rope_tables(seq):
    inv = 1.0 / (ROPE_THETA ** (jnp.arange(0, MLA_ROPE_DIM, 2, dtype=jnp.float32) / MLA_ROPE_DIM))
    ang = jnp.arange(seq, dtype=jnp.float32)[:, None] * inv[None, :]
    return jnp.cos(ang), jnp.sin(ang)


def apply_rope(x, cos, sin):
    half = x.shape[-1] // 2
    x1, x2 = x[..., :half], x[..., half:]
    cos = cos.astype(x.dtype)
    sin = sin.astype(x.dtype)
    return jnp.concatenate([x1 * cos - x2 * sin, x1 * sin + x2 * cos], axis=-1)


def mla(c_q, c_kv, k_rope, q_norm_g, w_uq, kv_norm_g, w_ukv):
    B, S, _ = c_q.shape
    q = (rmsnorm(c_q, q_norm_g) @ w_uq).reshape(B, S, MLA_HEADS, MLA_NOPE_DIM + MLA_ROPE_DIM)
    kv = (rmsnorm(c_kv, kv_norm_g) @ w_ukv).reshape(B, S, MLA_HEADS, MLA_NOPE_DIM + MLA_V_DIM)
    q_nope, q_pe = q[..., :MLA_NOPE_DIM], q[..., MLA_NOPE_DIM:]
    k_nope, v = kv[..., :MLA_NOPE_DIM], kv[..., MLA_NOPE_DIM:]
    cos, sin = rope_tables(S)
    q_pe = apply_rope(q_pe, cos[:, None, :], sin[:, None, :])
    k_pe = apply_rope(k_rope, cos, sin)
    scale = (MLA_NOPE_DIM + MLA_ROPE_DIM) ** -0.5
    q = jnp.concatenate([q_nope, q_pe], axis=-1) * scale
    k = jnp.concatenate([k_nope, jnp.broadcast_to(k_pe[:, :, None, :], (B, S, MLA_HEADS, MLA_ROPE_DIM))], axis=-1)
    n_blk = S // Q_BLOCK
    q_blocks = q.reshape(B, n_blk, Q_BLOCK, MLA_HEADS, q.shape[-1]).transpose(1, 0, 2, 3, 4)

    def attend(qb):
        s = jnp.einsum('bqhd,bkhd->bhqk', qb, k).astype(jnp.float32)
        p = jax.nn.softmax(s, axis=-1).astype(v.dtype)
        return jnp.einsum('bhqk,bkhd->bqhd', p, v)

    out = lax.map(attend, q_blocks)
    return out.transpose(1, 0, 2, 3, 4).reshape(B, S, MLA_HEADS * MLA_V_DIM)


def short_conv(u, w, b):
    S = u.shape[1]
    pad = SHORT_CONV // 2
    up = jnp.pad(u, ((0, 0), (pad, SHORT_CONV - 1 - pad), (0, 0)))
    y = b
    for tap in range(SHORT_CONV):
        y = y + up[:, tap:tap + S] * w[tap]
    return y


def hyena_filters(L, w1, b1, w2, b2, w3, freq):
    f32 = jnp.float32
    pos = jnp.arange(L, dtype=f32)
    t = pos / max(L - 1, 1)
    bands = jnp.linspace(1e-4, FILTER_BANDS - 1, FILTER_BANDS, dtype=f32)
    ang = (2.0 * math.pi * pos / L)[:, None] * bands[None, :]
    z = jnp.concatenate([t[:, None], jnp.cos(ang), -jnp.sin(ang)], axis=-1)
    fr = freq.astype(f32)
    h = jnp.sin(fr * (z @ w1.astype(f32) + b1.astype(f32)))
    h = jnp.sin(fr * (h @ w2.astype(f32) + b2.astype(f32)))
    h = h @ w3.astype(f32)
    deltas = jnp.abs(jnp.linspace(MIN_DECAY, MAX_DECAY, HYENA_CHANNELS, dtype=f32))
    decay = jnp.exp(-t[:, None] * deltas[None, :])
    h = h.reshape(L, HYENA_ORDER, 2, HYENA_CHANNELS) * decay[:, None, None, :]
    h_fwd, h_bwd = h[:, :, 0], h[:, :, 1]
    k = jnp.concatenate([h_fwd, jnp.zeros((1, HYENA_ORDER, HYENA_CHANNELS), f32), h_bwd[:0:-1]], axis=0)
    k = k / jnp.sum(jnp.abs(k), axis=0, keepdims=True)
    return jnp.fft.rfft(k, axis=0)


def fftconv(u, k_f, d):
    L = u.shape[1]
    uf32 = u.astype(jnp.float32)
    u_f = jnp.fft.rfft(uf32, n=2 * L, axis=1)
    y = jnp.fft.irfft(u_f * k_f[None], n=2 * L, axis=1)[:, :L]
    return (y + uf32 * d.astype(jnp.float32)).astype(u.dtype)


def hyena(u, conv_w, conv_b, w1, b1, w2, b2, w3, freq, d_skip):
    L = u.shape[1]
    u = short_conv(u, conv_w, conv_b)
    v, x1, x2 = jnp.split(u, HYENA_ORDER + 1, axis=-1)
    k_f = hyena_filters(L, w1, b1, w2, b2, w3, freq)
    z = fftconv(v, k_f[:, 0], d_skip[0]) * x1
    z = fftconv(z, k_f[:, 1], d_skip[1]) * x2
    return z


def setup_inputs(seed: int = 0) -> dict:
    key = jax.random.key(seed)
    ks = iter(jax.random.split(key, 40))

    def nrm(shape, scale):
        return jax.random.normal(next(ks), shape, jnp.float32) * scale

    def gain(shape):
        return 1.0 + nrm(shape, 0.02)

    L_ = DEPTH
    return {
        'x': nrm((BATCH, SEQ, D_MODEL), 1.0),
        'ffn1_norm_g': gain((L_, D_MODEL)),
        'ffn1_w_gate': nrm((L_, D_MODEL, FFN_HIDDEN), D_MODEL ** -0.5),
        'ffn1_w_up': nrm((L_, D_MODEL, FFN_HIDDEN), D_MODEL ** -0.5),
        'ffn1_w_down': nrm((L_, FFN_HIDDEN, D_MODEL), FFN_HIDDEN ** -0.5),
        'mix_norm_g': gain((L_, D_MODEL)),
        'w_in': nrm((L_, D_MODEL, IN_COLS), D_MODEL ** -0.5),
        'q_norm_g': gain((L_, MLA_Q_RANK)),
        'w_uq': nrm((L_, MLA_Q_RANK, MLA_HEADS * (MLA_NOPE_DIM + MLA_ROPE_DIM)), MLA_Q_RANK ** -0.5),
        'kv_norm_g': gain((L_, MLA_KV_RANK)),
        'w_ukv': nrm((L_, MLA_KV_RANK, MLA_HEADS * (MLA_NOPE_DIM + MLA_V_DIM)), MLA_KV_RANK ** -0.5),
        'hyena_conv_w': nrm((L_, SHORT_CONV, (HYENA_ORDER + 1) * HYENA_CHANNELS), SHORT_CONV ** -0.5),
        'hyena_conv_b': nrm((L_, (HYENA_ORDER + 1) * HYENA_CHANNELS), 0.01),
        'filt_w1': nrm((L_, FILTER_EMB, FILTER_HIDDEN), FILTER_EMB ** -0.5),
        'filt_b1': nrm((L_, FILTER_HIDDEN), 0.01),
        'filt_w2': nrm((L_, FILTER_HIDDEN, FILTER_HIDDEN), FILTER_HIDDEN ** -0.5),
        'filt_b2': nrm((L_, FILTER_HIDDEN), 0.01),
        'filt_w3': nrm((L_, FILTER_HIDDEN, HYENA_ORDER * 2 * HYENA_CHANNELS), FILTER_HIDDEN ** -0.5),
        'filt_freq': gain((L_, FILTER_HIDDEN)),
        'hyena_d': nrm((L_, HYENA_ORDER, HYENA_CHANNELS), 0.1),
        'head_norm_g': gain((L_, MIX_WIDTH)),
        'w_out': nrm((L_, MIX_WIDTH, D_MODEL), MIX_WIDTH ** -0.5),
        'ffn2_norm_g': gain((L_, D_MODEL)),
        'ffn2_w_gate': nrm((L_, D_MODEL, FFN_HIDDEN), D_MODEL ** -0.5),
        'ffn2_w_up': nrm((L_, D_MODEL, FFN_HIDDEN), D_MODEL ** -0.5),
        'ffn2_w_down': nrm((L_, FFN_HIDDEN, D_MODEL), FFN_HIDDEN ** -0.5),
        'final_norm_g': gain((D_MODEL,)),
    }


def reference(x, ffn1_norm_g, ffn1_w_gate, ffn1_w_up, ffn1_w_down, mix_norm_g, w_in,
              q_norm_g, w_uq, kv_norm_g, w_ukv, hyena_conv_w, hyena_conv_b,
              filt_w1, filt_b1, filt_w2, filt_b2, filt_w3, filt_freq, hyena_d,
              head_norm_g, w_out, ffn2_norm_g, ffn2_w_gate, ffn2_w_up, ffn2_w_down,
              final_norm_g):
    B, S, _ = x.shape
    for l in range(DEPTH):
        x = x + FFN_RES * swiglu(rmsnorm(x, ffn1_norm_g[l]), ffn1_w_gate[l], ffn1_w_up[l], ffn1_w_down[l])
        u = rmsnorm(x, mix_norm_g[l]) @ w_in[l]
        c_q, c_kv, k_rope, u_hy = jnp.split(u, IN_SPLITS, axis=-1)
        a = mla(c_q, c_kv, k_rope, q_norm_g[l], w_uq[l], kv_norm_g[l], w_ukv[l])
        h = hyena(u_hy, hyena_conv_w[l], hyena_conv_b[l], filt_w1[l], filt_b1[l],
                  filt_w2[l], filt_b2[l], filt_w3[l], filt_freq[l], hyena_d[l])
        mix = jnp.concatenate([a, h], axis=-1).reshape(B, S, N_GROUPS, HEAD_GROUP_DIM)
        mix = rmsnorm(mix, head_norm_g[l].reshape(N_GROUPS, HEAD_GROUP_DIM)).reshape(B, S, MIX_WIDTH)
        x = x + mix @ w_out[l]
        x = x + FFN_RES * swiglu(rmsnorm(x, ffn2_norm_g[l]), ffn2_w_gate[l], ffn2_w_up[l], ffn2_w_down[l])
    return rmsnorm(x, final_norm_g)
```

```cpp
#include <hip/hip_runtime.h>
#include <hip/hip_cooperative_groups.h>
#include <cstdio>
namespace cg = cooperative_groups;
namespace pg8 {
#define PG8_LAS __attribute__((address_space(3)))
typedef unsigned short bf16_t;
typedef short bf16x8 __attribute__((ext_vector_type(8)));
typedef float f32x4 __attribute__((ext_vector_type(4)));
typedef unsigned u32x4 __attribute__((ext_vector_type(4)));
constexpr int BM = 256, BK = 64, HALF = 128, HTB = HALF * BK * 2  , STAGE_BYTES = 8 * HTB, NXCD = 8, WGM = 8;

__host__ __device__ __forceinline__ int lds_byte(int r, int c) { const int st = (r >> 4) * 2 + (c >> 5), rr = r & 15, cc = c & 31, ob = rr * 64 + cc * 2; return st * 1024 + (ob ^ (((ob >> 9) & 1) << 5)); }
__host__ __device__ __forceinline__ void stage_rc(int b, int& R, int& C) { const int st = b / 1024, sb = b % 1024, swz = sb ^ (((sb >> 9) & 1) << 5); R = (st >> 1) * 16 + swz / 64; C = (st & 1) * 32 + (swz % 64) / 2; }
__host__ __device__ __forceinline__ int perm32(int rho) { const int n = rho >> 4, i = rho & 15; return 8 * (i >> 2) + 4 * n + (i & 3); }

struct Unit { int pm, pn; };
struct Gemm { const bf16_t* A; const bf16_t* Bt; int M, N, K; };

struct StaticOrder {
    int nM, nN, nwg, G, c;
    __host__ __device__ void init(int M, int N, int G_, int c_) { nM = M / BM; nN = N / BM; nwg = nM * nN; G = G_; c = c_; }
    __host__ __device__ bool next(int i, Unit& u) const {
        const long L = (long)i * G + c; if (L >= nwg) return false;
        int wgid = (int)L; { const int q = nwg / NXCD, r = nwg % NXCD, xcd = wgid % NXCD, off = wgid / NXCD; wgid = (xcd < r ? xcd * (q + 1) : r * (q + 1) + (xcd - r) * q) + off; }
        const int nig = WGM * nN, gid = wgid / nig, fm = gid * WGM, gsz = (nM - fm) < WGM ? (nM - fm) : WGM;
        u.pm = fm + ((wgid % nig) % gsz); u.pn = (wgid % nig) / gsz; return true;
    }
    __device__ __forceinline__ void a_ready(const Unit&) const {}
    __device__ __forceinline__ void done(const Unit&) const {}
};
typedef unsigned u32x2 __attribute__((ext_vector_type(2)));
typedef __bf16 bf16x2_t __attribute__((ext_vector_type(2)));
typedef float f32x2_t __attribute__((ext_vector_type(2)));
__device__ __forceinline__ unsigned pk2(float lo, float hi) { f32x2_t v = {lo, hi}; bf16x2_t b = __builtin_convertvector(v, bf16x2_t); return __builtin_bit_cast(unsigned, b); }
__device__ __forceinline__ float silu_mul(float g, float u) { return g * __builtin_amdgcn_rcpf(1.0f + __expf(-g)) * u; }
struct EpiSwiGLU {
    static constexpr bool PERM = true, AFTER_DRAIN = false;
    bf16_t* H; int ldh;
    __device__ __forceinline__ void operator()(const f32x4 (&acc)[2][2][4][2], const Unit& u, int wr, int wc, int fr, int fq) const {
        const int row0 = u.pm * BM + wr * 64 + fr, col0 = u.pn * HALF + wc * 32 + 8 * fq;
#pragma unroll
        for (int ai = 0; ai < 2; ++ai)
#pragma unroll
            for (int m = 0; m < 4; ++m) { bf16_t* rowp = H + (size_t)(row0 + ai * HALF + m * 16) * ldh + col0;
                const f32x4 g0 = acc[ai][0][m][0], g1 = acc[ai][0][m][1], u0 = acc[ai][1][m][0], u1 = acc[ai][1][m][1];
                u32x4 w; w.x = pk2(silu_mul(g0[0], u0[0]), silu_mul(g0[1], u0[1])); w.y = pk2(silu_mul(g0[2], u0[2]), silu_mul(g0[3], u0[3]));
                w.z = pk2(silu_mul(g1[0], u1[0]), silu_mul(g1[1], u1[1])); w.w = pk2(silu_mul(g1[2], u1[2]), silu_mul(g1[3], u1[3]));
                *(u32x4*)rowp = w; }
    }
};
struct EpiResid {
    static constexpr bool PERM = false, AFTER_DRAIN = false;
    const float* base; float* out; int ldc; float alpha;
    __device__ __forceinline__ void operator()(const f32x4 (&acc)[2][2][4][2], const Unit& u, int wr, int wc, int fr, int fq) const {
        const int row0 = u.pm * BM + wr * 64 + fr, col0 = u.pn * BM + wc * 32 + 4 * fq;
#pragma unroll
        for (int ai = 0; ai < 2; ++ai)
#pragma unroll
            for (int m = 0; m < 4; ++m) { const size_t off = (size_t)(row0 + ai * HALF + m * 16) * ldc + col0;
#pragma unroll
                for (int bj = 0; bj < 2; ++bj)
#pragma unroll
                    for (int n = 0; n < 2; ++n) { const size_t o = off + bj * HALF + n * 16; const f32x4 b = *(const f32x4*)(base + o); *(f32x4*)(out + o) = b + alpha * acc[ai][bj][m][n]; }
                asm volatile("" ::: "memory"); }
    }
};
struct EpiF32 {
    static constexpr bool PERM = false, AFTER_DRAIN = false;
    float* C; int ldc;
    __device__ __forceinline__ void operator()(const f32x4 (&acc)[2][2][4][2], const Unit& u, int wr, int wc, int fr, int fq) const {
        const int row0 = u.pm * BM + wr * 64 + fr, col0 = u.pn * BM + wc * 32 + 4 * fq;
#pragma unroll
        for (int ai = 0; ai < 2; ++ai)
#pragma unroll
            for (int m = 0; m < 4; ++m) { float* rowp = C + (size_t)(row0 + ai * HALF + m * 16) * ldc + col0;
#pragma unroll
                for (int bj = 0; bj < 2; ++bj)
#pragma unroll
                    for (int n = 0; n < 2; ++n) *(f32x4*)(rowp + bj * HALF + n * 16) = acc[ai][bj][m][n]; }
    }
};
struct EpiBf16P {
    static constexpr bool PERM = true, AFTER_DRAIN = false;
    bf16_t* O; size_t ldc;
    __device__ __forceinline__ void operator()(const f32x4 (&acc)[2][2][4][2], const Unit& u, int wr, int wc, int fr, int fq) const {
        const int row0 = u.pm * BM + wr * 64 + fr, col0 = u.pn * BM + wc * 32 + 8 * fq;
#pragma unroll
        for (int ai = 0; ai < 2; ++ai)
#pragma unroll
            for (int m = 0; m < 4; ++m) { bf16_t* rowp = O + (size_t)(row0 + ai * HALF + m * 16) * ldc + col0;
#pragma unroll
                for (int bj = 0; bj < 2; ++bj) { const f32x4 v0 = acc[ai][bj][m][0], v1 = acc[ai][bj][m][1];
                    u32x4 w; w.x = pk2(v0[0], v0[1]); w.y = pk2(v0[2], v0[3]); w.z = pk2(v1[0], v1[1]); w.w = pk2(v1[2], v1[3]);
                    *(u32x4*)(rowp + bj * HALF) = w; } }
    }
};
struct EpiQ {
    static constexpr bool PERM = false, AFTER_DRAIN = false;
    bf16_t* Q; const f32x2_t* tab; float scale;
    __device__ __forceinline__ void operator()(const f32x4 (&acc)[2][2][4][2], const Unit& u, int wr, int wc, int fr, int fq) const {
        const int row0 = u.pm * BM + wr * 64 + fr, colb = u.pn * BM + wc * 32;
#pragma unroll
        for (int ai = 0; ai < 2; ++ai)
#pragma unroll
            for (int m = 0; m < 4; ++m) { const int row = row0 + ai * HALF + m * 16, pos = row & 4095;
#pragma unroll
                for (int bj = 0; bj < 2; ++bj) { const int cgp = colb + bj * HALF; const bool pe = ((cgp >> 5) % 3) == 2;
                    f32x4 a = acc[ai][bj][m][0], b = acc[ai][bj][m][1];
                    if (pe) {
#pragma unroll
                        for (int e = 0; e < 4; ++e) { const f32x2_t cs = tab[pos * 16 + 4 * fq + e]; const float x1 = a[e], x2 = b[e]; a[e] = x1 * cs.x - x2 * cs.y; b[e] = x1 * cs.y + x2 * cs.x; } }
                    a = a * scale; b = b * scale;
                    bf16_t* qp = Q + (size_t)row * 768 + cgp + 4 * fq;
                    u32x2 w0; w0.x = pk2(a[0], a[1]); w0.y = pk2(a[2], a[3]); *(u32x2*)qp = w0;
                    u32x2 w1; w1.x = pk2(b[0], b[1]); w1.y = pk2(b[2], b[3]); *(u32x2*)(qp + 16) = w1;
                    asm volatile("" ::: "memory"); } }
    }
};
template <class Epi, class Sched>
__device__ __forceinline__ void gemm_phase(PG8_LAS unsigned char* lds, const Gemm g, const Sched& S, const Epi& E) {
    const int tid = threadIdx.x, wid = __builtin_amdgcn_readfirstlane(tid >> 6), lane = tid & 63, wr = wid >> 2, wc = wid & 3, fr = lane & 15, fq = lane >> 4;
    const int K = g.K, nt = K / BK;
    unsigned voffA[2], voffB[2];
#pragma unroll
    for (int i = 0; i < 2; ++i) { int R, C; stage_rc(tid * 16 + i * 8192, R, C); const int Rb = Epi::PERM ? ((R & ~31) + perm32(R & 31)) : R;
        voffA[i] = (unsigned)(R * K + C) * 2u; voffB[i] = (unsigned)(Rb * K + C) * 2u; }
    const size_t kstep = (size_t)(BK * 2);
    const size_t hstep = (size_t)HALF * K * 2;
    const size_t tstep = 2 * hstep;
    const unsigned ldsw = (unsigned)wid * 1024u;
    const int aoff = lds_byte(wr * 64 + fr, fq * 8), boff = lds_byte(wc * 32 + fr, fq * 8);
#define PG8_SA(b, h) (((b) * 2 + (h)) * HTB)
#define PG8_SB(b, h) ((4 + (b) * 2 + (h)) * HTB)
#define PG8_STAGE(bufoff, gbase, voff) do { _Pragma("unroll") for (int _i = 0; _i < 2; ++_i) \
        __builtin_amdgcn_global_load_lds((const unsigned*)((const char*)(gbase) + (voff)[_i]), (PG8_LAS unsigned*)(lds + (bufoff) + ldsw + _i * 8192), 16, 0, 0); } while (0)
#define PG8_LDA(dst, b, h) do { _Pragma("unroll") for (int m = 0; m < 4; ++m) _Pragma("unroll") for (int k = 0; k < 2; ++k) dst[m][k] = *(const PG8_LAS bf16x8*)(lds + PG8_SA(b, h) + aoff + m * 2048 + k * 1024); } while (0)
#define PG8_LDB(dst, b, h) do { _Pragma("unroll") for (int n = 0; n < 2; ++n) _Pragma("unroll") for (int k = 0; k < 2; ++k) dst[n][k] = *(const PG8_LAS bf16x8*)(lds + PG8_SB(b, h) + boff + n * 2048 + k * 1024); } while (0)
#define PG8_MMA(ai, bj, At, Bt) do { __builtin_amdgcn_s_setprio(1); _Pragma("unroll") for (int m = 0; m < 4; ++m) _Pragma("unroll") for (int n = 0; n < 2; ++n) _Pragma("unroll") for (int k = 0; k < 2; ++k) \
        acc[ai][bj][m][n] = __builtin_amdgcn_mfma_f32_16x16x32_bf16(Bt[n][k], At[m][k], acc[ai][bj][m][n], 0, 0, 0); __builtin_amdgcn_s_setprio(0); } while (0)
#define PG8_WAIT_V(n) asm volatile("s_waitcnt vmcnt(" #n ")" ::: "memory")
#define PG8_WAIT_L(n) asm volatile("s_waitcnt lgkmcnt(" #n ")" ::: "memory")
#define PG8_BAR __builtin_amdgcn_s_barrier()
#define PG8_SCHED __builtin_amdgcn_sched_barrier(0)
    Unit cur, nxt; int ui = 0;
    if (!S.next(0, cur)) return;
    f32x4 acc[2][2][4][2];
#pragma unroll
    for (int a = 0; a < 2; ++a)
#pragma unroll
        for (int b = 0; b < 2; ++b)
#pragma unroll
            for (int m = 0; m < 4; ++m)
#pragma unroll
                for (int n = 0; n < 2; ++n) acc[a][b][m][n] = (f32x4){0.f, 0.f, 0.f, 0.f};
    bf16x8 At[4][2], B0[2][2], B1[2][2];
    const char* cA = (const char*)g.A + (size_t)cur.pm * tstep; const char* cB = (const char*)g.Bt + (size_t)cur.pn * tstep;
    S.a_ready(cur);
    PG8_STAGE(PG8_SB(0, 0), cB, voffB); PG8_STAGE(PG8_SA(0, 0), cA, voffA); PG8_STAGE(PG8_SB(0, 1), cB + hstep, voffB); PG8_STAGE(PG8_SA(0, 1), cA + hstep, voffA);
    if (wr == 1) PG8_BAR;
    PG8_WAIT_V(4); PG8_BAR;
    PG8_STAGE(PG8_SB(1, 0), cB + kstep, voffB); PG8_STAGE(PG8_SA(1, 0), cA + kstep, voffA); PG8_STAGE(PG8_SB(1, 1), cB + hstep + kstep, voffB);
    PG8_WAIT_V(6); PG8_BAR;
    for (;;) {
        const bool has_next = S.next(ui + 1, nxt);
        const char* nA = has_next ? (const char*)g.A + (size_t)nxt.pm * tstep : cA; const char* nB = has_next ? (const char*)g.Bt + (size_t)nxt.pn * tstep : cB;
        for (int t = 0; t < nt; t += 2) {
            const bool last = (t == nt - 2);
            const char* a1 = cA + (size_t)(t + 1) * kstep;
            const char* a2 = last ? nA : cA + (size_t)(t + 2) * kstep; const char* b2 = last ? nB : cB + (size_t)(t + 2) * kstep;
            const char* a3 = a2 + kstep; const char* b3 = b2 + kstep;
            if (last && has_next) S.a_ready(nxt);
            PG8_LDB(B0, 0, 0); PG8_SCHED; PG8_LDA(At, 0, 0); PG8_STAGE(PG8_SA(1, 1), a1 + hstep, voffA);
            PG8_WAIT_L(8); PG8_BAR; PG8_WAIT_L(0); PG8_MMA(0, 0, At, B0); PG8_BAR; PG8_SCHED;
            PG8_LDB(B1, 0, 1); PG8_STAGE(PG8_SB(0, 0), b2, voffB);
            PG8_BAR; PG8_WAIT_L(0); PG8_MMA(0, 1, At, B1); PG8_BAR;
            PG8_LDA(At, 0, 1); PG8_STAGE(PG8_SA(0, 0), a2, voffA);
            PG8_BAR; PG8_WAIT_L(0); PG8_MMA(1, 0, At, B0); PG8_BAR; PG8_SCHED;
            PG8_STAGE(PG8_SB(0, 1), b2 + hstep, voffB);
            PG8_WAIT_V(6); PG8_BAR; PG8_MMA(1, 1, At, B1); PG8_BAR;
            PG8_LDB(B0, 1, 0); PG8_SCHED; PG8_LDA(At, 1, 0); PG8_STAGE(PG8_SA(0, 1), a2 + hstep, voffA);
            PG8_WAIT_L(8); PG8_BAR; PG8_WAIT_L(0); PG8_MMA(0, 0, At, B0); PG8_BAR; PG8_SCHED;
            PG8_LDB(B1, 1, 1); PG8_STAGE(PG8_SB(1, 0), b3, voffB);
            PG8_BAR; PG8_WAIT_L(0); PG8_MMA(0, 1, At, B1); PG8_BAR;
            PG8_LDA(At, 1, 1); PG8_STAGE(PG8_SA(1, 0), a3, voffA);
            PG8_BAR; PG8_WAIT_L(0); PG8_MMA(1, 0, At, B0); PG8_BAR; PG8_SCHED;
            PG8_STAGE(PG8_SB(1, 1), b3 + hstep, voffB);
            PG8_WAIT_V(6); PG8_BAR; PG8_MMA(1, 1, At, B1); PG8_BAR;
        }
        if constexpr (!Epi::AFTER_DRAIN) { E(acc, cur, wr, wc, fr, fq); S.done(cur); }
        if (!has_next) break;
#pragma unroll
        for (int a = 0; a < 2; ++a)
#pragma unroll
            for (int b = 0; b < 2; ++b)
#pragma unroll
                for (int m = 0; m < 4; ++m)
#pragma unroll
                    for (int n = 0; n < 2; ++n) acc[a][b][m][n] = (f32x4){0.f, 0.f, 0.f, 0.f};
        cur = nxt; cA = nA; cB = nB; ++ui;
    }
    PG8_WAIT_V(0);
    if (wr == 0) PG8_BAR;
    PG8_BAR;
    if constexpr (Epi::AFTER_DRAIN) { E.fused(acc, cur, wr, wc, fr, fq, lds, wid, lane); S.done(cur); }
#undef PG8_SA
#undef PG8_SB
#undef PG8_STAGE
#undef PG8_LDA
#undef PG8_LDB
#undef PG8_MMA
#undef PG8_WAIT_V
#undef PG8_WAIT_L
#undef PG8_BAR
#undef PG8_SCHED
}
}

#define LAS __attribute__((address_space(3)))
using pg8::bf16_t; using pg8::bf16x8; using pg8::f32x4; using pg8::u32x4; using pg8::u32x2; using pg8::f32x2_t; using pg8::pk2;
typedef float f32x16 __attribute__((ext_vector_type(16)));
constexpr int MTOK = 32768, DM = 1024, FFH = 2816, SEQ = 4096, NB = 8;
constexpr float EPSN = 1e-6f;
constexpr size_t MiB = 1u << 20;
constexpr size_t WS_CTL = 0;
constexpr size_t WS_W1GU = 2 * MiB, WS_W1D = 13 * MiB, WS_W2GU = 19 * MiB, WS_W2D = 30 * MiB;
constexpr size_t WS_WINA = 36 * MiB, WS_WINB = 37 * MiB, WS_WUQ = 40 * MiB, WS_WUK = 41 * MiB, WS_WUV = 41 * MiB + 512 * 1024, WS_WOUT = 42 * MiB;
constexpr size_t WS_ROPE = 44 * MiB, WS_FILT = 46 * MiB, WS_XN = 80 * MiB, WS_H = 144 * MiB;
constexpr size_t WS_UA = 144 * MiB, WS_UT = 208 * MiB, WS_KPE = 304 * MiB;
constexpr size_t WS_CQN = 320 * MiB, WS_CKVN = 336 * MiB, WS_Q = 352 * MiB  , WS_KN = 448 * MiB, WS_VT = 480 * MiB, WS_HYT = WS_UA  , WS_END = 512 * MiB;
constexpr size_t WS_MIXN = WS_XN;
constexpr int LDS_BYTES = 147456;
constexpr int NPHASE = 14;

__device__ __forceinline__ float wave_sum(float v) {
#pragma unroll
    for (int o = 1; o < 64; o <<= 1) v += __shfl_xor(v, o);
    return v;
}
__device__ __forceinline__ float bf2f(unsigned short b) { return __uint_as_float(((unsigned)b) << 16); }
__device__ __forceinline__ f32x16 mfma32(bf16x8 a, bf16x8 b, f32x16 c) { return __builtin_amdgcn_mfma_f32_32x32x16_bf16(a, b, c, 0, 0, 0); }
__device__ __forceinline__ void sincos_rr(float x, float& sn, float& cs) {
    const float n = rintf(x * 0.15915494309189535f);
    float r = fmaf(-n, 6.2831854820251465f, x); r = fmaf(-n, -1.7484555314695172e-7f, r);
    sn = __sinf(r); cs = __cosf(r);
}
#define LDS_WAIT() asm volatile("s_waitcnt lgkmcnt(0)" ::: "memory")

struct Params { const float* in[27]; float* out; unsigned char* ws; int ph_lo, ph_hi; };

__device__ __forceinline__ void tr_item(const float* src, int ldsrc, int scol0, int k0, bool valid, bf16_t* dst, int lddst, int drow0, LAS float* scr, int lane) {
    if (valid) {
#pragma unroll 8
        for (int i = 0; i < 32; ++i) { const int kk = 2 * i + (lane >> 5); scr[kk * 33 + (lane & 31)] = src[(size_t)(k0 + kk) * ldsrc + scol0 + (lane & 31)]; }
    } else {
#pragma unroll 8
        for (int i = 0; i < 32; ++i) { const int kk = 2 * i + (lane >> 5); scr[kk * 33 + (lane & 31)] = 0.f; }
    }
    LDS_WAIT();
    const int c = lane & 7;
#pragma unroll
    for (int j = 0; j < 4; ++j) { const int n = (lane >> 3) + 8 * j; const LAS float* s = scr + (8 * c) * 33 + n;
        u32x4 o; o.x = pk2(s[0 * 33], s[1 * 33]); o.y = pk2(s[2 * 33], s[3 * 33]); o.z = pk2(s[4 * 33], s[5 * 33]); o.w = pk2(s[6 * 33], s[7 * 33]);
        *(u32x4*)(dst + (size_t)(drow0 + n) * lddst + k0 + 8 * c) = o; }
    LDS_WAIT();
}

__device__ __forceinline__ void rms_row_bf16(const float* xrow, const float* g, bf16_t* orow, int lane) {
    const f32x4* xr = (const f32x4*)xrow + lane; const f32x4* gr = (const f32x4*)g + lane;
    f32x4 v[4]; float s = 0.f;
#pragma unroll
    for (int j = 0; j < 4; ++j) { v[j] = xr[64 * j]; s += (v[j].x * v[j].x + v[j].y * v[j].y) + (v[j].z * v[j].z + v[j].w * v[j].w); }
    const float rstd = 1.0f / sqrtf(wave_sum(s) * (1.0f / DM) + EPSN);
    u32x2* o8 = (u32x2*)orow + lane;
#pragma unroll
    for (int j = 0; j < 4; ++j) { const f32x4 gv = gr[64 * j]; u32x2 w; w.x = pk2(v[j].x * rstd * gv.x, v[j].y * rstd * gv.y); w.y = pk2(v[j].z * rstd * gv.z, v[j].w * rstd * gv.w); o8[64 * j] = w; }
}

__device__ __forceinline__ void filter_block(const Params& p, LAS unsigned char* lds, int pb, int tid) {
    LAS float* z = (LAS float*)(lds + 131072); LAS float* h1 = z + 528; LAS float* h2 = h1 + 1024;
    const float *w1 = p.in[13], *b1 = p.in[14], *w2 = p.in[15], *b2 = p.in[16], *w3 = p.in[17], *fr = p.in[18];
    float* FILT = (float*)(p.ws + WS_FILT); float* NORM = (float*)(p.ws + WS_CTL);
    for (int idx = tid; idx < 528; idx += 512) { const int pp = idx / 33, e = idx - pp * 33; const float t = (float)(pb * 16 + pp);
        float v;
        if (e == 0) v = t / 4095.0f;
        else { const int j = (e - 1) & 15; const float band = 1e-4f + (float)j * ((15.0f - 1e-4f) / 15.0f); const float ang = (6.283185307179586f * t / 4096.0f) * band; float sn, cs; sincos_rr(ang, sn, cs); v = (e <= 16) ? cs : -sn; }
        z[idx] = v; }
    __syncthreads();
    for (int idx = tid; idx < 1024; idx += 512) { const int pp = idx >> 6, j = idx & 63; float a = b1[j];
#pragma unroll 3
        for (int e = 0; e < 33; ++e) a += z[pp * 33 + e] * w1[e * 64 + j];
        float sn, cs; sincos_rr(fr[j] * a, sn, cs); h1[idx] = sn; }
    __syncthreads();
    for (int idx = tid; idx < 1024; idx += 512) { const int pp = idx >> 6, j = idx & 63; float a = b2[j];
#pragma unroll 4
        for (int i = 0; i < 64; ++i) a += h1[pp * 64 + i] * w2[i * 64 + j];
        float sn, cs; sincos_rr(fr[j] * a, sn, cs); h2[idx] = sn; }
    __syncthreads();
    const float dmin = 3.0701134573253945f, dmax = 15.350567286626973f;
#pragma unroll 1
    for (int m = 0; m < 4; ++m) { const int q = tid + 512 * m;
        float acc[16];
#pragma unroll
        for (int pp = 0; pp < 16; ++pp) acc[pp] = 0.f;
#pragma unroll 2
        for (int i = 0; i < 64; ++i) { const float w = w3[i * 2048 + q];
#pragma unroll
            for (int pp = 0; pp < 16; ++pp) acc[pp] += h2[pp * 64 + i] * w; }
        const int o = q >> 10, dir = (q >> 9) & 1, c = q & 511; const float delta = dmin + (float)c * ((dmax - dmin) / 511.0f);
        float sabs = 0.f;
#pragma unroll
        for (int pp = 0; pp < 16; ++pp) { const int t = pb * 16 + pp; const float v = acc[pp] * __expf(-((float)t / 4095.0f) * delta); acc[pp] = v; if (!(dir == 1 && t == 0)) sabs += fabsf(v); }
        float* dst = FILT + ((size_t)((o * 2 + dir) * 512 + c)) * 4096 + pb * 16;
#pragma unroll
        for (int k = 0; k < 4; ++k) *(f32x4*)(dst + 4 * k) = (f32x4){acc[4 * k], acc[4 * k + 1], acc[4 * k + 2], acc[4 * k + 3]};
        atomicAdd(&NORM[o * 512 + c], sabs); }
    __syncthreads();
}

constexpr int KL_STRIDE = 208, VL_STRIDE = 144, KL_BYTES = 64 * KL_STRIDE, VL_BYTES = 64 * VL_STRIDE, ATT_BUF = KL_BYTES + VL_BYTES;
__device__ __forceinline__ bf16x8 pack8(const f32x16& x, int s) {
    u32x4 p; p.x = pk2(x[8 * s], x[8 * s + 1]); p.y = pk2(x[8 * s + 2], x[8 * s + 3]); p.z = pk2(x[8 * s + 4], x[8 * s + 5]); p.w = pk2(x[8 * s + 6], x[8 * s + 7]);
    return __builtin_bit_cast(bf16x8, p);
}
__device__ __forceinline__ void attn_unit(const Params& p, LAS unsigned char* lds, int unit, int tid, int lane, int wave) {
    const int bh = unit >> 4, qb = unit & 15, b = bh >> 3, h = bh & 7, r = lane & 31, hh = lane >> 5;
    const float* Q = (const float*)(p.ws + WS_Q); const bf16_t* KN = (const bf16_t*)(p.ws + WS_KN); const bf16_t* KPE = (const bf16_t*)(p.ws + WS_KPE); const bf16_t* VT = (const bf16_t*)(p.ws + WS_VT);
    bf16_t* MIXN = (bf16_t*)(p.ws + WS_MIXN);
    const size_t tok0 = (size_t)b * SEQ, qrow = tok0 + qb * 256 + wave * 32 + r;
    bf16x8 qf[6];
    { const float QS = 0.14724352f;
      const float* qp = Q + qrow * 768 + 96 * h + 8 * hh;
#pragma unroll
      for (int ks = 0; ks < 4; ++ks) { const f32x4 a = *(const f32x4*)(qp + 16 * ks), b = *(const f32x4*)(qp + 16 * ks + 4);
          u32x4 w; w.x = pk2(a.x * QS, a.y * QS); w.y = pk2(a.z * QS, a.w * QS); w.z = pk2(b.x * QS, b.y * QS); w.w = pk2(b.z * QS, b.w * QS); qf[ks] = __builtin_bit_cast(bf16x8, w); }
      const f32x2_t* tab = (const f32x2_t*)(p.ws + WS_ROPE) + (size_t)((int)(qrow & 4095)) * 16 + 8 * hh;
      float x1[8], x2[8];
      { const f32x4 a = *(const f32x4*)(qp + 64), b = *(const f32x4*)(qp + 68), c = *(const f32x4*)(qp + 80), d = *(const f32x4*)(qp + 84);
        x1[0] = a.x; x1[1] = a.y; x1[2] = a.z; x1[3] = a.w; x1[4] = b.x; x1[5] = b.y; x1[6] = b.z; x1[7] = b.w;
        x2[0] = c.x; x2[1] = c.y; x2[2] = c.z; x2[3] = c.w; x2[4] = d.x; x2[5] = d.y; x2[6] = d.z; x2[7] = d.w; }
      float y1[8], y2[8];
#pragma unroll
      for (int j = 0; j < 8; ++j) { const f32x2_t cs = tab[j]; y1[j] = (x1[j] * cs.x - x2[j] * cs.y) * QS; y2[j] = (x1[j] * cs.y + x2[j] * cs.x) * QS; }
      u32x4 w; w.x = pk2(y1[0], y1[1]); w.y = pk2(y1[2], y1[3]); w.z = pk2(y1[4], y1[5]); w.w = pk2(y1[6], y1[7]); qf[4] = __builtin_bit_cast(bf16x8, w);
      w.x = pk2(y2[0], y2[1]); w.y = pk2(y2[2], y2[3]); w.z = pk2(y2[4], y2[5]); w.w = pk2(y2[6], y2[7]); qf[5] = __builtin_bit_cast(bf16x8, w); }
    const int kc1 = tid + 512; const bool has1 = tid < 256;
    const int key0 = tid / 12, part0 = tid - key0 * 12, key1 = kc1 / 12, part1 = kc1 - key1 * 12;
    const bf16_t* ks0 = part0 < 8 ? KN + (tok0 + key0) * 512 + 64 * h + 8 * part0 : KPE + (tok0 + key0) * 32 + 8 * (part0 - 8);
    const bf16_t* ks1 = part1 < 8 ? KN + (tok0 + key1) * 512 + 64 * h + 8 * part1 : KPE + (tok0 + key1) * 32 + 8 * (part1 - 8);
    const int kst0 = part0 < 8 ? 64 * 512 : 64 * 32, kst1 = part1 < 8 ? 64 * 512 : 64 * 32;
    const bf16_t* vs = VT + (size_t)(64 * h + (tid >> 3)) * MTOK + tok0 + 8 * (tid & 7);
    const int kd0 = key0 * KL_STRIDE + part0 * 16, kd1 = key1 * KL_STRIDE + part1 * 16, vd = KL_BYTES + (tid >> 3) * VL_STRIDE + (tid & 7) * 16;
    u32x4 rk0, rk1 = (u32x4){0u, 0u, 0u, 0u}, rv;
    rk0 = *(const u32x4*)ks0; if (has1) rk1 = *(const u32x4*)ks1; rv = *(const u32x4*)vs;
    *(LAS u32x4*)(lds + kd0) = rk0; if (has1) *(LAS u32x4*)(lds + kd1) = rk1; *(LAS u32x4*)(lds + vd) = rv;
    __syncthreads();
    f32x16 o0, o1;
#pragma unroll
    for (int i = 0; i < 16; ++i) { o0[i] = 0.f; o1[i] = 0.f; }
    float lsum = 0.f;
    for (int kt = 0; kt < 64; ++kt) {
        const int buf = kt & 1; const bool more = kt + 1 < 64;
        if (more) { rk0 = *(const u32x4*)(ks0 + (size_t)(kt + 1) * kst0); if (has1) rk1 = *(const u32x4*)(ks1 + (size_t)(kt + 1) * kst1); rv = *(const u32x4*)(vs + (kt + 1) * 64); }
        const LAS unsigned char* KLb = lds + buf * ATT_BUF; const LAS unsigned char* VLb = KLb + KL_BYTES;
        f32x16 s0, s1;
#pragma unroll
        for (int i = 0; i < 16; ++i) { s0[i] = 0.f; s1[i] = 0.f; }
#pragma unroll
        for (int ks = 0; ks < 6; ++ks) {
            const bf16x8 ka = *(const LAS bf16x8*)(KLb + r * KL_STRIDE + 32 * ks + 16 * hh);
            const bf16x8 kb = *(const LAS bf16x8*)(KLb + (32 + r) * KL_STRIDE + 32 * ks + 16 * hh);
            s0 = mfma32(ka, qf[ks], s0); s1 = mfma32(kb, qf[ks], s1); }
#pragma unroll
        for (int i = 0; i < 16; ++i) { s0[i] = __builtin_amdgcn_exp2f(s0[i]); s1[i] = __builtin_amdgcn_exp2f(s1[i]); lsum += s0[i] + s1[i]; }
        bf16x8 pf[2][2];
        pf[0][0] = pack8(s0, 0); pf[0][1] = pack8(s0, 1); pf[1][0] = pack8(s1, 0); pf[1][1] = pack8(s1, 1);
#pragma unroll
        for (int sub = 0; sub < 2; ++sub)
#pragma unroll
            for (int s = 0; s < 2; ++s) {
                const LAS unsigned char* vp = VLb + r * VL_STRIDE + (32 * sub + 16 * s + 4 * hh) * 2;
                const u32x2 lo0 = *(const LAS u32x2*)vp, hi0 = *(const LAS u32x2*)(vp + 16);
                const u32x2 lo1 = *(const LAS u32x2*)(vp + 32 * VL_STRIDE), hi1 = *(const LAS u32x2*)(vp + 32 * VL_STRIDE + 16);
                const bf16x8 va0 = __builtin_bit_cast(bf16x8, ((u32x4){lo0.x, lo0.y, hi0.x, hi0.y}));
                const bf16x8 va1 = __builtin_bit_cast(bf16x8, ((u32x4){lo1.x, lo1.y, hi1.x, hi1.y}));
                o0 = mfma32(va0, pf[sub][s], o0); o1 = mfma32(va1, pf[sub][s], o1); }
        if (more) { LAS unsigned char* nb = lds + (buf ^ 1) * ATT_BUF; *(LAS u32x4*)(nb + kd0) = rk0; if (has1) *(LAS u32x4*)(nb + kd1) = rk1; *(LAS u32x4*)(nb + vd) = rv; }
        __syncthreads();
    }
    const float l = lsum + __shfl_xor(lsum, 32); const float inv = 1.0f / l;
    float ss = 0.f;
#pragma unroll
    for (int i = 0; i < 16; ++i) { o0[i] *= inv; o1[i] *= inv; ss += o0[i] * o0[i] + o1[i] * o1[i]; }
    ss += __shfl_xor(ss, 32);
    const float rstd = 1.0f / sqrtf(ss * (1.0f / 64.0f) + EPSN);
    const float* hg = p.in[20] + 64 * h;
#pragma unroll
    for (int g = 0; g < 4; ++g) {
        const int dv0 = 8 * g + 4 * hh, dv1 = 32 + dv0;
        const f32x4 g0 = *(const f32x4*)(hg + dv0), g1 = *(const f32x4*)(hg + dv1);
        u32x2 w0, w1;
        w0.x = pk2(o0[4 * g] * rstd * g0.x, o0[4 * g + 1] * rstd * g0.y); w0.y = pk2(o0[4 * g + 2] * rstd * g0.z, o0[4 * g + 3] * rstd * g0.w);
        w1.x = pk2(o1[4 * g] * rstd * g1.x, o1[4 * g + 1] * rstd * g1.y); w1.y = pk2(o1[4 * g + 2] * rstd * g1.z, o1[4 * g + 3] * rstd * g1.w);
        *(u32x2*)(MIXN + qrow * 1024 + 64 * h + dv0) = w0; *(u32x2*)(MIXN + qrow * 1024 + 64 * h + dv1) = w1; }
}

constexpr int UT_STRIDE = 8192 + 32, UTL_BYTES = 8 * UT_STRIDE, RL_OFF = UTL_BYTES;
typedef short bf16x8_u __attribute__((ext_vector_type(8), aligned(2)));
__device__ __forceinline__ void hy_load_filter(const Params& p, LAS unsigned char* lds, int o, int c, int tid) {
    LAS bf16_t* RL = (LAS bf16_t*)(lds + RL_OFF);
    const float* FILT = (const float*)(p.ws + WS_FILT); const float* NORM = (const float*)(p.ws + WS_CTL);
    const float invn = 1.0f / NORM[o * 512 + c];
    const float* hf = FILT + (size_t)((o * 2 + 0) * 512 + c) * 4096; const float* hb = FILT + (size_t)((o * 2 + 1) * 512 + c) * 4096;
    for (int i = tid; i < 8192; i += 512) { float v = 0.f; if (i <= 4095) v = hf[4095 - i] * invn; else if (i < 8191) v = hb[i - 4095] * invn;
        RL[i] = (bf16_t)(pk2(v, 0.f) & 0xffffu); }
}
__device__ __forceinline__ void hy_conv(LAS unsigned char* lds, f32x16 (&acc)[2][2], int lane, int wave) {
    const LAS bf16_t* RL = (const LAS bf16_t*)(lds + RL_OFF);
    const int r = lane & 31, hh = lane >> 5, bb = r & 7, t1o = r >> 3;
#pragma unroll
    for (int a = 0; a < 2; ++a)
#pragma unroll
        for (int b = 0; b < 2; ++b)
#pragma unroll
            for (int i = 0; i < 16; ++i) acc[a][b][i] = 0.f;
    const LAS unsigned char* ub = lds + bb * UT_STRIDE + 16 * hh;
    for (int q = 0; q < 71; ++q) {
        const int d1 = 8 * wave - 63 + q;
        bf16x8 A[2][4], B[2][4];
        const int e0 = 4095 + 8 * hh - r - 64 * d1;
#pragma unroll
        for (int mt = 0; mt < 2; ++mt)
#pragma unroll
            for (int ks = 0; ks < 4; ++ks) { const bf16x8_u w = *(const LAS bf16x8_u*)(RL + e0 + 16 * ks - 32 * mt); A[mt][ks] = w; }
#pragma unroll
        for (int nt = 0; nt < 2; ++nt) { const int s1 = 8 * wave + 4 * nt + t1o - d1; const bool valid = (unsigned)s1 < 64u; const int s1c = valid ? s1 : 0;
#pragma unroll
            for (int ks = 0; ks < 4; ++ks) { bf16x8 v = *(const LAS bf16x8*)(ub + s1c * 128 + 32 * ks); if (!valid) v = (bf16x8){0, 0, 0, 0, 0, 0, 0, 0}; B[nt][ks] = v; } }
#pragma unroll
        for (int ks = 0; ks < 4; ++ks)
#pragma unroll
            for (int mt = 0; mt < 2; ++mt)
#pragma unroll
                for (int nt = 0; nt < 2; ++nt) acc[mt][nt] = mfma32(A[mt][ks], B[nt][ks], acc[mt][nt]);
    }
}
__device__ __forceinline__ void hy_epi(const Params& p, LAS unsigned char* lds, const f32x16 (&acc)[2][2], int o, int c, int lane, int wave) {
    const int r = lane & 31, hh = lane >> 5, bb = r & 7, t1o = r >> 3;
    const bf16_t* UTg = (const bf16_t*)(p.ws + WS_UT); bf16_t* HYT = (bf16_t*)(p.ws + WS_HYT);
    const int gc = 512 * (o + 1) + c;
    const float* cw = p.in[11]; const float w0 = cw[gc], w1 = cw[1536 + gc], w2 = cw[3072 + gc], cbv = p.in[12][gc], dsk = p.in[19][o * 512 + c];
    const bf16_t* gx = UTg + (size_t)gc * MTOK + bb * SEQ;
#pragma unroll
    for (int mt = 0; mt < 2; ++mt)
#pragma unroll
        for (int nt = 0; nt < 2; ++nt)
#pragma unroll
            for (int g = 0; g < 4; ++g) {
                const int t = 64 * (8 * wave + 4 * nt + t1o) + 32 * mt + 8 * g + 4 * hh;
                const u32x2 xr = *(const u32x2*)(gx + t);
                float xv[6];
                xv[0] = t > 0 ? bf2f(gx[t - 1]) : 0.f; xv[5] = t + 4 < SEQ ? bf2f(gx[t + 4]) : 0.f;
                xv[1] = __uint_as_float(xr.x << 16); xv[2] = __uint_as_float(xr.x & 0xffff0000u); xv[3] = __uint_as_float(xr.y << 16); xv[4] = __uint_as_float(xr.y & 0xffff0000u);
                LAS unsigned char* up = lds + bb * UT_STRIDE + t * 2;
                const u32x2 ur = *(const LAS u32x2*)up;
                float uv[4]; uv[0] = __uint_as_float(ur.x << 16); uv[1] = __uint_as_float(ur.x & 0xffff0000u); uv[2] = __uint_as_float(ur.y << 16); uv[3] = __uint_as_float(ur.y & 0xffff0000u);
                float res[4];
#pragma unroll
                for (int j = 0; j < 4; ++j) { const float gate = cbv + w0 * xv[j] + w1 * xv[j + 1] + w2 * xv[j + 2]; res[j] = (acc[mt][nt][4 * g + j] + uv[j] * dsk) * gate; }
                u32x2 w; w.x = pk2(res[0], res[1]); w.y = pk2(res[2], res[3]);
                if (o == 0) *(LAS u32x2*)up = w; else *(u32x2*)(HYT + (size_t)c * MTOK + bb * SEQ + t) = w;
            }
}
__device__ __forceinline__ void hyena_channel(const Params& p, LAS unsigned char* lds, int c, int tid, int lane, int wave) {
    const bf16_t* UTg = (const bf16_t*)(p.ws + WS_UT);
    { const float* cw = p.in[11]; const float w0 = cw[c], w1 = cw[1536 + c], w2 = cw[3072 + c], cbv = p.in[12][c];
      for (int i = 0; i < 8; ++i) { const int ch = tid + 512 * i, b = ch >> 9, s0 = (ch & 511) * 8;
          const bf16_t* src = UTg + (size_t)c * MTOK + b * SEQ + s0;
          const u32x4 raw = *(const u32x4*)src;
          float f[10];
          f[0] = s0 > 0 ? bf2f(src[-1]) : 0.f; f[9] = s0 + 8 < SEQ ? bf2f(src[8]) : 0.f;
          f[1] = __uint_as_float(raw.x << 16); f[2] = __uint_as_float(raw.x & 0xffff0000u); f[3] = __uint_as_float(raw.y << 16); f[4] = __uint_as_float(raw.y & 0xffff0000u);
          f[5] = __uint_as_float(raw.z << 16); f[6] = __uint_as_float(raw.z & 0xffff0000u); f[7] = __uint_as_float(raw.w << 16); f[8] = __uint_as_float(raw.w & 0xffff0000u);
          float v[8];
#pragma unroll
          for (int j = 0; j < 8; ++j) v[j] = cbv + w0 * f[j] + w1 * f[j + 1] + w2 * f[j + 2];
          u32x4 w; w.x = pk2(v[0], v[1]); w.y = pk2(v[2], v[3]); w.z = pk2(v[4], v[5]); w.w = pk2(v[6], v[7]);
          *(LAS u32x4*)(lds + b * UT_STRIDE + s0 * 2) = w; } }
    hy_load_filter(p, lds, 0, c, tid);
    __syncthreads();
    f32x16 acc[2][2];
    hy_conv(lds, acc, lane, wave);
    __syncthreads();
    hy_epi(p, lds, acc, 0, c, lane, wave);
    hy_load_filter(p, lds, 1, c, tid);
    __syncthreads();
    hy_conv(lds, acc, lane, wave);
    hy_epi(p, lds, acc, 1, c, lane, wave);
    __syncthreads();
}

__global__ void __launch_bounds__(512) fwd_megakernel(Params p) {
    extern __shared__ __attribute__((aligned(16))) unsigned char lds_raw[];
    LAS unsigned char* lds = (LAS unsigned char*)lds_raw;
    cg::grid_group grid = cg::this_grid();
    const int tid = threadIdx.x, lane = tid & 63, wave = __builtin_amdgcn_readfirstlane(tid >> 6);
    const int G = gridDim.x, bx = blockIdx.x;
    const int vcu = (G % 8 == 0) ? (bx % 8) * (G / 8) + bx / 8 : bx;
    const int gw = vcu * 8 + wave, NGW = G * 8;
    unsigned char* ws = p.ws;
    const int lo = p.ph_lo, hi = p.ph_hi;
#ifndef P0SEL
#define P0SEL 15
#endif
#ifndef P6SEL
#define P6SEL 7
#endif
#ifndef PHMASK
#define PHMASK 0xffff
#endif
#define IN(k) (((PHMASK >> (k)) & 1) && lo <= (k) && (k) < hi)
#define SEAM(k) do { if (IN(k) && IN((k) + 1)) grid.sync(); } while (0)
    bf16_t* XN = (bf16_t*)(ws + WS_XN); bf16_t* HB = (bf16_t*)(ws + WS_H);

    if (IN(0)) {
        LAS float* scr = (LAS float*)(lds + wave * 16384);
        constexpr int I_GU = 16 * 176, I_D = 44 * 32, I_INA = 16 * 16, I_INB = 16 * 48, I_UQ = 4 * 24, I_UK = 4 * 16, I_OUT = 16 * 32;
        constexpr int NITEMS = 2 * (I_GU + I_D) + I_INA + I_INB + I_UQ + 2 * I_UK + I_OUT;
        if (P0SEL & 1) for (int it = gw; it < NITEMS; it += NGW) {
            int r = it;
            bool done = false;
#pragma unroll
            for (int f = 0; f < 2; ++f) {
                if (done) break;
                const float* wg = p.in[f ? 23 : 2]; const float* wu = p.in[f ? 24 : 3]; const float* wd = p.in[f ? 25 : 4];
                bf16_t* GU = (bf16_t*)(ws + (f ? WS_W2GU : WS_W1GU)); bf16_t* DD = (bf16_t*)(ws + (f ? WS_W2D : WS_W1D));
                if (r < I_GU) { const int kb = r / 176, nb = r - kb * 176, pn = nb >> 3, rb = nb & 7;
                    tr_item(rb < 4 ? wg : wu, FFH, 128 * pn + 32 * (rb & 3), 64 * kb, true, GU, DM, 32 * nb, scr, lane); done = true; break; }
                r -= I_GU;
                if (r < I_D) { const int kb = r / 32, nb = r - kb * 32; tr_item(wd, DM, 32 * nb, 64 * kb, true, DD, FFH, 32 * nb, scr, lane); done = true; break; }
                r -= I_D;
            }
            if (done) continue;
            if (r < I_INA) { const int kb = r / 16, nb = r - kb * 16; tr_item(p.in[6], 1952, 32 * nb, 64 * kb, nb < 13, (bf16_t*)(ws + WS_WINA), DM, 32 * nb, scr, lane); continue; } r -= I_INA;
            if (r < I_INB) { const int kb = r / 48, nb = r - kb * 48; tr_item(p.in[6], 1952, 416 + 32 * nb, 64 * kb, true, (bf16_t*)(ws + WS_WINB), DM, 32 * nb, scr, lane); continue; } r -= I_INB;
            if (r < I_UQ) { const int kb = r / 24, nb = r - kb * 24; tr_item(p.in[8], 768, 32 * nb, 64 * kb, true, (bf16_t*)(ws + WS_WUQ), 256, 32 * nb, scr, lane); continue; } r -= I_UQ;
            if (r < I_UK) { const int kb = r / 16, nb = r - kb * 16; tr_item(p.in[10], 1024, 128 * (nb >> 1) + 32 * (nb & 1), 64 * kb, kb < 2, (bf16_t*)(ws + WS_WUK), 256, 32 * nb, scr, lane); continue; } r -= I_UK;
            if (r < I_UK) { const int kb = r / 16, nb = r - kb * 16; tr_item(p.in[10], 1024, 128 * (nb >> 1) + 64 + 32 * (nb & 1), 64 * kb, kb < 2, (bf16_t*)(ws + WS_WUV), 256, 32 * nb, scr, lane); continue; } r -= I_UK;
            { const int kb = r / 32, nb = r - kb * 32; tr_item(p.in[21], DM, 32 * nb, 64 * kb, true, (bf16_t*)(ws + WS_WOUT), DM, 32 * nb, scr, lane); }
        }
        if (P0SEL & 2) { f32x2_t* tab = (f32x2_t*)(ws + WS_ROPE);
          for (int idx = gw * 64 + lane; idx < SEQ * 16; idx += NGW * 64) { const int s = idx >> 4, i = idx & 15;
              const float inv = exp2f(-(float)i * 0.8304820237218406f); const float ang = (float)s * inv; float sn, cs; sincos_rr(ang, sn, cs); tab[idx] = (f32x2_t){cs, sn}; } }
        __syncthreads();
        if (P0SEL & 4) for (int pb = bx; pb < 256; pb += G) filter_block(p, lds, pb, tid);
        if (P0SEL & 8) for (int m = gw; m < MTOK; m += NGW) rms_row_bf16(p.in[0] + (size_t)m * DM, p.in[1], XN + (size_t)m * DM, lane);
    }
    SEAM(0);
    if (IN(1)) { __syncthreads(); pg8::Gemm g{XN, (const bf16_t*)(ws + WS_W1GU), MTOK, 2 * FFH, DM}; pg8::StaticOrder S; S.init(MTOK, 2 * FFH, G, bx);
        pg8::EpiSwiGLU E{HB, FFH}; pg8::gemm_phase<pg8::EpiSwiGLU, pg8::StaticOrder>(lds, g, S, E); }
    SEAM(1);
    if (IN(2)) { __syncthreads(); pg8::Gemm g{HB, (const bf16_t*)(ws + WS_W1D), MTOK, DM, FFH}; pg8::StaticOrder S; S.init(MTOK, DM, G, bx);
        pg8::EpiResid E{p.in[0], p.out, DM, 0.5f}; pg8::gemm_phase<pg8::EpiResid, pg8::StaticOrder>(lds, g, S, E); }
    SEAM(2);
    if (IN(3)) { for (int m = gw; m < MTOK; m += NGW) rms_row_bf16(p.out + (size_t)m * DM, p.in[5], XN + (size_t)m * DM, lane); }
    SEAM(3);
    if (IN(4)) { __syncthreads();
        { pg8::Gemm g{XN, (const bf16_t*)(ws + WS_WINA), MTOK, 512, DM}; pg8::StaticOrder S; S.init(MTOK, 512, G, bx);
          pg8::EpiF32 E{(float*)(ws + WS_UA), 512}; pg8::gemm_phase<pg8::EpiF32, pg8::StaticOrder>(lds, g, S, E); }
        { pg8::Gemm g{(const bf16_t*)(ws + WS_WINB), XN, 1536, MTOK, DM}; pg8::StaticOrder S; S.init(1536, MTOK, G, bx);
          pg8::EpiBf16P E{(bf16_t*)(ws + WS_UT), (size_t)MTOK}; pg8::gemm_phase<pg8::EpiBf16P, pg8::StaticOrder>(lds, g, S, E); } }
    SEAM(4);
    if (IN(5)) {
        const float* UA = (const float*)(ws + WS_UA); bf16_t* CQN = (bf16_t*)(ws + WS_CQN); bf16_t* CKVN = (bf16_t*)(ws + WS_CKVN); bf16_t* KPE = (bf16_t*)(ws + WS_KPE);
        const f32x2_t* tab = (const f32x2_t*)(ws + WS_ROPE);
        const f32x4 gq = ((const f32x4*)p.in[7])[lane]; const f32x4 gk = lane < 32 ? ((const f32x4*)p.in[9])[lane] : (f32x4){0.f, 0.f, 0.f, 0.f};
        for (int row = gw; row < MTOK; row += NGW) {
            const f32x4* ur = (const f32x4*)(UA + (size_t)row * 512);
            const f32x4 a = ur[lane], bq = ur[64 + lane];
            const float rq = 1.0f / sqrtf(wave_sum((a.x * a.x + a.y * a.y) + (a.z * a.z + a.w * a.w)) * (1.0f / 256.0f) + EPSN);
            u32x2 w; w.x = pk2(a.x * rq * gq.x, a.y * rq * gq.y); w.y = pk2(a.z * rq * gq.z, a.w * rq * gq.w);
            *((u32x2*)(CQN + (size_t)row * 256) + lane) = w;
            const float skv = lane < 32 ? (bq.x * bq.x + bq.y * bq.y) + (bq.z * bq.z + bq.w * bq.w) : 0.f;
            const float rkv = 1.0f / sqrtf(wave_sum(skv) * (1.0f / 128.0f) + EPSN);
            u32x2 wk = (u32x2){0u, 0u};
            if (lane < 32) { wk.x = pk2(bq.x * rkv * gk.x, bq.y * rkv * gk.y); wk.y = pk2(bq.z * rkv * gk.z, bq.w * rkv * gk.w); }
            *((u32x2*)(CKVN + (size_t)row * 256) + lane) = wk;
            f32x4 pr; pr.x = __shfl_xor(bq.x, 4); pr.y = __shfl_xor(bq.y, 4); pr.z = __shfl_xor(bq.z, 4); pr.w = __shfl_xor(bq.w, 4);
            if (lane >= 32 && lane < 40) { const int pos = row & 4095; const bool first = lane < 36; const int i0 = 4 * ((lane - 32) & 3);
                float ov[4];
#pragma unroll
                for (int e = 0; e < 4; ++e) { const f32x2_t cs = tab[pos * 16 + i0 + e]; const float x1 = first ? bq[e] : pr[e], x2 = first ? pr[e] : bq[e]; ov[e] = first ? x1 * cs.x - x2 * cs.y : x1 * cs.y + x2 * cs.x; }
                u32x2 wo; wo.x = pk2(ov[0], ov[1]); wo.y = pk2(ov[2], ov[3]);
                *(u32x2*)(KPE + (size_t)row * 32 + 4 * (lane - 32)) = wo; }
        }
    }
    SEAM(5);
    if (IN(6)) { __syncthreads();
        if (P6SEL & 1) { pg8::Gemm g{(const bf16_t*)(ws + WS_CQN), (const bf16_t*)(ws + WS_WUQ), MTOK, 768, 256}; pg8::StaticOrder S; S.init(MTOK, 768, G, bx);
          pg8::EpiF32 E{(float*)(ws + WS_Q), 768}; pg8::gemm_phase<pg8::EpiF32, pg8::StaticOrder>(lds, g, S, E); }
        if (P6SEL & 2) { pg8::Gemm g{(const bf16_t*)(ws + WS_CKVN), (const bf16_t*)(ws + WS_WUK), MTOK, 512, 256}; pg8::StaticOrder S; S.init(MTOK, 512, G, bx);
          pg8::EpiBf16P E{(bf16_t*)(ws + WS_KN), (size_t)512}; pg8::gemm_phase<pg8::EpiBf16P, pg8::StaticOrder>(lds, g, S, E); }
        if (P6SEL & 4) { pg8::Gemm g{(const bf16_t*)(ws + WS_WUV), (const bf16_t*)(ws + WS_CKVN), 512, MTOK, 256}; pg8::StaticOrder S; S.init(512, MTOK, G, bx);
          pg8::EpiBf16P E{(bf16_t*)(ws + WS_VT), (size_t)MTOK}; pg8::gemm_phase<pg8::EpiBf16P, pg8::StaticOrder>(lds, g, S, E); } }
    SEAM(6);
    if (IN(7)) { __syncthreads();
        for (int u = vcu; u < 1024; u += G) attn_unit(p, lds, u, tid, lane, wave);
        __syncthreads();
        for (int c = bx; c < 512; c += G) hyena_channel(p, lds, c, tid, lane, wave);
    }
    SEAM(7);
    if (IN(8)) {
        const bf16_t* HYT = (const bf16_t*)(ws + WS_HYT); bf16_t* MIXN = (bf16_t*)(ws + WS_MIXN); const float* hg = p.in[20] + 512;
        for (int it = gw; it < 8 * (MTOK / 64); it += NGW) { const int grp = it & 7, row = (it >> 3) * 64 + lane;
            float v[64]; float ss = 0.f;
#pragma unroll
            for (int cc = 0; cc < 64; ++cc) { v[cc] = bf2f(HYT[(size_t)(64 * grp + cc) * MTOK + row]); ss += v[cc] * v[cc]; }
            const float rstd = 1.0f / sqrtf(ss * (1.0f / 64.0f) + EPSN);
            bf16_t* dst = MIXN + (size_t)row * 1024 + 512 + 64 * grp;
#pragma unroll
            for (int k = 0; k < 8; ++k) { const float* gp = hg + 64 * grp + 8 * k;
                u32x4 w; w.x = pk2(v[8 * k] * rstd * gp[0], v[8 * k + 1] * rstd * gp[1]); w.y = pk2(v[8 * k + 2] * rstd * gp[2], v[8 * k + 3] * rstd * gp[3]);
                w.z = pk2(v[8 * k + 4] * rstd * gp[4], v[8 * k + 5] * rstd * gp[5]); w.w = pk2(v[8 * k + 6] * rstd * gp[6], v[8 * k + 7] * rstd * gp[7]);
                *(u32x4*)(dst + 8 * k) = w; } }
    }
    SEAM(8);
    if (IN(9)) { __syncthreads(); pg8::Gemm g{(const bf16_t*)(ws + WS_MIXN), (const bf16_t*)(ws + WS_WOUT), MTOK, DM, DM}; pg8::StaticOrder S; S.init(MTOK, DM, G, bx);
        pg8::EpiResid E{p.out, p.out, DM, 1.0f}; pg8::gemm_phase<pg8::EpiResid, pg8::StaticOrder>(lds, g, S, E); }
    SEAM(9);
    if (IN(10)) { for (int m = gw; m < MTOK; m += NGW) rms_row_bf16(p.out + (size_t)m * DM, p.in[22], XN + (size_t)m * DM, lane); }
    SEAM(10);
    if (IN(11)) { __syncthreads(); pg8::Gemm g{XN, (const bf16_t*)(ws + WS_W2GU), MTOK, 2 * FFH, DM}; pg8::StaticOrder S; S.init(MTOK, 2 * FFH, G, bx);
        pg8::EpiSwiGLU E{HB, FFH}; pg8::gemm_phase<pg8::EpiSwiGLU, pg8::StaticOrder>(lds, g, S, E); }
    SEAM(11);
    if (IN(12)) { __syncthreads(); pg8::Gemm g{HB, (const bf16_t*)(ws + WS_W2D), MTOK, DM, FFH}; pg8::StaticOrder S; S.init(MTOK, DM, G, bx);
        pg8::EpiResid E{p.out, p.out, DM, 0.5f}; pg8::gemm_phase<pg8::EpiResid, pg8::StaticOrder>(lds, g, S, E); }
    SEAM(12);
    if (IN(13)) {
        const f32x4* gr = (const f32x4*)p.in[26] + lane;
        for (int m = gw; m < MTOK; m += NGW) { f32x4* xr = (f32x4*)(p.out + (size_t)m * DM) + lane; f32x4 v[4]; float s = 0.f;
#pragma unroll
            for (int j = 0; j < 4; ++j) { v[j] = xr[64 * j]; s += (v[j].x * v[j].x + v[j].y * v[j].y) + (v[j].z * v[j].z + v[j].w * v[j].w); }
            const float rstd = 1.0f / sqrtf(wave_sum(s) * (1.0f / DM) + EPSN);
#pragma unroll
            for (int j = 0; j < 4; ++j) xr[64 * j] = v[j] * rstd * gr[64 * j]; }
    }
#undef IN
#undef SEAM
}

#ifndef ONE_LAUNCH
#define ONE_LAUNCH 1
#endif
extern "C" void kernel_launch(void* const* d_in, const int* in_sizes, int n_in, void* d_out, int out_size, void* d_ws, size_t ws_size, hipStream_t stream) {
    static int grid = 0;
    if (grid == 0) {
        if (n_in != 27 || ws_size < WS_END) { fprintf(stderr, "kernel_launch: unexpected n_in %d or ws_size %zu\n", n_in, ws_size); grid = -1; return; }
        int dev = 0, cus = 0, per_cu = 0;
        (void)hipGetDevice(&dev); (void)hipDeviceGetAttribute(&cus, hipDeviceAttributeMultiprocessorCount, dev);
        if (hipFuncSetAttribute((const void*)fwd_megakernel, hipFuncAttributeMaxDynamicSharedMemorySize, LDS_BYTES) != hipSuccess) { fprintf(stderr, "kernel_launch: hipFuncSetAttribute failed\n"); grid = -1; return; }
        if (hipOccupancyMaxActiveBlocksPerMultiprocessor(&per_cu, (const void*)fwd_megakernel, 512, LDS_BYTES) != hipSuccess || per_cu < 1) { fprintf(stderr, "kernel_launch: occupancy query says %d\n", per_cu); (void)hipGetLastError(); grid = -1; return; }
        grid = cus;
    }
    if (grid < 0) return;
    (void)hipMemsetAsync((char*)d_ws + WS_CTL, 0, 8192, stream);
    Params p{};
    for (int i = 0; i < 27; ++i) p.in[i] = (const float*)d_in[i];
    p.out = (float*)d_out; p.ws = (unsigned char*)d_ws;
#if ONE_LAUNCH
    p.ph_lo = 0; p.ph_hi = NPHASE;
    void* args[] = {&p};
    hipError_t e = hipLaunchCooperativeKernel((const void*)fwd_megakernel, dim3(grid), dim3(512), args, LDS_BYTES, stream);
    if (e != hipSuccess) fprintf(stderr, "cooperative launch failed: %s (grid %d)\n", hipGetErrorString(e), grid);
#else
    for (int k = 0; k < NPHASE; ++k) { p.ph_lo = k; p.ph_hi = k + 1; hipLaunchKernelGGL(fwd_megakernel, dim3(grid), dim3(512), LDS_BYTES, stream, p); }
#endif
}
```

```cpp
#include <hip/hip_runtime.h>
#include <hip/hip_cooperative_groups.h>
#include <cstdio>
namespace cg = cooperative_groups;
namespace pg8 {
#define PG8_LAS __attribute__((address_space(3)))
typedef unsigned short bf16_t;
typedef short bf16x8 __attribute__((ext_vector_type(8)));
typedef float f32x4 __attribute__((ext_vector_type(4)));
typedef unsigned u32x4 __attribute__((ext_vector_type(4)));
constexpr int BM = 256, BK = 64, HALF = 128, HTB = HALF * BK * 2  , STAGE_BYTES = 8 * HTB, NXCD = 8, WGM = 8;

__host__ __device__ __forceinline__ int lds_byte(int r, int c) { const int st = (r >> 4) * 2 + (c >> 5), rr = r & 15, cc = c & 31, ob = rr * 64 + cc * 2; return st * 1024 + (ob ^ (((ob >> 9) & 1) << 5)); }
__host__ __device__ __forceinline__ void stage_rc(int b, int& R, int& C) { const int st = b / 1024, sb = b % 1024, swz = sb ^ (((sb >> 9) & 1) << 5); R = (st >> 1) * 16 + swz / 64; C = (st & 1) * 32 + (swz % 64) / 2; }
__host__ __device__ __forceinline__ int perm32(int rho) { const int n = rho >> 4, i = rho & 15; return 8 * (i >> 2) + 4 * n + (i & 3); }

struct Unit { int pm, pn; };
struct Gemm { const bf16_t* A; const bf16_t* Bt; int M, N, K; };

struct StaticOrder {
    int nM, nN, nwg, G, c;
    __host__ __device__ void init(int M, int N, int G_, int c_) { nM = M / BM; nN = N / BM; nwg = nM * nN; G = G_; c = c_; }
    __host__ __device__ bool next(int i, Unit& u) const {
        const long L = (long)i * G + c; if (L >= nwg) return false;
        int wgid = (int)L; { const int q = nwg / NXCD, r = nwg % NXCD, xcd = wgid % NXCD, off = wgid / NXCD; wgid = (xcd < r ? xcd * (q + 1) : r * (q + 1) + (xcd - r) * q) + off; }
        const int nig = WGM * nN, gid = wgid / nig, fm = gid * WGM, gsz = (nM - fm) < WGM ? (nM - fm) : WGM;
        u.pm = fm + ((wgid % nig) % gsz); u.pn = (wgid % nig) / gsz; return true;
    }
    __device__ __forceinline__ void a_ready(const Unit&) const {}
    __device__ __forceinline__ void done(const Unit&) const {}
};
typedef unsigned u32x2 __attribute__((ext_vector_type(2)));
typedef __bf16 bf16x2_t __attribute__((ext_vector_type(2)));
typedef float f32x2_t __attribute__((ext_vector_type(2)));
__device__ __forceinline__ unsigned pk2(float lo, float hi) { f32x2_t v = {lo, hi}; bf16x2_t b = __builtin_convertvector(v, bf16x2_t); return __builtin_bit_cast(unsigned, b); }
__device__ __forceinline__ float silu_mul(float g, float u) { return g * __builtin_amdgcn_rcpf(1.0f + __expf(-g)) * u; }
struct EpiSwiGLU {
    static constexpr bool PERM = true, AFTER_DRAIN = false;
    bf16_t* H; int ldh;
    __device__ __forceinline__ void operator()(const f32x4 (&acc)[2][2][4][2], const Unit& u, int wr, int wc, int fr, int fq) const {
        const int row0 = u.pm * BM + wr * 64 + fr, col0 = u.pn * HALF + wc * 32 + 8 * fq;
#pragma unroll
        for (int ai = 0; ai < 2; ++ai)
#pragma unroll
            for (int m = 0; m < 4; ++m) { bf16_t* rowp = H + (size_t)(row0 + ai * HALF + m * 16) * ldh + col0;
                const f32x4 g0 = acc[ai][0][m][0], g1 = acc[ai][0][m][1], u0 = acc[ai][1][m][0], u1 = acc[ai][1][m][1];
                u32x4 w; w.x = pk2(silu_mul(g0[0], u0[0]), silu_mul(g0[1], u0[1])); w.y = pk2(silu_mul(g0[2], u0[2]), silu_mul(g0[3], u0[3]));
                w.z = pk2(silu_mul(g1[0], u1[0]), silu_mul(g1[1], u1[1])); w.w = pk2(silu_mul(g1[2], u1[2]), silu_mul(g1[3], u1[3]));
                *(u32x4*)rowp = w; }
    }
};
struct EpiResid {
    static constexpr bool PERM = false, AFTER_DRAIN = false;
    const float* base; float* out; int ldc; float alpha;
    __device__ __forceinline__ void operator()(const f32x4 (&acc)[2][2][4][2], const Unit& u, int wr, int wc, int fr, int fq) const {
        const int row0 = u.pm * BM + wr * 64 + fr, col0 = u.pn * BM + wc * 32 + 4 * fq;
#pragma unroll
        for (int ai = 0; ai < 2; ++ai)
#pragma unroll
            for (int m = 0; m < 4; ++m) { const size_t off = (size_t)(row0 + ai * HALF + m * 16) * ldc + col0;
#pragma unroll
                for (int bj = 0; bj < 2; ++bj)
#pragma unroll
                    for (int n = 0; n < 2; ++n) { const size_t o = off + bj * HALF + n * 16; const f32x4 b = *(const f32x4*)(base + o); *(f32x4*)(out + o) = b + alpha * acc[ai][bj][m][n]; }
                asm volatile("" ::: "memory"); }
    }
};
struct EpiF32 {
    static constexpr bool PERM = false, AFTER_DRAIN = false;
    float* C; int ldc;
    __device__ __forceinline__ void operator()(const f32x4 (&acc)[2][2][4][2], const Unit& u, int wr, int wc, int fr, int fq) const {
        const int row0 = u.pm * BM + wr * 64 + fr, col0 = u.pn * BM + wc * 32 + 4 * fq;
#pragma unroll
        for (int ai = 0; ai < 2; ++ai)
#pragma unroll
            for (int m = 0; m < 4; ++m) { float* rowp = C + (size_t)(row0 + ai * HALF + m * 16) * ldc + col0;
#pragma unroll
                for (int bj = 0; bj < 2; ++bj)
#pragma unroll
                    for (int n = 0; n < 2; ++n) *(f32x4*)(rowp + bj * HALF + n * 16) = acc[ai][bj][m][n]; }
    }
};
struct EpiBf16P {
    static constexpr bool PERM = true, AFTER_DRAIN = false;
    bf16_t* O; size_t ldc;
    __device__ __forceinline__ void operator()(const f32x4 (&acc)[2][2][4][2], const Unit& u, int wr, int wc, int fr, int fq) const {
        const int row0 = u.pm * BM + wr * 64 + fr, col0 = u.pn * BM + wc * 32 + 8 * fq;
#pragma unroll
        for (int ai = 0; ai < 2; ++ai)
#pragma unroll
            for (int m = 0; m < 4; ++m) { bf16_t* rowp = O + (size_t)(row0 + ai * HALF + m * 16) * ldc + col0;
#pragma unroll
                for (int bj = 0; bj < 2; ++bj) { const f32x4 v0 = acc[ai][bj][m][0], v1 = acc[ai][bj][m][1];
                    u32x4 w; w.x = pk2(v0[0], v0[1]); w.y = pk2(v0[2], v0[3]); w.z = pk2(v1[0], v1[1]); w.w = pk2(v1[2], v1[3]);
                    *(u32x4*)(rowp + bj * HALF) = w; } }
    }
};
struct EpiQ {
    static constexpr bool PERM = false, AFTER_DRAIN = false;
    bf16_t* Q; const f32x2_t* tab; float scale;
    __device__ __forceinline__ void operator()(const f32x4 (&acc)[2][2][4][2], const Unit& u, int wr, int wc, int fr, int fq) const {
        const int row0 = u.pm * BM + wr * 64 + fr, colb = u.pn * BM + wc * 32;
#pragma unroll
        for (int ai = 0; ai < 2; ++ai)
#pragma unroll
            for (int m = 0; m < 4; ++m) { const int row = row0 + ai * HALF + m * 16, pos = row & 4095;
#pragma unroll
                for (int bj = 0; bj < 2; ++bj) { const int cgp = colb + bj * HALF; const bool pe = ((cgp >> 5) % 3) == 2;
                    f32x4 a = acc[ai][bj][m][0], b = acc[ai][bj][m][1];
                    if (pe) {
#pragma unroll
                        for (int e = 0; e < 4; ++e) { const f32x2_t cs = tab[pos * 16 + 4 * fq + e]; const float x1 = a[e], x2 = b[e]; a[e] = x1 * cs.x - x2 * cs.y; b[e] = x1 * cs.y + x2 * cs.x; } }
                    a = a * scale; b = b * scale;
                    bf16_t* qp = Q + (size_t)row * 768 + cgp + 4 * fq;
                    u32x2 w0; w0.x = pk2(a[0], a[1]); w0.y = pk2(a[2], a[3]); *(u32x2*)qp = w0;
                    u32x2 w1; w1.x = pk2(b[0], b[1]); w1.y = pk2(b[2], b[3]); *(u32x2*)(qp + 16) = w1;
                    asm volatile("" ::: "memory"); } }
    }
};
template <class Epi, class Sched>
__device__ __forceinline__ void gemm_phase(PG8_LAS unsigned char* lds, const Gemm g, const Sched& S, const Epi& E) {
    const int tid = threadIdx.x, wid = __builtin_amdgcn_readfirstlane(tid >> 6), lane = tid & 63, wr = wid >> 2, wc = wid & 3, fr = lane & 15, fq = lane >> 4;
    const int K = g.K, nt = K / BK;
    unsigned voffA[2], voffB[2];
#pragma unroll
    for (int i = 0; i < 2; ++i) { int R, C; stage_rc(tid * 16 + i * 8192, R, C); const int Rb = Epi::PERM ? ((R & ~31) + perm32(R & 31)) : R;
        voffA[i] = (unsigned)(R * K + C) * 2u; voffB[i] = (unsigned)(Rb * K + C) * 2u; }
    const size_t kstep = (size_t)(BK * 2);
    const size_t hstep = (size_t)HALF * K * 2;
    const size_t tstep = 2 * hstep;
    const unsigned ldsw = (unsigned)wid * 1024u;
    const int aoff = lds_byte(wr * 64 + fr, fq * 8), boff = lds_byte(wc * 32 + fr, fq * 8);
#define PG8_SA(b, h) (((b) * 2 + (h)) * HTB)
#define PG8_SB(b, h) ((4 + (b) * 2 + (h)) * HTB)
#define PG8_STAGE(bufoff, gbase, voff) do { _Pragma("unroll") for (int _i = 0; _i < 2; ++_i) \
        __builtin_amdgcn_global_load_lds((const unsigned*)((const char*)(gbase) + (voff)[_i]), (PG8_LAS unsigned*)(lds + (bufoff) + ldsw + _i * 8192), 16, 0, 0); } while (0)
#define PG8_LDA(dst, b, h) do { _Pragma("unroll") for (int m = 0; m < 4; ++m) _Pragma("unroll") for (int k = 0; k < 2; ++k) dst[m][k] = *(const PG8_LAS bf16x8*)(lds + PG8_SA(b, h) + aoff + m * 2048 + k * 1024); } while (0)
#define PG8_LDB(dst, b, h) do { _Pragma("unroll") for (int n = 0; n < 2; ++n) _Pragma("unroll") for (int k = 0; k < 2; ++k) dst[n][k] = *(const PG8_LAS bf16x8*)(lds + PG8_SB(b, h) + boff + n * 2048 + k * 1024); } while (0)
#define PG8_MMA(ai, bj, At, Bt) do { __builtin_amdgcn_s_setprio(1); _Pragma("unroll") for (int m = 0; m < 4; ++m) _Pragma("unroll") for (int n = 0; n < 2; ++n) _Pragma("unroll") for (int k = 0; k < 2; ++k) \
        acc[ai][bj][m][n] = __builtin_amdgcn_mfma_f32_16x16x32_bf16(Bt[n][k], At[m][k], acc[ai][bj][m][n], 0, 0, 0); __builtin_amdgcn_s_setprio(0); } while (0)
#define PG8_WAIT_V(n) asm volatile("s_waitcnt vmcnt(" #n ")" ::: "memory")
#define PG8_WAIT_L(n) asm volatile("s_waitcnt lgkmcnt(" #n ")" ::: "memory")
#define PG8_BAR __builtin_amdgcn_s_barrier()
#define PG8_SCHED __builtin_amdgcn_sched_barrier(0)
    Unit cur, nxt; int ui = 0;
    if (!S.next(0, cur)) return;
    f32x4 acc[2][2][4][2];
#pragma unroll
    for (int a = 0; a < 2; ++a)
#pragma unroll
        for (int b = 0; b < 2; ++b)
#pragma unroll
            for (int m = 0; m < 4; ++m)
#pragma unroll
                for (int n = 0; n < 2; ++n) acc[a][b][m][n] = (f32x4){0.f, 0.f, 0.f, 0.f};
    bf16x8 At[4][2], B0[2][2], B1[2][2];
    const char* cA = (const char*)g.A + (size_t)cur.pm * tstep; const char* cB = (const char*)g.Bt + (size_t)cur.pn * tstep;
    S.a_ready(cur);
    PG8_STAGE(PG8_SB(0, 0), cB, voffB); PG8_STAGE(PG8_SA(0, 0), cA, voffA); PG8_STAGE(PG8_SB(0, 1), cB + hstep, voffB); PG8_STAGE(PG8_SA(0, 1), cA + hstep, voffA);
    if (wr == 1) PG8_BAR;
    PG8_WAIT_V(4); PG8_BAR;
    PG8_STAGE(PG8_SB(1, 0), cB + kstep, voffB); PG8_STAGE(PG8_SA(1, 0), cA + kstep, voffA); PG8_STAGE(PG8_SB(1, 1), cB + hstep + kstep, voffB);
    PG8_WAIT_V(6); PG8_BAR;
    for (;;) {
        const bool has_next = S.next(ui + 1, nxt);
        const char* nA = has_next ? (const char*)g.A + (size_t)nxt.pm * tstep : cA; const char* nB = has_next ? (const char*)g.Bt + (size_t)nxt.pn * tstep : cB;
        for (int t = 0; t < nt; t += 2) {
            const bool last = (t == nt - 2);
            const char* a1 = cA + (size_t)(t + 1) * kstep;
            const char* a2 = last ? nA : cA + (size_t)(t + 2) * kstep; const char* b2 = last ? nB : cB + (size_t)(t + 2) * kstep;
            const char* a3 = a2 + kstep; const char* b3 = b2 + kstep;
            if (last && has_next) S.a_ready(nxt);
            PG8_LDB(B0, 0, 0); PG8_SCHED; PG8_LDA(At, 0, 0); PG8_STAGE(PG8_SA(1, 1), a1 + hstep, voffA);
            PG8_WAIT_L(8); PG8_BAR; PG8_WAIT_L(0); PG8_MMA(0, 0, At, B0); PG8_BAR; PG8_SCHED;
            PG8_LDB(B1, 0, 1); PG8_STAGE(PG8_SB(0, 0), b2, voffB);
            PG8_BAR; PG8_WAIT_L(0); PG8_MMA(0, 1, At, B1); PG8_BAR;
            PG8_LDA(At, 0, 1); PG8_STAGE(PG8_SA(0, 0), a2, voffA);
            PG8_BAR; PG8_WAIT_L(0); PG8_MMA(1, 0, At, B0); PG8_BAR; PG8_SCHED;
            PG8_STAGE(PG8_SB(0, 1), b2 + hstep, voffB);
            PG8_WAIT_V(6); PG8_BAR; PG8_MMA(1, 1, At, B1); PG8_BAR;
            PG8_LDB(B0, 1, 0); PG8_SCHED; PG8_LDA(At, 1, 0); PG8_STAGE(PG8_SA(0, 1), a2 + hstep, voffA);
            PG8_WAIT_L(8); PG8_BAR; PG8_WAIT_L(0); PG8_MMA(0, 0, At, B0); PG8_BAR; PG8_SCHED;
            PG8_LDB(B1, 1, 1); PG8_STAGE(PG8_SB(1, 0), b3, voffB);
            PG8_BAR; PG8_WAIT_L(0); PG8_MMA(0, 1, At, B1); PG8_BAR;
            PG8_LDA(At, 1, 1); PG8_STAGE(PG8_SA(1, 0), a3, voffA);
            PG8_BAR; PG8_WAIT_L(0); PG8_MMA(1, 0, At, B0); PG8_BAR; PG8_SCHED;
            PG8_STAGE(PG8_SB(1, 1), b3 + hstep, voffB);
            PG8_WAIT_V(6); PG8_BAR; PG8_MMA(1, 1, At, B1); PG8_BAR;
        }
        if constexpr (!Epi::AFTER_DRAIN) { E(acc, cur, wr, wc, fr, fq); S.done(cur); }
        if (!has_next) break;
#pragma unroll
        for (int a = 0; a < 2; ++a)
#pragma unroll
            for (int b = 0; b < 2; ++b)
#pragma unroll
                for (int m = 0; m < 4; ++m)
#pragma unroll
                    for (int n = 0; n < 2; ++n) acc[a][b][m][n] = (f32x4){0.f, 0.f, 0.f, 0.f};
        cur = nxt; cA = nA; cB = nB; ++ui;
    }
    PG8_WAIT_V(0);
    if (wr == 0) PG8_BAR;
    PG8_BAR;
    if constexpr (Epi::AFTER_DRAIN) { E.fused(acc, cur, wr, wc, fr, fq, lds, wid, lane); S.done(cur); }
#undef PG8_SA
#undef PG8_SB
#undef PG8_STAGE
#undef PG8_LDA
#undef PG8_LDB
#undef PG8_MMA
#undef PG8_WAIT_V
#undef PG8_WAIT_L
#undef PG8_BAR
#undef PG8_SCHED
}
}

#define LAS __attribute__((address_space(3)))
using pg8::bf16_t; using pg8::bf16x8; using pg8::f32x4; using pg8::u32x4; using pg8::u32x2; using pg8::f32x2_t; using pg8::pk2;
typedef float f32x16 __attribute__((ext_vector_type(16)));
constexpr int MTOK = 32768, DM = 1024, FFH = 2816, SEQ = 4096, NB = 8;
constexpr float EPSN = 1e-6f;
constexpr size_t MiB = 1u << 20;
constexpr size_t WS_CTL = 0, WS_BAR = 16384, CTL_ZERO = 32768;
constexpr size_t WS_W1GU = 2 * MiB, WS_W1D = 13 * MiB, WS_W2GU = 19 * MiB, WS_W2D = 30 * MiB;
constexpr size_t WS_WINA = 36 * MiB, WS_WINB = 37 * MiB, WS_WUQ = 40 * MiB, WS_WUK = 41 * MiB, WS_WUV = 41 * MiB + 512 * 1024, WS_WOUT = 42 * MiB;
constexpr size_t WS_ROPE = 44 * MiB, WS_FILT = 46 * MiB, WS_XN = 80 * MiB, WS_H = 144 * MiB;
constexpr size_t WS_UA = 144 * MiB, WS_UT = 208 * MiB, WS_KPE = 304 * MiB;
constexpr size_t WS_CQN = 320 * MiB, WS_CKVN = 336 * MiB, WS_Q = 352 * MiB  , WS_KN = 448 * MiB, WS_VT = 480 * MiB, WS_HYT = WS_UA  , WS_END = 512 * MiB;
constexpr size_t WS_MIXN = WS_XN;
constexpr int LDS_BYTES = 147456;
constexpr int NPHASE = 14;

__device__ __forceinline__ float wave_sum(float v) {
#pragma unroll
    for (int o = 1; o < 64; o <<= 1) v += __shfl_xor(v, o);
    return v;
}
__device__ __forceinline__ float bf2f(unsigned short b) { return __uint_as_float(((unsigned)b) << 16); }
__device__ __forceinline__ f32x16 mfma32(bf16x8 a, bf16x8 b, f32x16 c) { return __builtin_amdgcn_mfma_f32_32x32x16_bf16(a, b, c, 0, 0, 0); }
__device__ __forceinline__ void sincos_rr(float x, float& sn, float& cs) {
    const float n = rintf(x * 0.15915494309189535f);
    float r = fmaf(-n, 6.2831854820251465f, x); r = fmaf(-n, -1.7484555314695172e-7f, r);
    sn = __sinf(r); cs = __cosf(r);
}
#define LDS_WAIT() asm volatile("s_waitcnt lgkmcnt(0)" ::: "memory")

struct Params { const float* in[27]; float* out; unsigned char* ws; int ph_lo, ph_hi; };

__device__ __forceinline__ void tr_item(const float* src, int ldsrc, int scol0, int k0, bool valid, bf16_t* dst, int lddst, int drow0, LAS float* scr, int lane) {
    if (valid) {
#pragma unroll 8
        for (int i = 0; i < 32; ++i) { const int kk = 2 * i + (lane >> 5); scr[kk * 33 + (lane & 31)] = src[(size_t)(k0 + kk) * ldsrc + scol0 + (lane & 31)]; }
    } else {
#pragma unroll 8
        for (int i = 0; i < 32; ++i) { const int kk = 2 * i + (lane >> 5); scr[kk * 33 + (lane & 31)] = 0.f; }
    }
    LDS_WAIT();
    const int c = lane & 7;
#pragma unroll
    for (int j = 0; j < 4; ++j) { const int n = (lane >> 3) + 8 * j; const LAS float* s = scr + (8 * c) * 33 + n;
        u32x4 o; o.x = pk2(s[0 * 33], s[1 * 33]); o.y = pk2(s[2 * 33], s[3 * 33]); o.z = pk2(s[4 * 33], s[5 * 33]); o.w = pk2(s[6 * 33], s[7 * 33]);
        *(u32x4*)(dst + (size_t)(drow0 + n) * lddst + k0 + 8 * c) = o; }
    LDS_WAIT();
}

__device__ __forceinline__ void rms_row_bf16(const float* xrow, const float* g, bf16_t* orow, int lane) {
    const f32x4* xr = (const f32x4*)xrow + lane; const f32x4* gr = (const f32x4*)g + lane;
    f32x4 v[4]; float s = 0.f;
#pragma unroll
    for (int j = 0; j < 4; ++j) { v[j] = xr[64 * j]; s += (v[j].x * v[j].x + v[j].y * v[j].y) + (v[j].z * v[j].z + v[j].w * v[j].w); }
    const float rstd = 1.0f / sqrtf(wave_sum(s) * (1.0f / DM) + EPSN);
    u32x2* o8 = (u32x2*)orow + lane;
#pragma unroll
    for (int j = 0; j < 4; ++j) { const f32x4 gv = gr[64 * j]; u32x2 w; w.x = pk2(v[j].x * rstd * gv.x, v[j].y * rstd * gv.y); w.y = pk2(v[j].z * rstd * gv.z, v[j].w * rstd * gv.w); o8[64 * j] = w; }
}

__device__ __forceinline__ void filter_block(const Params& p, LAS unsigned char* lds, int pb, int tid) {
    LAS float* z = (LAS float*)(lds + 131072); LAS float* h1 = z + 528; LAS float* h2 = h1 + 1024;
    const float *w1 = p.in[13], *b1 = p.in[14], *w2 = p.in[15], *b2 = p.in[16], *w3 = p.in[17], *fr = p.in[18];
    float* FILT = (float*)(p.ws + WS_FILT); float* NORM = (float*)(p.ws + WS_CTL);
    for (int idx = tid; idx < 528; idx += 512) { const int pp = idx / 33, e = idx - pp * 33; const float t = (float)(pb * 16 + pp);
        float v;
        if (e == 0) v = t / 4095.0f;
        else { const int j = (e - 1) & 15; const float band = 1e-4f + (float)j * ((15.0f - 1e-4f) / 15.0f); const float ang = (6.283185307179586f * t / 4096.0f) * band; float sn, cs; sincos_rr(ang, sn, cs); v = (e <= 16) ? cs : -sn; }
        z[idx] = v; }
    __syncthreads();
    for (int idx = tid; idx < 1024; idx += 512) { const int pp = idx >> 6, j = idx & 63; float a = b1[j];
#pragma unroll 3
        for (int e = 0; e < 33; ++e) a += z[pp * 33 + e] * w1[e * 64 + j];
        float sn, cs; sincos_rr(fr[j] * a, sn, cs); h1[idx] = sn; }
    __syncthreads();
    for (int idx = tid; idx < 1024; idx += 512) { const int pp = idx >> 6, j = idx & 63; float a = b2[j];
#pragma unroll 4
        for (int i = 0; i < 64; ++i) a += h1[pp * 64 + i] * w2[i * 64 + j];
        float sn, cs; sincos_rr(fr[j] * a, sn, cs); h2[idx] = sn; }
    __syncthreads();
    const float dmin = 3.0701134573253945f, dmax = 15.350567286626973f;
#pragma unroll 1
    for (int m = 0; m < 4; ++m) { const int q = tid + 512 * m;
        float acc[16];
#pragma unroll
        for (int pp = 0; pp < 16; ++pp) acc[pp] = 0.f;
#pragma unroll 2
        for (int i = 0; i < 64; ++i) { const float w = w3[i * 2048 + q];
#pragma unroll
            for (int pp = 0; pp < 16; ++pp) acc[pp] += h2[pp * 64 + i] * w; }
        const int o = q >> 10, dir = (q >> 9) & 1, c = q & 511; const float delta = dmin + (float)c * ((dmax - dmin) / 511.0f);
        float sabs = 0.f;
#pragma unroll
        for (int pp = 0; pp < 16; ++pp) { const int t = pb * 16 + pp; const float v = acc[pp] * __expf(-((float)t / 4095.0f) * delta); acc[pp] = v; if (!(dir == 1 && t == 0)) sabs += fabsf(v); }
        float* dst = FILT + ((size_t)((o * 2 + dir) * 512 + c)) * 4096 + pb * 16;
#pragma unroll
        for (int k = 0; k < 4; ++k) *(f32x4*)(dst + 4 * k) = (f32x4){acc[4 * k], acc[4 * k + 1], acc[4 * k + 2], acc[4 * k + 3]};
        atomicAdd(&NORM[o * 512 + c], sabs); }
    __syncthreads();
}

constexpr int KL_STRIDE = 208, VL_STRIDE = 144, KL_BYTES = 64 * KL_STRIDE, VL_BYTES = 64 * VL_STRIDE, ATT_BUF = KL_BYTES + VL_BYTES;
__device__ __forceinline__ bf16x8 pack8(const f32x16& x, int s) {
    u32x4 p; p.x = pk2(x[8 * s], x[8 * s + 1]); p.y = pk2(x[8 * s + 2], x[8 * s + 3]); p.z = pk2(x[8 * s + 4], x[8 * s + 5]); p.w = pk2(x[8 * s + 6], x[8 * s + 7]);
    return __builtin_bit_cast(bf16x8, p);
}
__device__ __forceinline__ void attn_unit(const Params& p, LAS unsigned char* lds, int unit, int tid, int lane, int wave) {
    const int bh = unit >> 4, qb = unit & 15, b = bh >> 3, h = bh & 7, r = lane & 31, hh = lane >> 5;
    const float* Q = (const float*)(p.ws + WS_Q); const bf16_t* KN = (const bf16_t*)(p.ws + WS_KN); const bf16_t* KPE = (const bf16_t*)(p.ws + WS_KPE); const bf16_t* VT = (const bf16_t*)(p.ws + WS_VT);
    bf16_t* MIXN = (bf16_t*)(p.ws + WS_MIXN);
    const size_t tok0 = (size_t)b * SEQ, qrow = tok0 + qb * 256 + wave * 32 + r;
    bf16x8 qf[6];
    { const float QS = 0.14724352f;
      const float* qp = Q + qrow * 768 + 96 * h + 8 * hh;
#pragma unroll
      for (int ks = 0; ks < 4; ++ks) { const f32x4 a = *(const f32x4*)(qp + 16 * ks), b = *(const f32x4*)(qp + 16 * ks + 4);
          u32x4 w; w.x = pk2(a.x * QS, a.y * QS); w.y = pk2(a.z * QS, a.w * QS); w.z = pk2(b.x * QS, b.y * QS); w.w = pk2(b.z * QS, b.w * QS); qf[ks] = __builtin_bit_cast(bf16x8, w); }
      const f32x2_t* tab = (const f32x2_t*)(p.ws + WS_ROPE) + (size_t)((int)(qrow & 4095)) * 16 + 8 * hh;
      float x1[8], x2[8];
      { const f32x4 a = *(const f32x4*)(qp + 64), b = *(const f32x4*)(qp + 68), c = *(const f32x4*)(qp + 80), d = *(const f32x4*)(qp + 84);
        x1[0] = a.x; x1[1] = a.y; x1[2] = a.z; x1[3] = a.w; x1[4] = b.x; x1[5] = b.y; x1[6] = b.z; x1[7] = b.w;
        x2[0] = c.x; x2[1] = c.y; x2[2] = c.z; x2[3] = c.w; x2[4] = d.x; x2[5] = d.y; x2[6] = d.z; x2[7] = d.w; }
      float y1[8], y2[8];
#pragma unroll
      for (int j = 0; j < 8; ++j) { const f32x2_t cs = tab[j]; y1[j] = (x1[j] * cs.x - x2[j] * cs.y) * QS; y2[j] = (x1[j] * cs.y + x2[j] * cs.x) * QS; }
      u32x4 w; w.x = pk2(y1[0], y1[1]); w.y = pk2(y1[2], y1[3]); w.z = pk2(y1[4], y1[5]); w.w = pk2(y1[6], y1[7]); qf[4] = __builtin_bit_cast(bf16x8, w);
      w.x = pk2(y2[0], y2[1]); w.y = pk2(y2[2], y2[3]); w.z = pk2(y2[4], y2[5]); w.w = pk2(y2[6], y2[7]); qf[5] = __builtin_bit_cast(bf16x8, w); }
    const int kc1 = tid + 512; const bool has1 = tid < 256;
    const int key0 = tid / 12, part0 = tid - key0 * 12, key1 = kc1 / 12, part1 = kc1 - key1 * 12;
    const bf16_t* ks0 = part0 < 8 ? KN + (tok0 + key0) * 512 + 64 * h + 8 * part0 : KPE + (tok0 + key0) * 32 + 8 * (part0 - 8);
    const bf16_t* ks1 = part1 < 8 ? KN + (tok0 + key1) * 512 + 64 * h + 8 * part1 : KPE + (tok0 + key1) * 32 + 8 * (part1 - 8);
    const int kst0 = part0 < 8 ? 64 * 512 : 64 * 32, kst1 = part1 < 8 ? 64 * 512 : 64 * 32;
    const bf16_t* vs = VT + (size_t)(64 * h + (tid >> 3)) * MTOK + tok0 + 8 * (tid & 7);
    const int kd0 = key0 * KL_STRIDE + part0 * 16, kd1 = key1 * KL_STRIDE + part1 * 16, vd = KL_BYTES + (tid >> 3) * VL_STRIDE + (tid & 7) * 16;
    u32x4 rk0, rk1 = (u32x4){0u, 0u, 0u, 0u}, rv;
    rk0 = *(const u32x4*)ks0; if (has1) rk1 = *(const u32x4*)ks1; rv = *(const u32x4*)vs;
    *(LAS u32x4*)(lds + kd0) = rk0; if (has1) *(LAS u32x4*)(lds + kd1) = rk1; *(LAS u32x4*)(lds + vd) = rv;
    __syncthreads();
    f32x16 o0, o1;
#pragma unroll
    for (int i = 0; i < 16; ++i) { o0[i] = 0.f; o1[i] = 0.f; }
    float lsum = 0.f;
    for (int kt = 0; kt < 64; ++kt) {
        const int buf = kt & 1; const bool more = kt + 1 < 64;
        if (more) { rk0 = *(const u32x4*)(ks0 + (size_t)(kt + 1) * kst0); if (has1) rk1 = *(const u32x4*)(ks1 + (size_t)(kt + 1) * kst1); rv = *(const u32x4*)(vs + (kt + 1) * 64); }
        const LAS unsigned char* KLb = lds + buf * ATT_BUF; const LAS unsigned char* VLb = KLb + KL_BYTES;
        f32x16 s0, s1;
#pragma unroll
        for (int i = 0; i < 16; ++i) { s0[i] = 0.f; s1[i] = 0.f; }
#pragma unroll
        for (int ks = 0; ks < 6; ++ks) {
            const bf16x8 ka = *(const LAS bf16x8*)(KLb + r * KL_STRIDE + 32 * ks + 16 * hh);
            const bf16x8 kb = *(const LAS bf16x8*)(KLb + (32 + r) * KL_STRIDE + 32 * ks + 16 * hh);
            s0 = mfma32(ka, qf[ks], s0); s1 = mfma32(kb, qf[ks], s1); }
#pragma unroll
        for (int i = 0; i < 16; ++i) { s0[i] = __builtin_amdgcn_exp2f(s0[i]); s1[i] = __builtin_amdgcn_exp2f(s1[i]); lsum += s0[i] + s1[i]; }
        bf16x8 pf[2][2];
        pf[0][0] = pack8(s0, 0); pf[0][1] = pack8(s0, 1); pf[1][0] = pack8(s1, 0); pf[1][1] = pack8(s1, 1);
#pragma unroll
        for (int sub = 0; sub < 2; ++sub)
#pragma unroll
            for (int s = 0; s < 2; ++s) {
                const LAS unsigned char* vp = VLb + r * VL_STRIDE + (32 * sub + 16 * s + 4 * hh) * 2;
                const u32x2 lo0 = *(const LAS u32x2*)vp, hi0 = *(const LAS u32x2*)(vp + 16);
                const u32x2 lo1 = *(const LAS u32x2*)(vp + 32 * VL_STRIDE), hi1 = *(const LAS u32x2*)(vp + 32 * VL_STRIDE + 16);
                const bf16x8 va0 = __builtin_bit_cast(bf16x8, ((u32x4){lo0.x, lo0.y, hi0.x, hi0.y}));
                const bf16x8 va1 = __builtin_bit_cast(bf16x8, ((u32x4){lo1.x, lo1.y, hi1.x, hi1.y}));
                o0 = mfma32(va0, pf[sub][s], o0); o1 = mfma32(va1, pf[sub][s], o1); }
        if (more) { LAS unsigned char* nb = lds + (buf ^ 1) * ATT_BUF; *(LAS u32x4*)(nb + kd0) = rk0; if (has1) *(LAS u32x4*)(nb + kd1) = rk1; *(LAS u32x4*)(nb + vd) = rv; }
        __syncthreads();
    }
    const float l = lsum + __shfl_xor(lsum, 32); const float inv = 1.0f / l;
    float ss = 0.f;
#pragma unroll
    for (int i = 0; i < 16; ++i) { o0[i] *= inv; o1[i] *= inv; ss += o0[i] * o0[i] + o1[i] * o1[i]; }
    ss += __shfl_xor(ss, 32);
    const float rstd = 1.0f / sqrtf(ss * (1.0f / 64.0f) + EPSN);
    const float* hg = p.in[20] + 64 * h;
#pragma unroll
    for (int g = 0; g < 4; ++g) {
        const int dv0 = 8 * g + 4 * hh, dv1 = 32 + dv0;
        const f32x4 g0 = *(const f32x4*)(hg + dv0), g1 = *(const f32x4*)(hg + dv1);
        u32x2 w0, w1;
        w0.x = pk2(o0[4 * g] * rstd * g0.x, o0[4 * g + 1] * rstd * g0.y); w0.y = pk2(o0[4 * g + 2] * rstd * g0.z, o0[4 * g + 3] * rstd * g0.w);
        w1.x = pk2(o1[4 * g] * rstd * g1.x, o1[4 * g + 1] * rstd * g1.y); w1.y = pk2(o1[4 * g + 2] * rstd * g1.z, o1[4 * g + 3] * rstd * g1.w);
        *(u32x2*)(MIXN + qrow * 1024 + 64 * h + dv0) = w0; *(u32x2*)(MIXN + qrow * 1024 + 64 * h + dv1) = w1; }
}

constexpr int UT_STRIDE = 8192 + 32, UTL_BYTES = 8 * UT_STRIDE, RL_OFF = UTL_BYTES;
typedef short bf16x8_u __attribute__((ext_vector_type(8), aligned(2)));
__device__ __forceinline__ void hy_load_filter(const Params& p, LAS unsigned char* lds, int o, int c, int tid) {
    LAS bf16_t* RL = (LAS bf16_t*)(lds + RL_OFF);
    const float* FILT = (const float*)(p.ws + WS_FILT); const float* NORM = (const float*)(p.ws + WS_CTL);
    const float invn = 1.0f / NORM[o * 512 + c];
    const float* hf = FILT + (size_t)((o * 2 + 0) * 512 + c) * 4096; const float* hb = FILT + (size_t)((o * 2 + 1) * 512 + c) * 4096;
    for (int i = tid; i < 8192; i += 512) { float v = 0.f; if (i <= 4095) v = hf[4095 - i] * invn; else if (i < 8191) v = hb[i - 4095] * invn;
        RL[i] = (bf16_t)(pk2(v, 0.f) & 0xffffu); }
}
__device__ __forceinline__ void hy_conv(LAS unsigned char* lds, f32x16 (&acc)[2][2], int lane, int wave) {
    const LAS bf16_t* RL = (const LAS bf16_t*)(lds + RL_OFF);
    const int r = lane & 31, hh = lane >> 5, bb = r & 7, t1o = r >> 3;
#pragma unroll
    for (int a = 0; a < 2; ++a)
#pragma unroll
        for (int b = 0; b < 2; ++b)
#pragma unroll
            for (int i = 0; i < 16; ++i) acc[a][b][i] = 0.f;
    const LAS unsigned char* ub = lds + bb * UT_STRIDE + 16 * hh;
    for (int q = 0; q < 71; ++q) {
        const int d1 = 8 * wave - 63 + q;
        bf16x8 A[2][4], B[2][4];
        const int e0 = 4095 + 8 * hh - r - 64 * d1;
#pragma unroll
        for (int mt = 0; mt < 2; ++mt)
#pragma unroll
            for (int ks = 0; ks < 4; ++ks) { const bf16x8_u w = *(const LAS bf16x8_u*)(RL + e0 + 16 * ks - 32 * mt); A[mt][ks] = w; }
#pragma unroll
        for (int nt = 0; nt < 2; ++nt) { const int s1 = 8 * wave + 4 * nt + t1o - d1; const bool valid = (unsigned)s1 < 64u; const int s1c = valid ? s1 : 0;
#pragma unroll
            for (int ks = 0; ks < 4; ++ks) { bf16x8 v = *(const LAS bf16x8*)(ub + s1c * 128 + 32 * ks); if (!valid) v = (bf16x8){0, 0, 0, 0, 0, 0, 0, 0}; B[nt][ks] = v; } }
#pragma unroll
        for (int ks = 0; ks < 4; ++ks)
#pragma unroll
            for (int mt = 0; mt < 2; ++mt)
#pragma unroll
                for (int nt = 0; nt < 2; ++nt) acc[mt][nt] = mfma32(A[mt][ks], B[nt][ks], acc[mt][nt]);
    }
}
__device__ __forceinline__ void hy_epi(const Params& p, LAS unsigned char* lds, const f32x16 (&acc)[2][2], int o, int c, int lane, int wave) {
    const int r = lane & 31, hh = lane >> 5, bb = r & 7, t1o = r >> 3;
    const bf16_t* UTg = (const bf16_t*)(p.ws + WS_UT); bf16_t* HYT = (bf16_t*)(p.ws + WS_HYT);
    const int gc = 512 * (o + 1) + c;
    const float* cw = p.in[11]; const float w0 = cw[gc], w1 = cw[1536 + gc], w2 = cw[3072 + gc], cbv = p.in[12][gc], dsk = p.in[19][o * 512 + c];
    const bf16_t* gx = UTg + (size_t)gc * MTOK + bb * SEQ;
#pragma unroll
    for (int mt = 0; mt < 2; ++mt)
#pragma unroll
        for (int nt = 0; nt < 2; ++nt)
#pragma unroll
            for (int g = 0; g < 4; ++g) {
                const int t = 64 * (8 * wave + 4 * nt + t1o) + 32 * mt + 8 * g + 4 * hh;
                const u32x2 xr = *(const u32x2*)(gx + t);
                float xv[6];
                xv[0] = t > 0 ? bf2f(gx[t - 1]) : 0.f; xv[5] = t + 4 < SEQ ? bf2f(gx[t + 4]) : 0.f;
                xv[1] = __uint_as_float(xr.x << 16); xv[2] = __uint_as_float(xr.x & 0xffff0000u); xv[3] = __uint_as_float(xr.y << 16); xv[4] = __uint_as_float(xr.y & 0xffff0000u);
                LAS unsigned char* up = lds + bb * UT_STRIDE + t * 2;
                const u32x2 ur = *(const LAS u32x2*)up;
                float uv[4]; uv[0] = __uint_as_float(ur.x << 16); uv[1] = __uint_as_float(ur.x & 0xffff0000u); uv[2] = __uint_as_float(ur.y << 16); uv[3] = __uint_as_float(ur.y & 0xffff0000u);
                float res[4];
#pragma unroll
                for (int j = 0; j < 4; ++j) { const float gate = cbv + w0 * xv[j] + w1 * xv[j + 1] + w2 * xv[j + 2]; res[j] = (acc[mt][nt][4 * g + j] + uv[j] * dsk) * gate; }
                u32x2 w; w.x = pk2(res[0], res[1]); w.y = pk2(res[2], res[3]);
                if (o == 0) *(LAS u32x2*)up = w; else *(u32x2*)(HYT + (size_t)c * MTOK + bb * SEQ + t) = w;
            }
}
__device__ __forceinline__ void hyena_channel(const Params& p, LAS unsigned char* lds, int c, int tid, int lane, int wave) {
    const bf16_t* UTg = (const bf16_t*)(p.ws + WS_UT);
    { const float* cw = p.in[11]; const float w0 = cw[c], w1 = cw[1536 + c], w2 = cw[3072 + c], cbv = p.in[12][c];
      for (int i = 0; i < 8; ++i) { const int ch = tid + 512 * i, b = ch >> 9, s0 = (ch & 511) * 8;
          const bf16_t* src = UTg + (size_t)c * MTOK + b * SEQ + s0;
          const u32x4 raw = *(const u32x4*)src;
          float f[10];
          f[0] = s0 > 0 ? bf2f(src[-1]) : 0.f; f[9] = s0 + 8 < SEQ ? bf2f(src[8]) : 0.f;
          f[1] = __uint_as_float(raw.x << 16); f[2] = __uint_as_float(raw.x & 0xffff0000u); f[3] = __uint_as_float(raw.y << 16); f[4] = __uint_as_float(raw.y & 0xffff0000u);
          f[5] = __uint_as_float(raw.z << 16); f[6] = __uint_as_float(raw.z & 0xffff0000u); f[7] = __uint_as_float(raw.w << 16); f[8] = __uint_as_float(raw.w & 0xffff0000u);
          float v[8];
#pragma unroll
          for (int j = 0; j < 8; ++j) v[j] = cbv + w0 * f[j] + w1 * f[j + 1] + w2 * f[j + 2];
          u32x4 w; w.x = pk2(v[0], v[1]); w.y = pk2(v[2], v[3]); w.z = pk2(v[4], v[5]); w.w = pk2(v[6], v[7]);
          *(LAS u32x4*)(lds + b * UT_STRIDE + s0 * 2) = w; } }
    hy_load_filter(p, lds, 0, c, tid);
    __syncthreads();
    f32x16 acc[2][2];
    hy_conv(lds, acc, lane, wave);
    __syncthreads();
    hy_epi(p, lds, acc, 0, c, lane, wave);
    hy_load_filter(p, lds, 1, c, tid);
    __syncthreads();
    hy_conv(lds, acc, lane, wave);
    hy_epi(p, lds, acc, 1, c, lane, wave);
    __syncthreads();
}

#define XB_TMO      128
#define XB_XCNT(j)  (256  + 64 * (j))
#define XB_XSUB(j)  (1280 + 64 * (j))
#define XB_XGEN(j)  (2304 + 64 * (j))
#define XB_TOP      3328
#define XB_TOPGEN   3392
#define XCD_BAR_WORDS 3456
#define XB_SPIN_CAP (1u << 18)

__device__ __forceinline__ unsigned xb_ld(unsigned* p)              { return __hip_atomic_load(p, __ATOMIC_RELAXED, __HIP_MEMORY_SCOPE_AGENT); }
__device__ __forceinline__ unsigned xb_add(unsigned* p, unsigned v) { return __hip_atomic_fetch_add(p, v, __ATOMIC_RELAXED, __HIP_MEMORY_SCOPE_AGENT); }
__device__ __forceinline__ unsigned xb_xcc_id() { return (unsigned)__builtin_amdgcn_s_getreg((3 << 11) | 20) & 0xFu; }
#define XB_SPIN(cond, bar) do { unsigned _sp = 0; while (cond) { __builtin_amdgcn_s_sleep(1); \
    if ((++_sp & 255u) == 0u) { if (xb_ld(&(bar)[XB_TMO])) break; if (_sp > XB_SPIN_CAP) { atomicAdd(&(bar)[XB_TMO], 1u); break; } } } } while (0)

struct XcdBarrier {
    unsigned* bar; unsigned x;
    volatile LAS unsigned* st;
};

__device__ __forceinline__ XcdBarrier xcd_barrier_post(unsigned* bar, volatile LAS unsigned* st) {
    XcdBarrier b; b.bar = bar; b.x = xb_xcc_id(); b.st = st;
    if (threadIdx.x == 0) (void)xb_add(&bar[XB_XCNT(b.x)], 1u);
    return b;
}
__device__ __forceinline__ void xcd_barrier_complete(unsigned* bar, unsigned x, unsigned& nloc, unsigned& nx) {
    const unsigned G = gridDim.x * gridDim.y * gridDim.z;
    unsigned sum, cnt, mine, sp = 0u;
    for (;;) {
        sum = 0u; cnt = 0u; mine = 0u;
#pragma unroll
        for (unsigned j = 0; j < 16; ++j) { const unsigned c = xb_ld(&bar[XB_XCNT(j)]); sum += c; cnt += (c > 0u) ? 1u : 0u; mine = (j == x) ? c : mine; }
        if (sum == G) break;
        __builtin_amdgcn_s_sleep(1);
        if ((++sp & 255u) == 0u) { if (xb_ld(&bar[XB_TMO])) break; if (sp > XB_SPIN_CAP) { atomicAdd(&bar[XB_TMO], 1u); break; } }
    }
    nloc = mine > 0u ? mine : 1u; nx = cnt > 0u ? cnt : 1u;
}

__device__ __forceinline__ void xcd_barrier(const XcdBarrier& b) {
    asm volatile("s_waitcnt vmcnt(0)" ::: "memory");
    __syncthreads();
    if (threadIdx.x == 0) {
        unsigned* bar = b.bar;
        __builtin_amdgcn_s_waitcnt(0);
        unsigned nloc = b.st[0], nx = b.st[1];
        if (nloc == 0u) { xcd_barrier_complete(bar, b.x, nloc, nx); b.st[0] = nloc; b.st[1] = nx; }
        const unsigned old = xb_add(&bar[XB_XSUB(b.x)], 1u);
        const unsigned gen = old / nloc;
        if (old + 1u == (gen + 1u) * nloc) {
            __builtin_amdgcn_fence(__ATOMIC_RELEASE, "agent");
            asm volatile("s_waitcnt vmcnt(0)" ::: "memory");
            const unsigned og = xb_add(&bar[XB_TOP], 1u);
            const unsigned tg = og / nx;
            if (og + 1u == (tg + 1u) * nx) xb_add(&bar[XB_TOPGEN], 1u);
            else XB_SPIN(xb_ld(&bar[XB_TOPGEN]) == tg, bar);
            __builtin_amdgcn_fence(__ATOMIC_ACQUIRE, "agent");
            xb_add(&bar[XB_XGEN(b.x)], 1u);
            asm volatile("s_waitcnt vmcnt(0)" ::: "memory");
        } else {
            XB_SPIN(xb_ld(&bar[XB_XGEN(b.x)]) == gen, bar);
            __builtin_amdgcn_fence(__ATOMIC_ACQUIRE, "agent");
            asm volatile("s_waitcnt vmcnt(0)" ::: "memory");
        }
    }
    __syncthreads();
}

__global__ void __launch_bounds__(512) fwd_megakernel(Params p) {
    extern __shared__ __attribute__((aligned(16))) unsigned char lds_raw[];
    LAS unsigned char* lds = (LAS unsigned char*)lds_raw;
    cg::grid_group grid = cg::this_grid();
    const int tid = threadIdx.x, lane = tid & 63, wave = __builtin_amdgcn_readfirstlane(tid >> 6);
    const int G = gridDim.x, bx = blockIdx.x;
    const int vcu = (G % 8 == 0) ? (bx % 8) * (G / 8) + bx / 8 : bx;
    const int gw = vcu * 8 + wave, NGW = G * 8;
    unsigned char* ws = p.ws;
    const int lo = p.ph_lo, hi = p.ph_hi;
    volatile LAS unsigned* bst = (volatile LAS unsigned*)(lds + LDS_BYTES - 64);
    if (tid < 2) bst[tid] = 0u;
    __syncthreads();
    const XcdBarrier xbar = xcd_barrier_post((unsigned*)(ws + WS_BAR), bst);
#ifndef P0SEL
#define P0SEL 15
#endif
#ifndef REPMASK
#define REPMASK 0
#endif
#define NREP(k) ((((REPMASK) >> (k)) & 1) ? 2 : 1)
#ifndef P6SEL
#define P6SEL 7
#endif
#ifndef PHMASK
#define PHMASK 0xffff
#endif
#define IN(k) (((PHMASK >> (k)) & 1) && lo <= (k) && (k) < hi)
#define SEAM(k) do { if (IN(k) && IN((k) + 1)) { if ((k) == 0) grid.sync(); else xcd_barrier(xbar); if ((REPMASK >> 15) & 1) xcd_barrier(xbar); } } while (0)
    bf16_t* XN = (bf16_t*)(ws + WS_XN); bf16_t* HB = (bf16_t*)(ws + WS_H);

    if (IN(0)) {
        LAS float* scr = (LAS float*)(lds + wave * 16384);
        constexpr int I_GU = 16 * 176, I_D = 44 * 32, I_INA = 16 * 16, I_INB = 16 * 48, I_UQ = 4 * 24, I_UK = 4 * 16, I_OUT = 16 * 32;
        constexpr int NITEMS = 2 * (I_GU + I_D) + I_INA + I_INB + I_UQ + 2 * I_UK + I_OUT;
        for (int rep = 0; rep < NREP(0); ++rep) if (P0SEL & 1) for (int it = gw; it < NITEMS; it += NGW) {
            int r = it;
            bool done = false;
#pragma unroll
            for (int f = 0; f < 2; ++f) {
                if (done) break;
                const float* wg = p.in[f ? 23 : 2]; const float* wu = p.in[f ? 24 : 3]; const float* wd = p.in[f ? 25 : 4];
                bf16_t* GU = (bf16_t*)(ws + (f ? WS_W2GU : WS_W1GU)); bf16_t* DD = (bf16_t*)(ws + (f ? WS_W2D : WS_W1D));
                if (r < I_GU) { const int kb = r / 176, nb = r - kb * 176, pn = nb >> 3, rb = nb & 7;
                    tr_item(rb < 4 ? wg : wu, FFH, 128 * pn + 32 * (rb & 3), 64 * kb, true, GU, DM, 32 * nb, scr, lane); done = true; break; }
                r -= I_GU;
                if (r < I_D) { const int kb = r / 32, nb = r - kb * 32; tr_item(wd, DM, 32 * nb, 64 * kb, true, DD, FFH, 32 * nb, scr, lane); done = true; break; }
                r -= I_D;
            }
            if (done) continue;
            if (r < I_INA) { const int kb = r / 16, nb = r - kb * 16; tr_item(p.in[6], 1952, 32 * nb, 64 * kb, nb < 13, (bf16_t*)(ws + WS_WINA), DM, 32 * nb, scr, lane); continue; } r -= I_INA;
            if (r < I_INB) { const int kb = r / 48, nb = r - kb * 48; tr_item(p.in[6], 1952, 416 + 32 * nb, 64 * kb, true, (bf16_t*)(ws + WS_WINB), DM, 32 * nb, scr, lane); continue; } r -= I_INB;
            if (r < I_UQ) { const int kb = r / 24, nb = r - kb * 24; tr_item(p.in[8], 768, 32 * nb, 64 * kb, true, (bf16_t*)(ws + WS_WUQ), 256, 32 * nb, scr, lane); continue; } r -= I_UQ;
            if (r < I_UK) { const int kb = r / 16, nb = r - kb * 16; tr_item(p.in[10], 1024, 128 * (nb >> 1) + 32 * (nb & 1), 64 * kb, kb < 2, (bf16_t*)(ws + WS_WUK), 256, 32 * nb, scr, lane); continue; } r -= I_UK;
            if (r < I_UK) { const int kb = r / 16, nb = r - kb * 16; tr_item(p.in[10], 1024, 128 * (nb >> 1) + 64 + 32 * (nb & 1), 64 * kb, kb < 2, (bf16_t*)(ws + WS_WUV), 256, 32 * nb, scr, lane); continue; } r -= I_UK;
            { const int kb = r / 32, nb = r - kb * 32; tr_item(p.in[21], DM, 32 * nb, 64 * kb, true, (bf16_t*)(ws + WS_WOUT), DM, 32 * nb, scr, lane); }
        }
        if (P0SEL & 2) { f32x2_t* tab = (f32x2_t*)(ws + WS_ROPE);
          for (int idx = gw * 64 + lane; idx < SEQ * 16; idx += NGW * 64) { const int s = idx >> 4, i = idx & 15;
              const float inv = exp2f(-(float)i * 0.8304820237218406f); const float ang = (float)s * inv; float sn, cs; sincos_rr(ang, sn, cs); tab[idx] = (f32x2_t){cs, sn}; } }
        __syncthreads();
        if (P0SEL & 4) for (int pb = bx; pb < 256; pb += G) filter_block(p, lds, pb, tid);
        for (int rep = 0; rep < NREP(13); ++rep) if (P0SEL & 8) for (int m = gw; m < MTOK; m += NGW) rms_row_bf16(p.in[0] + (size_t)m * DM, p.in[1], XN + (size_t)m * DM, lane);
    }
    SEAM(0);
    if (IN(1)) for (int rep = 0; rep < NREP(1); ++rep) { __syncthreads(); pg8::Gemm g{XN, (const bf16_t*)(ws + WS_W1GU), MTOK, 2 * FFH, DM}; pg8::StaticOrder S; S.init(MTOK, 2 * FFH, G, bx);
        pg8::EpiSwiGLU E{HB, FFH}; pg8::gemm_phase<pg8::EpiSwiGLU, pg8::StaticOrder>(lds, g, S, E); }
    SEAM(1);
    if (IN(2)) for (int rep = 0; rep < NREP(2); ++rep) { __syncthreads(); pg8::Gemm g{HB, (const bf16_t*)(ws + WS_W1D), MTOK, DM, FFH}; pg8::StaticOrder S; S.init(MTOK, DM, G, bx);
        pg8::EpiResid E{p.in[0], p.out, DM, 0.5f}; pg8::gemm_phase<pg8::EpiResid, pg8::StaticOrder>(lds, g, S, E); }
    SEAM(2);
    if (IN(3)) for (int rep = 0; rep < NREP(3); ++rep) { for (int m = gw; m < MTOK; m += NGW) rms_row_bf16(p.out + (size_t)m * DM, p.in[5], XN + (size_t)m * DM, lane); }
    SEAM(3);
    if (IN(4)) for (int rep = 0; rep < NREP(4); ++rep) { __syncthreads();
        { pg8::Gemm g{XN, (const bf16_t*)(ws + WS_WINA), MTOK, 512, DM}; pg8::StaticOrder S; S.init(MTOK, 512, G, bx);
          pg8::EpiF32 E{(float*)(ws + WS_UA), 512}; pg8::gemm_phase<pg8::EpiF32, pg8::StaticOrder>(lds, g, S, E); }
        { pg8::Gemm g{(const bf16_t*)(ws + WS_WINB), XN, 1536, MTOK, DM}; pg8::StaticOrder S; S.init(1536, MTOK, G, bx);
          pg8::EpiBf16P E{(bf16_t*)(ws + WS_UT), (size_t)MTOK}; pg8::gemm_phase<pg8::EpiBf16P, pg8::StaticOrder>(lds, g, S, E); } }
    SEAM(4);
    if (IN(5)) for (int rep = 0; rep < NREP(5); ++rep) {
        const float* UA = (const float*)(ws + WS_UA); bf16_t* CQN = (bf16_t*)(ws + WS_CQN); bf16_t* CKVN = (bf16_t*)(ws + WS_CKVN); bf16_t* KPE = (bf16_t*)(ws + WS_KPE);
        const f32x2_t* tab = (const f32x2_t*)(ws + WS_ROPE);
        const f32x4 gq = ((const f32x4*)p.in[7])[lane]; const f32x4 gk = lane < 32 ? ((const f32x4*)p.in[9])[lane] : (f32x4){0.f, 0.f, 0.f, 0.f};
        for (int row = gw; row < MTOK; row += NGW) {
            const f32x4* ur = (const f32x4*)(UA + (size_t)row * 512);
            const f32x4 a = ur[lane], bq = ur[64 + lane];
            const float rq = 1.0f / sqrtf(wave_sum((a.x * a.x + a.y * a.y) + (a.z * a.z + a.w * a.w)) * (1.0f / 256.0f) + EPSN);
            u32x2 w; w.x = pk2(a.x * rq * gq.x, a.y * rq * gq.y); w.y = pk2(a.z * rq * gq.z, a.w * rq * gq.w);
            *((u32x2*)(CQN + (size_t)row * 256) + lane) = w;
            const float skv = lane < 32 ? (bq.x * bq.x + bq.y * bq.y) + (bq.z * bq.z + bq.w * bq.w) : 0.f;
            const float rkv = 1.0f / sqrtf(wave_sum(skv) * (1.0f / 128.0f) + EPSN);
            u32x2 wk = (u32x2){0u, 0u};
            if (lane < 32) { wk.x = pk2(bq.x * rkv * gk.x, bq.y * rkv * gk.y); wk.y = pk2(bq.z * rkv * gk.z, bq.w * rkv * gk.w); }
            *((u32x2*)(CKVN + (size_t)row * 256) + lane) = wk;
            f32x4 pr; pr.x = __shfl_xor(bq.x, 4); pr.y = __shfl_xor(bq.y, 4); pr.z = __shfl_xor(bq.z, 4); pr.w = __shfl_xor(bq.w, 4);
            if (lane >= 32 && lane < 40) { const int pos = row & 4095; const bool first = lane < 36; const int i0 = 4 * ((lane - 32) & 3);
                float ov[4];
#pragma unroll
                for (int e = 0; e < 4; ++e) { const f32x2_t cs = tab[pos * 16 + i0 + e]; const float x1 = first ? bq[e] : pr[e], x2 = first ? pr[e] : bq[e]; ov[e] = first ? x1 * cs.x - x2 * cs.y : x1 * cs.y + x2 * cs.x; }
                u32x2 wo; wo.x = pk2(ov[0], ov[1]); wo.y = pk2(ov[2], ov[3]);
                *(u32x2*)(KPE + (size_t)row * 32 + 4 * (lane - 32)) = wo; }
        }
    }
    SEAM(5);
    if (IN(6)) for (int rep = 0; rep < NREP(6); ++rep) { __syncthreads();
        if (P6SEL & 1) { pg8::Gemm g{(const bf16_t*)(ws + WS_CQN), (const bf16_t*)(ws + WS_WUQ), MTOK, 768, 256}; pg8::StaticOrder S; S.init(MTOK, 768, G, bx);
          pg8::EpiF32 E{(float*)(ws + WS_Q), 768}; pg8::gemm_phase<pg8::EpiF32, pg8::StaticOrder>(lds, g, S, E); }
        if (P6SEL & 2) { pg8::Gemm g{(const bf16_t*)(ws + WS_CKVN), (const bf16_t*)(ws + WS_WUK), MTOK, 512, 256}; pg8::StaticOrder S; S.init(MTOK, 512, G, bx);
          pg8::EpiBf16P E{(bf16_t*)(ws + WS_KN), (size_t)512}; pg8::gemm_phase<pg8::EpiBf16P, pg8::StaticOrder>(lds, g, S, E); }
        if (P6SEL & 4) { pg8::Gemm g{(const bf16_t*)(ws + WS_WUV), (const bf16_t*)(ws + WS_CKVN), 512, MTOK, 256}; pg8::StaticOrder S; S.init(512, MTOK, G, bx);
          pg8::EpiBf16P E{(bf16_t*)(ws + WS_VT), (size_t)MTOK}; pg8::gemm_phase<pg8::EpiBf16P, pg8::StaticOrder>(lds, g, S, E); } }
    SEAM(6);
    if (IN(7)) { __syncthreads();
        for (int rep = 0; rep < NREP(7); ++rep) for (int u = vcu; u < 1024; u += G) attn_unit(p, lds, u, tid, lane, wave);
        __syncthreads();
        for (int rep = 0; rep < NREP(14); ++rep) for (int c = bx; c < 512; c += G) hyena_channel(p, lds, c, tid, lane, wave);
    }
    SEAM(7);
    if (IN(8)) for (int rep = 0; rep < NREP(8); ++rep) {
        const bf16_t* HYT = (const bf16_t*)(ws + WS_HYT); bf16_t* MIXN = (bf16_t*)(ws + WS_MIXN); const float* hg = p.in[20] + 512;
        for (int it = gw; it < 8 * (MTOK / 64); it += NGW) { const int grp = it & 7, row = (it >> 3) * 64 + lane;
            float v[64]; float ss = 0.f;
#pragma unroll
            for (int cc = 0; cc < 64; ++cc) { v[cc] = bf2f(HYT[(size_t)(64 * grp + cc) * MTOK + row]); ss += v[cc] * v[cc]; }
            const float rstd = 1.0f / sqrtf(ss * (1.0f / 64.0f) + EPSN);
            bf16_t* dst = MIXN + (size_t)row * 1024 + 512 + 64 * grp;
#pragma unroll
            for (int k = 0; k < 8; ++k) { const float* gp = hg + 64 * grp + 8 * k;
                u32x4 w; w.x = pk2(v[8 * k] * rstd * gp[0], v[8 * k + 1] * rstd * gp[1]); w.y = pk2(v[8 * k + 2] * rstd * gp[2], v[8 * k + 3] * rstd * gp[3]);
                w.z = pk2(v[8 * k + 4] * rstd * gp[4], v[8 * k + 5] * rstd * gp[5]); w.w = pk2(v[8 * k + 6] * rstd * gp[6], v[8 * k + 7] * rstd * gp[7]);
                *(u32x4*)(dst + 8 * k) = w; } }
    }
    SEAM(8);
    if (IN(9)) { __syncthreads(); pg8::Gemm g{(const bf16_t*)(ws + WS_MIXN), (const bf16_t*)(ws + WS_WOUT), MTOK, DM, DM}; pg8::StaticOrder S; S.init(MTOK, DM, G, bx);
        pg8::EpiResid E{p.out, p.out, DM, 1.0f}; pg8::gemm_phase<pg8::EpiResid, pg8::StaticOrder>(lds, g, S, E); }
    SEAM(9);
    if (IN(10)) for (int rep = 0; rep < NREP(10); ++rep) { for (int m = gw; m < MTOK; m += NGW) rms_row_bf16(p.out + (size_t)m * DM, p.in[22], XN + (size_t)m * DM, lane); }
    SEAM(10);
    if (IN(11)) for (int rep = 0; rep < NREP(11); ++rep) { __syncthreads(); pg8::Gemm g{XN, (const bf16_t*)(ws + WS_W2GU), MTOK, 2 * FFH, DM}; pg8::StaticOrder S; S.init(MTOK, 2 * FFH, G, bx);
        pg8::EpiSwiGLU E{HB, FFH}; pg8::gemm_phase<pg8::EpiSwiGLU, pg8::StaticOrder>(lds, g, S, E); }
    SEAM(11);
    if (IN(12)) { __syncthreads(); pg8::Gemm g{HB, (const bf16_t*)(ws + WS_W2D), MTOK, DM, FFH}; pg8::StaticOrder S; S.init(MTOK, DM, G, bx);
        pg8::EpiResid E{p.out, p.out, DM, 0.5f}; pg8::gemm_phase<pg8::EpiResid, pg8::StaticOrder>(lds, g, S, E); }
    SEAM(12);
    if (IN(13)) {
        const f32x4* gr = (const f32x4*)p.in[26] + lane;
        for (int m = gw; m < MTOK; m += NGW) { f32x4* xr = (f32x4*)(p.out + (size_t)m * DM) + lane; f32x4 v[4]; float s = 0.f;
#pragma unroll
            for (int j = 0; j < 4; ++j) { v[j] = xr[64 * j]; s += (v[j].x * v[j].x + v[j].y * v[j].y) + (v[j].z * v[j].z + v[j].w * v[j].w); }
            const float rstd = 1.0f / sqrtf(wave_sum(s) * (1.0f / DM) + EPSN);
#pragma unroll
            for (int j = 0; j < 4; ++j) xr[64 * j] = v[j] * rstd * gr[64 * j]; }
    }
#undef IN
#undef SEAM
}

#ifndef ONE_LAUNCH
#define ONE_LAUNCH 1
#endif
extern "C" void kernel_launch(void* const* d_in, const int* in_sizes, int n_in, void* d_out, int out_size, void* d_ws, size_t ws_size, hipStream_t stream) {
    static int grid = 0;
    if (grid == 0) {
        if (n_in != 27 || ws_size < WS_END) { fprintf(stderr, "kernel_launch: unexpected n_in %d or ws_size %zu\n", n_in, ws_size); grid = -1; return; }
        int dev = 0, cus = 0, per_cu = 0;
        (void)hipGetDevice(&dev); (void)hipDeviceGetAttribute(&cus, hipDeviceAttributeMultiprocessorCount, dev);
        if (hipFuncSetAttribute((const void*)fwd_megakernel, hipFuncAttributeMaxDynamicSharedMemorySize, LDS_BYTES) != hipSuccess) { fprintf(stderr, "kernel_launch: hipFuncSetAttribute failed\n"); grid = -1; return; }
        if (hipOccupancyMaxActiveBlocksPerMultiprocessor(&per_cu, (const void*)fwd_megakernel, 512, LDS_BYTES) != hipSuccess || per_cu < 1) { fprintf(stderr, "kernel_launch: occupancy query says %d\n", per_cu); (void)hipGetLastError(); grid = -1; return; }
        grid = cus;
    }
    if (grid < 0) return;
    (void)hipMemsetAsync((char*)d_ws + WS_CTL, 0, CTL_ZERO, stream);
    Params p{};
    for (int i = 0; i < 27; ++i) p.in[i] = (const float*)d_in[i];
    p.out = (float*)d_out; p.ws = (unsigned char*)d_ws;
#if ONE_LAUNCH
    p.ph_lo = 0; p.ph_hi = NPHASE;
    void* args[] = {&p};
    hipError_t e = hipLaunchCooperativeKernel((const void*)fwd_megakernel, dim3(grid), dim3(512), args, LDS_BYTES, stream);
    if (e != hipSuccess) fprintf(stderr, "cooperative launch failed: %s (grid %d)\n", hipGetErrorString(e), grid);
#else
    for (int k = 0; k < NPHASE; ++k) { p.ph_lo = k; p.ph_hi = k + 1; hipLaunchKernelGGL(fwd_megakernel, dim3(grid), dim3(512), LDS_BYTES, stream, p); }
#endif
}
```

```cpp
#include <hip/hip_runtime.h>
#include <hip/hip_cooperative_groups.h>
#include <cstdio>
namespace cg = cooperative_groups;
namespace pg8 {
#define PG8_LAS __attribute__((address_space(3)))
typedef unsigned short bf16_t;
typedef short bf16x8 __attribute__((ext_vector_type(8)));
typedef float f32x4 __attribute__((ext_vector_type(4)));
typedef unsigned u32x4 __attribute__((ext_vector_type(4)));
constexpr int BM = 256, BK = 64, HALF = 128, HTB = HALF * BK * 2  , STAGE_BYTES = 8 * HTB, NXCD = 8, WGM = 8;

__host__ __device__ __forceinline__ int lds_byte(int r, int c) { const int st = (r >> 4) * 2 + (c >> 5), rr = r & 15, cc = c & 31, ob = rr * 64 + cc * 2; return st * 1024 + (ob ^ (((ob >> 9) & 1) << 5)); }
__host__ __device__ __forceinline__ void stage_rc(int b, int& R, int& C) { const int st = b / 1024, sb = b % 1024, swz = sb ^ (((sb >> 9) & 1) << 5); R = (st >> 1) * 16 + swz / 64; C = (st & 1) * 32 + (swz % 64) / 2; }
__host__ __device__ __forceinline__ int perm32(int rho) { const int n = rho >> 4, i = rho & 15; return 8 * (i >> 2) + 4 * n + (i & 3); }

struct Unit { int pm, pn; };
struct Gemm { const bf16_t* A; const bf16_t* Bt; int M, N, K; };

struct StaticOrder {
    int nM, nN, nwg, G, c;
    __host__ __device__ void init(int M, int N, int G_, int c_) { nM = M / BM; nN = N / BM; nwg = nM * nN; G = G_; c = c_; }
    __host__ __device__ bool next(int i, Unit& u) const {
        const long L = (long)i * G + c; if (L >= nwg) return false;
        int wgid = (int)L; { const int q = nwg / NXCD, r = nwg % NXCD, xcd = wgid % NXCD, off = wgid / NXCD; wgid = (xcd < r ? xcd * (q + 1) : r * (q + 1) + (xcd - r) * q) + off; }
        const int nig = WGM * nN, gid = wgid / nig, fm = gid * WGM, gsz = (nM - fm) < WGM ? (nM - fm) : WGM;
        u.pm = fm + ((wgid % nig) % gsz); u.pn = (wgid % nig) / gsz; return true;
    }
    __device__ __forceinline__ void a_ready(const Unit&) const {}
    __device__ __forceinline__ void done(const Unit&) const {}
};
typedef unsigned u32x2 __attribute__((ext_vector_type(2)));
typedef __bf16 bf16x2_t __attribute__((ext_vector_type(2)));
typedef float f32x2_t __attribute__((ext_vector_type(2)));
__device__ __forceinline__ unsigned pk2(float lo, float hi) { f32x2_t v = {lo, hi}; bf16x2_t b = __builtin_convertvector(v, bf16x2_t); return __builtin_bit_cast(unsigned, b); }
__device__ __forceinline__ float silu_mul(float g, float u) { return g * __builtin_amdgcn_rcpf(1.0f + __expf(-g)) * u; }
struct EpiSwiGLU {
    static constexpr bool PERM = true, AFTER_DRAIN = false;
    bf16_t* H; int ldh;
    __device__ __forceinline__ void operator()(const f32x4 (&acc)[2][2][4][2], const Unit& u, int wr, int wc, int fr, int fq) const {
        const int row0 = u.pm * BM + wr * 64 + fr, col0 = u.pn * HALF + wc * 32 + 8 * fq;
#pragma unroll
        for (int ai = 0; ai < 2; ++ai)
#pragma unroll
            for (int m = 0; m < 4; ++m) { bf16_t* rowp = H + (size_t)(row0 + ai * HALF + m * 16) * ldh + col0;
                const f32x4 g0 = acc[ai][0][m][0], g1 = acc[ai][0][m][1], u0 = acc[ai][1][m][0], u1 = acc[ai][1][m][1];
                u32x4 w; w.x = pk2(silu_mul(g0[0], u0[0]), silu_mul(g0[1], u0[1])); w.y = pk2(silu_mul(g0[2], u0[2]), silu_mul(g0[3], u0[3]));
                w.z = pk2(silu_mul(g1[0], u1[0]), silu_mul(g1[1], u1[1])); w.w = pk2(silu_mul(g1[2], u1[2]), silu_mul(g1[3], u1[3]));
                *(u32x4*)rowp = w; }
    }
};
struct EpiResid {
    static constexpr bool PERM = false, AFTER_DRAIN = false;
    const float* base; float* out; int ldc; float alpha;
    __device__ __forceinline__ void operator()(const f32x4 (&acc)[2][2][4][2], const Unit& u, int wr, int wc, int fr, int fq) const {
        const int row0 = u.pm * BM + wr * 64 + fr, col0 = u.pn * BM + wc * 32 + 4 * fq;
#pragma unroll
        for (int ai = 0; ai < 2; ++ai)
#pragma unroll
            for (int m = 0; m < 4; ++m) { const size_t off = (size_t)(row0 + ai * HALF + m * 16) * ldc + col0;
#pragma unroll
                for (int bj = 0; bj < 2; ++bj)
#pragma unroll
                    for (int n = 0; n < 2; ++n) { const size_t o = off + bj * HALF + n * 16; const f32x4 b = *(const f32x4*)(base + o); *(f32x4*)(out + o) = b + alpha * acc[ai][bj][m][n]; }
                asm volatile("" ::: "memory"); }
    }
};
struct EpiF32 {
    static constexpr bool PERM = false, AFTER_DRAIN = false;
    float* C; int ldc;
    __device__ __forceinline__ void operator()(const f32x4 (&acc)[2][2][4][2], const Unit& u, int wr, int wc, int fr, int fq) const {
        const int row0 = u.pm * BM + wr * 64 + fr, col0 = u.pn * BM + wc * 32 + 4 * fq;
#pragma unroll
        for (int ai = 0; ai < 2; ++ai)
#pragma unroll
            for (int m = 0; m < 4; ++m) { float* rowp = C + (size_t)(row0 + ai * HALF + m * 16) * ldc + col0;
#pragma unroll
                for (int bj = 0; bj < 2; ++bj)
#pragma unroll
                    for (int n = 0; n < 2; ++n) *(f32x4*)(rowp + bj * HALF + n * 16) = acc[ai][bj][m][n]; }
    }
};
struct EpiBf16P {
    static constexpr bool PERM = true, AFTER_DRAIN = false;
    bf16_t* O; size_t ldc;
    __device__ __forceinline__ void operator()(const f32x4 (&acc)[2][2][4][2], const Unit& u, int wr, int wc, int fr, int fq) const {
        const int row0 = u.pm * BM + wr * 64 + fr, col0 = u.pn * BM + wc * 32 + 8 * fq;
#pragma unroll
        for (int ai = 0; ai < 2; ++ai)
#pragma unroll
            for (int m = 0; m < 4; ++m) { bf16_t* rowp = O + (size_t)(row0 + ai * HALF + m * 16) * ldc + col0;
#pragma unroll
                for (int bj = 0; bj < 2; ++bj) { const f32x4 v0 = acc[ai][bj][m][0], v1 = acc[ai][bj][m][1];
                    u32x4 w; w.x = pk2(v0[0], v0[1]); w.y = pk2(v0[2], v0[3]); w.z = pk2(v1[0], v1[1]); w.w = pk2(v1[2], v1[3]);
                    *(u32x4*)(rowp + bj * HALF) = w; } }
    }
};
struct EpiQ {
    static constexpr bool PERM = false, AFTER_DRAIN = false;
    bf16_t* Q; const f32x2_t* tab; float scale;
    __device__ __forceinline__ void operator()(const f32x4 (&acc)[2][2][4][2], const Unit& u, int wr, int wc, int fr, int fq) const {
        const int row0 = u.pm * BM + wr * 64 + fr, colb = u.pn * BM + wc * 32;
#pragma unroll
        for (int ai = 0; ai < 2; ++ai)
#pragma unroll
            for (int m = 0; m < 4; ++m) { const int row = row0 + ai * HALF + m * 16, pos = row & 4095;
#pragma unroll
                for (int bj = 0; bj < 2; ++bj) { const int cgp = colb + bj * HALF; const bool pe = ((cgp >> 5) % 3) == 2;
                    f32x4 a = acc[ai][bj][m][0], b = acc[ai][bj][m][1];
                    if (pe) {
#pragma unroll
                        for (int e = 0; e < 4; ++e) { const f32x2_t cs = tab[pos * 16 + 4 * fq + e]; const float x1 = a[e], x2 = b[e]; a[e] = x1 * cs.x - x2 * cs.y; b[e] = x1 * cs.y + x2 * cs.x; } }
                    a = a * scale; b = b * scale;
                    bf16_t* qp = Q + (size_t)row * 768 + cgp + 4 * fq;
                    u32x2 w0; w0.x = pk2(a[0], a[1]); w0.y = pk2(a[2], a[3]); *(u32x2*)qp = w0;
                    u32x2 w1; w1.x = pk2(b[0], b[1]); w1.y = pk2(b[2], b[3]); *(u32x2*)(qp + 16) = w1;
                    asm volatile("" ::: "memory"); } }
    }
};
template <class Epi, class Sched>
__device__ __forceinline__ void gemm_phase(PG8_LAS unsigned char* lds, const Gemm g, const Sched& S, const Epi& E) {
    const int tid = threadIdx.x, wid = __builtin_amdgcn_readfirstlane(tid >> 6), lane = tid & 63, wr = wid >> 2, wc = wid & 3, fr = lane & 15, fq = lane >> 4;
    const int K = g.K, nt = K / BK;
    unsigned voffA[2], voffB[2];
#pragma unroll
    for (int i = 0; i < 2; ++i) { int R, C; stage_rc(tid * 16 + i * 8192, R, C); const int Rb = Epi::PERM ? ((R & ~31) + perm32(R & 31)) : R;
        voffA[i] = (unsigned)(R * K + C) * 2u; voffB[i] = (unsigned)(Rb * K + C) * 2u; }
    const size_t kstep = (size_t)(BK * 2);
    const size_t hstep = (size_t)HALF * K * 2;
    const size_t tstep = 2 * hstep;
    const unsigned ldsw = (unsigned)wid * 1024u;
    const int aoff = lds_byte(wr * 64 + fr, fq * 8), boff = lds_byte(wc * 32 + fr, fq * 8);
#define PG8_SA(b, h) (((b) * 2 + (h)) * HTB)
#define PG8_SB(b, h) ((4 + (b) * 2 + (h)) * HTB)
#define PG8_STAGE(bufoff, gbase, voff) do { _Pragma("unroll") for (int _i = 0; _i < 2; ++_i) \
        __builtin_amdgcn_global_load_lds((const unsigned*)((const char*)(gbase) + (voff)[_i]), (PG8_LAS unsigned*)(lds + (bufoff) + ldsw + _i * 8192), 16, 0, 0); } while (0)
#define PG8_LDA(dst, b, h) do { _Pragma("unroll") for (int m = 0; m < 4; ++m) _Pragma("unroll") for (int k = 0; k < 2; ++k) dst[m][k] = *(const PG8_LAS bf16x8*)(lds + PG8_SA(b, h) + aoff + m * 2048 + k * 1024); } while (0)
#define PG8_LDB(dst, b, h) do { _Pragma("unroll") for (int n = 0; n < 2; ++n) _Pragma("unroll") for (int k = 0; k < 2; ++k) dst[n][k] = *(const PG8_LAS bf16x8*)(lds + PG8_SB(b, h) + boff + n * 2048 + k * 1024); } while (0)
#define PG8_MMA(ai, bj, At, Bt) do { __builtin_amdgcn_s_setprio(1); _Pragma("unroll") for (int m = 0; m < 4; ++m) _Pragma("unroll") for (int n = 0; n < 2; ++n) _Pragma("unroll") for (int k = 0; k < 2; ++k) \
        acc[ai][bj][m][n] = __builtin_amdgcn_mfma_f32_16x16x32_bf16(Bt[n][k], At[m][k], acc[ai][bj][m][n], 0, 0, 0); __builtin_amdgcn_s_setprio(0); } while (0)
#define PG8_WAIT_V(n) asm volatile("s_waitcnt vmcnt(" #n ")" ::: "memory")
#define PG8_WAIT_L(n) asm volatile("s_waitcnt lgkmcnt(" #n ")" ::: "memory")
#define PG8_BAR __builtin_amdgcn_s_barrier()
#define PG8_SCHED __builtin_amdgcn_sched_barrier(0)
    Unit cur, nxt; int ui = 0;
    if (!S.next(0, cur)) return;
    f32x4 acc[2][2][4][2];
#pragma unroll
    for (int a = 0; a < 2; ++a)
#pragma unroll
        for (int b = 0; b < 2; ++b)
#pragma unroll
            for (int m = 0; m < 4; ++m)
#pragma unroll
                for (int n = 0; n < 2; ++n) acc[a][b][m][n] = (f32x4){0.f, 0.f, 0.f, 0.f};
    bf16x8 At[4][2], B0[2][2], B1[2][2];
    const char* cA = (const char*)g.A + (size_t)cur.pm * tstep; const char* cB = (const char*)g.Bt + (size_t)cur.pn * tstep;
    S.a_ready(cur);
    PG8_STAGE(PG8_SB(0, 0), cB, voffB); PG8_STAGE(PG8_SA(0, 0), cA, voffA); PG8_STAGE(PG8_SB(0, 1), cB + hstep, voffB); PG8_STAGE(PG8_SA(0, 1), cA + hstep, voffA);
    if (wr == 1) PG8_BAR;
    PG8_WAIT_V(4); PG8_BAR;
    PG8_STAGE(PG8_SB(1, 0), cB + kstep, voffB); PG8_STAGE(PG8_SA(1, 0), cA + kstep, voffA); PG8_STAGE(PG8_SB(1, 1), cB + hstep + kstep, voffB);
    PG8_WAIT_V(6); PG8_BAR;
    for (;;) {
        const bool has_next = S.next(ui + 1, nxt);
        const char* nA = has_next ? (const char*)g.A + (size_t)nxt.pm * tstep : cA; const char* nB = has_next ? (const char*)g.Bt + (size_t)nxt.pn * tstep : cB;
        for (int t = 0; t < nt; t += 2) {
            const bool last = (t == nt - 2);
            const char* a1 = cA + (size_t)(t + 1) * kstep;
            const char* a2 = last ? nA : cA + (size_t)(t + 2) * kstep; const char* b2 = last ? nB : cB + (size_t)(t + 2) * kstep;
            const char* a3 = a2 + kstep; const char* b3 = b2 + kstep;
            if (last && has_next) S.a_ready(nxt);
            PG8_LDB(B0, 0, 0); PG8_SCHED; PG8_LDA(At, 0, 0); PG8_STAGE(PG8_SA(1, 1), a1 + hstep, voffA);
            PG8_WAIT_L(8); PG8_BAR; PG8_WAIT_L(0); PG8_MMA(0, 0, At, B0); PG8_BAR; PG8_SCHED;
            PG8_LDB(B1, 0, 1); PG8_STAGE(PG8_SB(0, 0), b2, voffB);
            PG8_BAR; PG8_WAIT_L(0); PG8_MMA(0, 1, At, B1); PG8_BAR;
            PG8_LDA(At, 0, 1); PG8_STAGE(PG8_SA(0, 0), a2, voffA);
            PG8_BAR; PG8_WAIT_L(0); PG8_MMA(1, 0, At, B0); PG8_BAR; PG8_SCHED;
            PG8_STAGE(PG8_SB(0, 1), b2 + hstep, voffB);
            PG8_WAIT_V(6); PG8_BAR; PG8_MMA(1, 1, At, B1); PG8_BAR;
            PG8_LDB(B0, 1, 0); PG8_SCHED; PG8_LDA(At, 1, 0); PG8_STAGE(PG8_SA(0, 1), a2 + hstep, voffA);
            PG8_WAIT_L(8); PG8_BAR; PG8_WAIT_L(0); PG8_MMA(0, 0, At, B0); PG8_BAR; PG8_SCHED;
            PG8_LDB(B1, 1, 1); PG8_STAGE(PG8_SB(1, 0), b3, voffB);
            PG8_BAR; PG8_WAIT_L(0); PG8_MMA(0, 1, At, B1); PG8_BAR;
            PG8_LDA(At, 1, 1); PG8_STAGE(PG8_SA(1, 0), a3, voffA);
            PG8_BAR; PG8_WAIT_L(0); PG8_MMA(1, 0, At, B0); PG8_BAR; PG8_SCHED;
            PG8_STAGE(PG8_SB(1, 1), b3 + hstep, voffB);
            PG8_WAIT_V(6); PG8_BAR; PG8_MMA(1, 1, At, B1); PG8_BAR;
        }
        if constexpr (!Epi::AFTER_DRAIN) { E(acc, cur, wr, wc, fr, fq); S.done(cur); }
        if (!has_next) break;
#pragma unroll
        for (int a = 0; a < 2; ++a)
#pragma unroll
            for (int b = 0; b < 2; ++b)
#pragma unroll
                for (int m = 0; m < 4; ++m)
#pragma unroll
                    for (int n = 0; n < 2; ++n) acc[a][b][m][n] = (f32x4){0.f, 0.f, 0.f, 0.f};
        cur = nxt; cA = nA; cB = nB; ++ui;
    }
    PG8_WAIT_V(0);
    if (wr == 0) PG8_BAR;
    PG8_BAR;
    if constexpr (Epi::AFTER_DRAIN) { E.fused(acc, cur, wr, wc, fr, fq, lds, wid, lane); S.done(cur); }
#undef PG8_SA
#undef PG8_SB
#undef PG8_STAGE
#undef PG8_LDA
#undef PG8_LDB
#undef PG8_MMA
#undef PG8_WAIT_V
#undef PG8_WAIT_L
#undef PG8_BAR
#undef PG8_SCHED
}
}

#define LAS __attribute__((address_space(3)))
using pg8::bf16_t; using pg8::bf16x8; using pg8::f32x4; using pg8::u32x4; using pg8::u32x2; using pg8::f32x2_t; using pg8::pk2;
typedef float f32x16 __attribute__((ext_vector_type(16)));
constexpr int MTOK = 32768, DM = 1024, FFH = 2816, SEQ = 4096, NB = 8;
constexpr float EPSN = 1e-6f;
constexpr size_t MiB = 1u << 20;
constexpr size_t WS_CTL = 0, WS_BAR = 16384, CTL_ZERO = 32768;
constexpr size_t WS_W1GU = 2 * MiB, WS_W1D = 13 * MiB, WS_W2GU = 19 * MiB, WS_W2D = 30 * MiB;
constexpr size_t WS_WINA = 36 * MiB, WS_WINB = 37 * MiB, WS_WUQ = 40 * MiB, WS_WUK = 41 * MiB, WS_WUV = 41 * MiB + 512 * 1024, WS_WOUT = 42 * MiB;
constexpr size_t WS_ROPE = 44 * MiB, WS_FILT = 46 * MiB, WS_XN = 80 * MiB, WS_H = 144 * MiB;
constexpr size_t WS_UA = 144 * MiB, WS_UT = 208 * MiB, WS_KPE = 304 * MiB;
constexpr size_t WS_CQN = 320 * MiB, WS_CKVN = 336 * MiB, WS_Q = 352 * MiB  , WS_KN = 448 * MiB, WS_VT = 480 * MiB, WS_HYT = WS_UA  , WS_END = 512 * MiB;
constexpr size_t WS_MIXN = WS_XN;
constexpr int LDS_BYTES = 147456;
constexpr int NPHASE = 14;

__device__ __forceinline__ float wave_sum(float v) {
#pragma unroll
    for (int o = 1; o < 64; o <<= 1) v += __shfl_xor(v, o);
    return v;
}
__device__ __forceinline__ float bf2f(unsigned short b) { return __uint_as_float(((unsigned)b) << 16); }
__device__ __forceinline__ f32x16 mfma32(bf16x8 a, bf16x8 b, f32x16 c) { return __builtin_amdgcn_mfma_f32_32x32x16_bf16(a, b, c, 0, 0, 0); }
__device__ __forceinline__ void sincos_rr(float x, float& sn, float& cs) {
    const float n = rintf(x * 0.15915494309189535f);
    float r = fmaf(-n, 6.2831854820251465f, x); r = fmaf(-n, -1.7484555314695172e-7f, r);
    sn = __sinf(r); cs = __cosf(r);
}
#define LDS_WAIT() asm volatile("s_waitcnt lgkmcnt(0)" ::: "memory")

struct Params { const float* in[27]; float* out; unsigned char* ws; int ph_lo, ph_hi; };

__device__ __forceinline__ void tr_item(const float* src, int ldsrc, int scol0, int k0, bool valid, bf16_t* dst, int lddst, int drow0, LAS float* scr, int lane) {
    if (valid) {
#pragma unroll 8
        for (int i = 0; i < 32; ++i) { const int kk = 2 * i + (lane >> 5); scr[kk * 33 + (lane & 31)] = src[(size_t)(k0 + kk) * ldsrc + scol0 + (lane & 31)]; }
    } else {
#pragma unroll 8
        for (int i = 0; i < 32; ++i) { const int kk = 2 * i + (lane >> 5); scr[kk * 33 + (lane & 31)] = 0.f; }
    }
    LDS_WAIT();
    const int c = lane & 7;
#pragma unroll
    for (int j = 0; j < 4; ++j) { const int n = (lane >> 3) + 8 * j; const LAS float* s = scr + (8 * c) * 33 + n;
        u32x4 o; o.x = pk2(s[0 * 33], s[1 * 33]); o.y = pk2(s[2 * 33], s[3 * 33]); o.z = pk2(s[4 * 33], s[5 * 33]); o.w = pk2(s[6 * 33], s[7 * 33]);
        *(u32x4*)(dst + (size_t)(drow0 + n) * lddst + k0 + 8 * c) = o; }
    LDS_WAIT();
}

__device__ __forceinline__ void rms_row_bf16(const float* xrow, const float* g, bf16_t* orow, int lane) {
    const f32x4* xr = (const f32x4*)xrow + lane; const f32x4* gr = (const f32x4*)g + lane;
    f32x4 v[4]; float s = 0.f;
#pragma unroll
    for (int j = 0; j < 4; ++j) { v[j] = xr[64 * j]; s += (v[j].x * v[j].x + v[j].y * v[j].y) + (v[j].z * v[j].z + v[j].w * v[j].w); }
    const float rstd = 1.0f / sqrtf(wave_sum(s) * (1.0f / DM) + EPSN);
    u32x2* o8 = (u32x2*)orow + lane;
#pragma unroll
    for (int j = 0; j < 4; ++j) { const f32x4 gv = gr[64 * j]; u32x2 w; w.x = pk2(v[j].x * rstd * gv.x, v[j].y * rstd * gv.y); w.y = pk2(v[j].z * rstd * gv.z, v[j].w * rstd * gv.w); o8[64 * j] = w; }
}

__device__ __forceinline__ void filter_block(const Params& p, LAS unsigned char* lds, int pb, int tid) {
    LAS float* z = (LAS float*)(lds + 131072); LAS float* h1 = z + 528; LAS float* h2 = h1 + 1024;
    const float *w1 = p.in[13], *b1 = p.in[14], *w2 = p.in[15], *b2 = p.in[16], *w3 = p.in[17], *fr = p.in[18];
    float* FILT = (float*)(p.ws + WS_FILT); float* NORM = (float*)(p.ws + WS_CTL);
    for (int idx = tid; idx < 528; idx += 512) { const int pp = idx / 33, e = idx - pp * 33; const float t = (float)(pb * 16 + pp);
        float v;
        if (e == 0) v = t / 4095.0f;
        else { const int j = (e - 1) & 15; const float band = 1e-4f + (float)j * ((15.0f - 1e-4f) / 15.0f); const float ang = (6.283185307179586f * t / 4096.0f) * band; float sn, cs; sincos_rr(ang, sn, cs); v = (e <= 16) ? cs : -sn; }
        z[idx] = v; }
    __syncthreads();
    for (int idx = tid; idx < 1024; idx += 512) { const int pp = idx >> 6, j = idx & 63; float a = b1[j];
#pragma unroll 3
        for (int e = 0; e < 33; ++e) a += z[pp * 33 + e] * w1[e * 64 + j];
        float sn, cs; sincos_rr(fr[j] * a, sn, cs); h1[idx] = sn; }
    __syncthreads();
    for (int idx = tid; idx < 1024; idx += 512) { const int pp = idx >> 6, j = idx & 63; float a = b2[j];
#pragma unroll 4
        for (int i = 0; i < 64; ++i) a += h1[pp * 64 + i] * w2[i * 64 + j];
        float sn, cs; sincos_rr(fr[j] * a, sn, cs); h2[idx] = sn; }
    __syncthreads();
    const float dmin = 3.0701134573253945f, dmax = 15.350567286626973f;
#pragma unroll 1
    for (int m = 0; m < 4; ++m) { const int q = tid + 512 * m;
        float acc[16];
#pragma unroll
        for (int pp = 0; pp < 16; ++pp) acc[pp] = 0.f;
#pragma unroll 2
        for (int i = 0; i < 64; ++i) { const float w = w3[i * 2048 + q];
#pragma unroll
            for (int pp = 0; pp < 16; ++pp) acc[pp] += h2[pp * 64 + i] * w; }
        const int o = q >> 10, dir = (q >> 9) & 1, c = q & 511; const float delta = dmin + (float)c * ((dmax - dmin) / 511.0f);
        float sabs = 0.f;
#pragma unroll
        for (int pp = 0; pp < 16; ++pp) { const int t = pb * 16 + pp; const float v = acc[pp] * __expf(-((float)t / 4095.0f) * delta); acc[pp] = v; if (!(dir == 1 && t == 0)) sabs += fabsf(v); }
        float* dst = FILT + ((size_t)((o * 2 + dir) * 512 + c)) * 4096 + pb * 16;
#pragma unroll
        for (int k = 0; k < 4; ++k) *(f32x4*)(dst + 4 * k) = (f32x4){acc[4 * k], acc[4 * k + 1], acc[4 * k + 2], acc[4 * k + 3]};
        atomicAdd(&NORM[o * 512 + c], sabs); }
    __syncthreads();
}

constexpr int KL_STRIDE = 208, VL_STRIDE = 144, KL_BYTES = 64 * KL_STRIDE, VL_BYTES = 64 * VL_STRIDE, ATT_BUF = KL_BYTES + VL_BYTES;
__device__ __forceinline__ bf16x8 pack8(const f32x16& x, int s) {
    u32x4 p; p.x = pk2(x[8 * s], x[8 * s + 1]); p.y = pk2(x[8 * s + 2], x[8 * s + 3]); p.z = pk2(x[8 * s + 4], x[8 * s + 5]); p.w = pk2(x[8 * s + 6], x[8 * s + 7]);
    return __builtin_bit_cast(bf16x8, p);
}
__device__ __forceinline__ void attn_unit(const Params& p, LAS unsigned char* lds, int unit, int tid, int lane, int wave) {
    const int bh = unit >> 4, qb = unit & 15, b = bh >> 3, h = bh & 7, r = lane & 31, hh = lane >> 5;
    const float* Q = (const float*)(p.ws + WS_Q); const bf16_t* KN = (const bf16_t*)(p.ws + WS_KN); const bf16_t* KPE = (const bf16_t*)(p.ws + WS_KPE); const bf16_t* VT = (const bf16_t*)(p.ws + WS_VT);
    bf16_t* MIXN = (bf16_t*)(p.ws + WS_MIXN);
    const size_t tok0 = (size_t)b * SEQ, qrow = tok0 + qb * 256 + wave * 32 + r;
    bf16x8 qf[6];
    { const float QS = 0.14724352f;
      const float* qp = Q + qrow * 768 + 96 * h + 8 * hh;
#pragma unroll
      for (int ks = 0; ks < 4; ++ks) { const f32x4 a = *(const f32x4*)(qp + 16 * ks), b = *(const f32x4*)(qp + 16 * ks + 4);
          u32x4 w; w.x = pk2(a.x * QS, a.y * QS); w.y = pk2(a.z * QS, a.w * QS); w.z = pk2(b.x * QS, b.y * QS); w.w = pk2(b.z * QS, b.w * QS); qf[ks] = __builtin_bit_cast(bf16x8, w); }
      const f32x2_t* tab = (const f32x2_t*)(p.ws + WS_ROPE) + (size_t)((int)(qrow & 4095)) * 16 + 8 * hh;
      float x1[8], x2[8];
      { const f32x4 a = *(const f32x4*)(qp + 64), b = *(const f32x4*)(qp + 68), c = *(const f32x4*)(qp + 80), d = *(const f32x4*)(qp + 84);
        x1[0] = a.x; x1[1] = a.y; x1[2] = a.z; x1[3] = a.w; x1[4] = b.x; x1[5] = b.y; x1[6] = b.z; x1[7] = b.w;
        x2[0] = c.x; x2[1] = c.y; x2[2] = c.z; x2[3] = c.w; x2[4] = d.x; x2[5] = d.y; x2[6] = d.z; x2[7] = d.w; }
      float y1[8], y2[8];
#pragma unroll
      for (int j = 0; j < 8; ++j) { const f32x2_t cs = tab[j]; y1[j] = (x1[j] * cs.x - x2[j] * cs.y) * QS; y2[j] = (x1[j] * cs.y + x2[j] * cs.x) * QS; }
      u32x4 w; w.x = pk2(y1[0], y1[1]); w.y = pk2(y1[2], y1[3]); w.z = pk2(y1[4], y1[5]); w.w = pk2(y1[6], y1[7]); qf[4] = __builtin_bit_cast(bf16x8, w);
      w.x = pk2(y2[0], y2[1]); w.y = pk2(y2[2], y2[3]); w.z = pk2(y2[4], y2[5]); w.w = pk2(y2[6], y2[7]); qf[5] = __builtin_bit_cast(bf16x8, w); }
    const int kc1 = tid + 512; const bool has1 = tid < 256;
    const int key0 = tid / 12, part0 = tid - key0 * 12, key1 = kc1 / 12, part1 = kc1 - key1 * 12;
    const bf16_t* ks0 = part0 < 8 ? KN + (tok0 + key0) * 512 + 64 * h + 8 * part0 : KPE + (tok0 + key0) * 32 + 8 * (part0 - 8);
    const bf16_t* ks1 = part1 < 8 ? KN + (tok0 + key1) * 512 + 64 * h + 8 * part1 : KPE + (tok0 + key1) * 32 + 8 * (part1 - 8);
    const int kst0 = part0 < 8 ? 64 * 512 : 64 * 32, kst1 = part1 < 8 ? 64 * 512 : 64 * 32;
    const bf16_t* vs = VT + (size_t)(64 * h + (tid >> 3)) * MTOK + tok0 + 8 * (tid & 7);
    const int kd0 = key0 * KL_STRIDE + part0 * 16, kd1 = key1 * KL_STRIDE + part1 * 16, vd = KL_BYTES + (tid >> 3) * VL_STRIDE + (tid & 7) * 16;
    u32x4 rk0, rk1 = (u32x4){0u, 0u, 0u, 0u}, rv;
    rk0 = *(const u32x4*)ks0; if (has1) rk1 = *(const u32x4*)ks1; rv = *(const u32x4*)vs;
    *(LAS u32x4*)(lds + kd0) = rk0; if (has1) *(LAS u32x4*)(lds + kd1) = rk1; *(LAS u32x4*)(lds + vd) = rv;
    __syncthreads();
    f32x16 o0, o1;
#pragma unroll
    for (int i = 0; i < 16; ++i) { o0[i] = 0.f; o1[i] = 0.f; }
    float lsum = 0.f;
    for (int kt = 0; kt < 64; ++kt) {
        const int buf = kt & 1; const bool more = kt + 1 < 64;
        if (more) { rk0 = *(const u32x4*)(ks0 + (size_t)(kt + 1) * kst0); if (has1) rk1 = *(const u32x4*)(ks1 + (size_t)(kt + 1) * kst1); rv = *(const u32x4*)(vs + (kt + 1) * 64); }
        const LAS unsigned char* KLb = lds + buf * ATT_BUF; const LAS unsigned char* VLb = KLb + KL_BYTES;
        f32x16 s0, s1;
#pragma unroll
        for (int i = 0; i < 16; ++i) { s0[i] = 0.f; s1[i] = 0.f; }
#pragma unroll
        for (int ks = 0; ks < 6; ++ks) {
            const bf16x8 ka = *(const LAS bf16x8*)(KLb + r * KL_STRIDE + 32 * ks + 16 * hh);
            const bf16x8 kb = *(const LAS bf16x8*)(KLb + (32 + r) * KL_STRIDE + 32 * ks + 16 * hh);
            s0 = mfma32(ka, qf[ks], s0); s1 = mfma32(kb, qf[ks], s1); }
#pragma unroll
        for (int i = 0; i < 16; ++i) { s0[i] = __builtin_amdgcn_exp2f(s0[i]); s1[i] = __builtin_amdgcn_exp2f(s1[i]); lsum += s0[i] + s1[i]; }
        bf16x8 pf[2][2];
        pf[0][0] = pack8(s0, 0); pf[0][1] = pack8(s0, 1); pf[1][0] = pack8(s1, 0); pf[1][1] = pack8(s1, 1);
#pragma unroll
        for (int sub = 0; sub < 2; ++sub)
#pragma unroll
            for (int s = 0; s < 2; ++s) {
                const LAS unsigned char* vp = VLb + r * VL_STRIDE + (32 * sub + 16 * s + 4 * hh) * 2;
                const u32x2 lo0 = *(const LAS u32x2*)vp, hi0 = *(const LAS u32x2*)(vp + 16);
                const u32x2 lo1 = *(const LAS u32x2*)(vp + 32 * VL_STRIDE), hi1 = *(const LAS u32x2*)(vp + 32 * VL_STRIDE + 16);
                const bf16x8 va0 = __builtin_bit_cast(bf16x8, ((u32x4){lo0.x, lo0.y, hi0.x, hi0.y}));
                const bf16x8 va1 = __builtin_bit_cast(bf16x8, ((u32x4){lo1.x, lo1.y, hi1.x, hi1.y}));
                o0 = mfma32(va0, pf[sub][s], o0); o1 = mfma32(va1, pf[sub][s], o1); }
        if (more) { LAS unsigned char* nb = lds + (buf ^ 1) * ATT_BUF; *(LAS u32x4*)(nb + kd0) = rk0; if (has1) *(LAS u32x4*)(nb + kd1) = rk1; *(LAS u32x4*)(nb + vd) = rv; }
        __syncthreads();
    }
    const float l = lsum + __shfl_xor(lsum, 32); const float inv = 1.0f / l;
    float ss = 0.f;
#pragma unroll
    for (int i = 0; i < 16; ++i) { o0[i] *= inv; o1[i] *= inv; ss += o0[i] * o0[i] + o1[i] * o1[i]; }
    ss += __shfl_xor(ss, 32);
    const float rstd = 1.0f / sqrtf(ss * (1.0f / 64.0f) + EPSN);
    const float* hg = p.in[20] + 64 * h;
#pragma unroll
    for (int g = 0; g < 4; ++g) {
        const int dv0 = 8 * g + 4 * hh, dv1 = 32 + dv0;
        const f32x4 g0 = *(const f32x4*)(hg + dv0), g1 = *(const f32x4*)(hg + dv1);
        u32x2 w0, w1;
        w0.x = pk2(o0[4 * g] * rstd * g0.x, o0[4 * g + 1] * rstd * g0.y); w0.y = pk2(o0[4 * g + 2] * rstd * g0.z, o0[4 * g + 3] * rstd * g0.w);
        w1.x = pk2(o1[4 * g] * rstd * g1.x, o1[4 * g + 1] * rstd * g1.y); w1.y = pk2(o1[4 * g + 2] * rstd * g1.z, o1[4 * g + 3] * rstd * g1.w);
        *(u32x2*)(MIXN + qrow * 1024 + 64 * h + dv0) = w0; *(u32x2*)(MIXN + qrow * 1024 + 64 * h + dv1) = w1; }
}

constexpr int UT_STRIDE = 8192 + 16, UTL_BYTES = 8 * UT_STRIDE, RL_OFF = UTL_BYTES, RL1_OFF = 16384 + 64  , ZR_OFF = RL_OFF + 32768 + 128;
typedef short bf16x8_a4 __attribute__((ext_vector_type(8), aligned(4)));
__device__ __forceinline__ void hy_load_filter(const Params& p, LAS unsigned char* lds, int o, int c, int tid) {
    LAS bf16_t* RL = (LAS bf16_t*)(lds + RL_OFF);
    const float* FILT = (const float*)(p.ws + WS_FILT); const float* NORM = (const float*)(p.ws + WS_CTL);
    const float invn = 1.0f / NORM[o * 512 + c];
    const float* hf = FILT + (size_t)((o * 2 + 0) * 512 + c) * 4096; const float* hb = FILT + (size_t)((o * 2 + 1) * 512 + c) * 4096;
    float fv[16];
#pragma unroll
    for (int k = 0; k < 16; ++k) { const int i = tid + 512 * k; const int j = i - 4095; fv[k] = (k < 8) ? hf[4095 - i] : hb[j > 4095 ? 4095 : j]; }
#pragma unroll
    for (int k = 0; k < 16; ++k) { const int i = tid + 512 * k; const float v = (i < 8191) ? fv[k] * invn : 0.f;
        const bf16_t hv = (bf16_t)(pk2(v, 0.f) & 0xffffu); RL[i] = hv; if (i > 0) RL[RL1_OFF / 2 + i - 1] = hv; }
    if (tid == 0) RL[RL1_OFF / 2 + 8191] = 0;
}
#define HY_RD2(lo, hi, addr, o0, o1, o2, o3) asm volatile("ds_read2_b32 %0, %2 offset0:" #o0 " offset1:" #o1 "\n\tds_read2_b32 %1, %2 offset0:" #o2 " offset1:" #o3 : "=&v"(lo), "=&v"(hi) : "v"(addr))
#define HY_RDB(dst, addr, off) asm volatile("ds_read_b128 %0, %1 offset:" #off : "=&v"(dst) : "v"(addr))
__device__ __forceinline__ void hy_conv(LAS unsigned char* lds, f32x16 (&acc)[2][2], int lane, int wave) {
    const int r = lane & 31, hh = lane >> 5, bb = r & 7, t1o = r >> 3;
#pragma unroll
    for (int a = 0; a < 2; ++a)
#pragma unroll
        for (int b = 0; b < 2; ++b)
#pragma unroll
            for (int i = 0; i < 16; ++i) acc[a][b][i] = 0.f;
    const unsigned lbase = (unsigned)(size_t)lds;
    const int e00 = 4095 + 8 * hh - r;
    const unsigned a_cst = lbase + RL_OFF + ((e00 & 1) ? (RL1_OFF + 2 * (e00 - 1)) : 2 * e00) - 64;
    const unsigned b_cst = lbase + bb * UT_STRIDE + 16 * hh, z_addr = lbase + ZR_OFF;
    u32x2 wl[6], wh[6]; u32x4 Bq[2][4];
    { const unsigned a0 = a_cst - 128 * (8 * wave - 63);
      asm volatile("" ::: "memory");
      HY_RD2(wl[4], wh[4], a0, 32, 33, 34, 35); HY_RD2(wl[5], wh[5], a0, 40, 41, 42, 43); }
    for (int q = 0; q < 71; ++q) {
        const int d1 = 8 * wave - 63 + q;
        const unsigned aa = a_cst - 128 * d1;
        HY_RD2(wl[0], wh[0], aa, 0, 1, 2, 3); HY_RD2(wl[1], wh[1], aa, 8, 9, 10, 11); HY_RD2(wl[2], wh[2], aa, 16, 17, 18, 19); HY_RD2(wl[3], wh[3], aa, 24, 25, 26, 27);
#pragma unroll
        for (int nt = 0; nt < 2; ++nt) { const int s1 = 8 * wave + 4 * nt + t1o - d1; const unsigned ba = ((unsigned)s1 < 64u) ? b_cst + 128 * s1 : z_addr;
            HY_RDB(Bq[nt][0], ba, 0); HY_RDB(Bq[nt][1], ba, 32); HY_RDB(Bq[nt][2], ba, 64); HY_RDB(Bq[nt][3], ba, 96); }
        asm volatile("s_waitcnt lgkmcnt(0)" : "+v"(wl[0]), "+v"(wh[0]), "+v"(wl[1]), "+v"(wh[1]), "+v"(wl[2]), "+v"(wh[2]), "+v"(wl[3]), "+v"(wh[3]), "+v"(wl[4]), "+v"(wh[4]), "+v"(wl[5]), "+v"(wh[5]));
        asm volatile("" : "+v"(Bq[0][0]), "+v"(Bq[0][1]), "+v"(Bq[0][2]), "+v"(Bq[0][3]), "+v"(Bq[1][0]), "+v"(Bq[1][1]), "+v"(Bq[1][2]), "+v"(Bq[1][3]));
        bf16x8 W6[6];
#pragma unroll
        for (int k = 0; k < 6; ++k) W6[k] = __builtin_bit_cast(bf16x8, ((u32x4){wl[k].x, wl[k].y, wh[k].x, wh[k].y}));
#pragma unroll
        for (int ks = 0; ks < 4; ++ks)
#pragma unroll
            for (int mt = 0; mt < 2; ++mt)
#pragma unroll
                for (int nt = 0; nt < 2; ++nt) acc[mt][nt] = mfma32(W6[ks - 2 * mt + 2], __builtin_bit_cast(bf16x8, Bq[nt][ks]), acc[mt][nt]);
        wl[4] = wl[0]; wh[4] = wh[0]; wl[5] = wl[1]; wh[5] = wh[1];
    }
}
__device__ __forceinline__ void hy_stage_col(const Params& p, LAS unsigned char* lds, int gc, int tid) {
    const bf16_t* UTg = (const bf16_t*)(p.ws + WS_UT);
    const float* cw = p.in[11]; const float w0 = cw[gc], w1 = cw[1536 + gc], w2 = cw[3072 + gc], cbv = p.in[12][gc];
    u32x4 raw[8]; unsigned pv[8], nx[8];
#pragma unroll
    for (int i = 0; i < 8; ++i) { const int ch = tid + 512 * i, b = ch >> 9, s0 = (ch & 511) * 8;
        const bf16_t* src = UTg + (size_t)gc * MTOK + b * SEQ + s0;
        raw[i] = *(const u32x4*)src; pv[i] = src[s0 > 0 ? -1 : 0]; nx[i] = src[s0 + 8 < SEQ ? 8 : 7]; }
#pragma unroll
    for (int i = 0; i < 8; ++i) { const int ch = tid + 512 * i, b = ch >> 9, s0 = (ch & 511) * 8;
        float f[10];
        f[0] = s0 > 0 ? __uint_as_float(pv[i] << 16) : 0.f; f[9] = s0 + 8 < SEQ ? __uint_as_float(nx[i] << 16) : 0.f;
        f[1] = __uint_as_float(raw[i].x << 16); f[2] = __uint_as_float(raw[i].x & 0xffff0000u); f[3] = __uint_as_float(raw[i].y << 16); f[4] = __uint_as_float(raw[i].y & 0xffff0000u);
        f[5] = __uint_as_float(raw[i].z << 16); f[6] = __uint_as_float(raw[i].z & 0xffff0000u); f[7] = __uint_as_float(raw[i].w << 16); f[8] = __uint_as_float(raw[i].w & 0xffff0000u);
        float v[8];
#pragma unroll
        for (int j = 0; j < 8; ++j) v[j] = cbv + w0 * f[j] + w1 * f[j + 1] + w2 * f[j + 2];
        u32x4 w; w.x = pk2(v[0], v[1]); w.y = pk2(v[2], v[3]); w.z = pk2(v[4], v[5]); w.w = pk2(v[6], v[7]);
        *(LAS u32x4*)(lds + b * UT_STRIDE + s0 * 2) = w; }
}
template <int MODE>
__device__ __forceinline__ void hy_own(LAS unsigned char* lds, f32x16 (&acc)[2][2], float dsk, int lane, int wave) {
    const int r = lane & 31, hh = lane >> 5, bb = r & 7, t1o = r >> 3;
#pragma unroll
    for (int mt = 0; mt < 2; ++mt)
#pragma unroll
        for (int nt = 0; nt < 2; ++nt)
#pragma unroll
            for (int g = 0; g < 4; ++g) {
                const int t = 64 * (8 * wave + 4 * nt + t1o) + 32 * mt + 8 * g + 4 * hh;
                LAS unsigned char* up = lds + bb * UT_STRIDE + t * 2;
                const u32x2 ur = *(const LAS u32x2*)up;
                float uv[4]; uv[0] = __uint_as_float(ur.x << 16); uv[1] = __uint_as_float(ur.x & 0xffff0000u); uv[2] = __uint_as_float(ur.y << 16); uv[3] = __uint_as_float(ur.y & 0xffff0000u);
                if (MODE == 0) {
#pragma unroll
                    for (int j = 0; j < 4; ++j) acc[mt][nt][4 * g + j] += uv[j] * dsk;
                } else { u32x2 w; w.x = pk2(acc[mt][nt][4 * g] * uv[0], acc[mt][nt][4 * g + 1] * uv[1]); w.y = pk2(acc[mt][nt][4 * g + 2] * uv[2], acc[mt][nt][4 * g + 3] * uv[3]); *(LAS u32x2*)up = w; }
            }
}
__device__ __forceinline__ void hy_copy_out(const Params& p, LAS unsigned char* lds, int c, int tid) {
    bf16_t* HYT = (bf16_t*)(p.ws + WS_HYT);
#pragma unroll
    for (int i = 0; i < 8; ++i) { const int ch = tid + 512 * i, b = ch >> 9, s0 = (ch & 511) * 8;
        *(u32x4*)(HYT + (size_t)c * MTOK + b * SEQ + s0) = *(const LAS u32x4*)(lds + b * UT_STRIDE + s0 * 2); }
}
__device__ __forceinline__ void hyena_channel(const Params& p, LAS unsigned char* lds, int c, int tid, int lane, int wave) {
    const float d0 = p.in[19][c], d1 = p.in[19][512 + c];
    hy_stage_col(p, lds, c, tid);
    if (tid < 32) *(LAS unsigned*)(lds + ZR_OFF + 4 * tid) = 0u;
    hy_load_filter(p, lds, 0, c, tid);
    __syncthreads();
    f32x16 acc[2][2];
    hy_conv(lds, acc, lane, wave);
    __syncthreads();
    hy_own<0>(lds, acc, d0, lane, wave);
    __syncthreads();
    hy_stage_col(p, lds, 512 + c, tid);
    hy_load_filter(p, lds, 1, c, tid);
    __syncthreads();
    hy_own<1>(lds, acc, 0.f, lane, wave);
    __syncthreads();
    hy_conv(lds, acc, lane, wave);
    __syncthreads();
    hy_own<0>(lds, acc, d1, lane, wave);
    __syncthreads();
    hy_stage_col(p, lds, 1024 + c, tid);
    __syncthreads();
    hy_own<1>(lds, acc, 0.f, lane, wave);
    __syncthreads();
    hy_copy_out(p, lds, c, tid);
    __syncthreads();
}

#define XB_TMO      128
#define XB_XCNT(j)  (256  + 64 * (j))
#define XB_XSUB(j)  (1280 + 64 * (j))
#define XB_XGEN(j)  (2304 + 64 * (j))
#define XB_TOP      3328
#define XB_TOPGEN   3392
#define XCD_BAR_WORDS 3456
#define XB_SPIN_CAP (1u << 18)

__device__ __forceinline__ unsigned xb_ld(unsigned* p)              { return __hip_atomic_load(p, __ATOMIC_RELAXED, __HIP_MEMORY_SCOPE_AGENT); }
__device__ __forceinline__ unsigned xb_add(unsigned* p, unsigned v) { return __hip_atomic_fetch_add(p, v, __ATOMIC_RELAXED, __HIP_MEMORY_SCOPE_AGENT); }
__device__ __forceinline__ unsigned xb_xcc_id() { return (unsigned)__builtin_amdgcn_s_getreg((3 << 11) | 20) & 0xFu; }
#define XB_SPIN(cond, bar) do { unsigned _sp = 0; while (cond) { __builtin_amdgcn_s_sleep(1); \
    if ((++_sp & 255u) == 0u) { if (xb_ld(&(bar)[XB_TMO])) break; if (_sp > XB_SPIN_CAP) { atomicAdd(&(bar)[XB_TMO], 1u); break; } } } } while (0)

struct XcdBarrier {
    unsigned* bar; unsigned x;
    volatile LAS unsigned* st;
};

__device__ __forceinline__ XcdBarrier xcd_barrier_post(unsigned* bar, volatile LAS unsigned* st) {
    XcdBarrier b; b.bar = bar; b.x = xb_xcc_id(); b.st = st;
    if (threadIdx.x == 0) (void)xb_add(&bar[XB_XCNT(b.x)], 1u);
    return b;
}
__device__ __forceinline__ void xcd_barrier_complete(unsigned* bar, unsigned x, unsigned& nloc, unsigned& nx) {
    const unsigned G = gridDim.x * gridDim.y * gridDim.z;
    unsigned sum, cnt, mine, sp = 0u;
    for (;;) {
        sum = 0u; cnt = 0u; mine = 0u;
#pragma unroll
        for (unsigned j = 0; j < 16; ++j) { const unsigned c = xb_ld(&bar[XB_XCNT(j)]); sum += c; cnt += (c > 0u) ? 1u : 0u; mine = (j == x) ? c : mine; }
        if (sum == G) break;
        __builtin_amdgcn_s_sleep(1);
        if ((++sp & 255u) == 0u) { if (xb_ld(&bar[XB_TMO])) break; if (sp > XB_SPIN_CAP) { atomicAdd(&bar[XB_TMO], 1u); break; } }
    }
    nloc = mine > 0u ? mine : 1u; nx = cnt > 0u ? cnt : 1u;
}

__device__ __forceinline__ void xcd_barrier(const XcdBarrier& b) {
    asm volatile("s_waitcnt vmcnt(0)" ::: "memory");
    __syncthreads();
    if (threadIdx.x == 0) {
        unsigned* bar = b.bar;
        __builtin_amdgcn_s_waitcnt(0);
        unsigned nloc = b.st[0], nx = b.st[1];
        if (nloc == 0u) { xcd_barrier_complete(bar, b.x, nloc, nx); b.st[0] = nloc; b.st[1] = nx; }
        const unsigned old = xb_add(&bar[XB_XSUB(b.x)], 1u);
        const unsigned gen = old / nloc;
        if (old + 1u == (gen + 1u) * nloc) {
            __builtin_amdgcn_fence(__ATOMIC_RELEASE, "agent");
            asm volatile("s_waitcnt vmcnt(0)" ::: "memory");
            const unsigned og = xb_add(&bar[XB_TOP], 1u);
            const unsigned tg = og / nx;
            if (og + 1u == (tg + 1u) * nx) xb_add(&bar[XB_TOPGEN], 1u);
            else XB_SPIN(xb_ld(&bar[XB_TOPGEN]) == tg, bar);
            __builtin_amdgcn_fence(__ATOMIC_ACQUIRE, "agent");
            xb_add(&bar[XB_XGEN(b.x)], 1u);
            asm volatile("s_waitcnt vmcnt(0)" ::: "memory");
        } else {
            XB_SPIN(xb_ld(&bar[XB_XGEN(b.x)]) == gen, bar);
            __builtin_amdgcn_fence(__ATOMIC_ACQUIRE, "agent");
            asm volatile("s_waitcnt vmcnt(0)" ::: "memory");
        }
    }
    __syncthreads();
}

__global__ void __launch_bounds__(512) fwd_megakernel(Params p) {
    extern __shared__ __attribute__((aligned(16))) unsigned char lds_raw[];
    LAS unsigned char* lds = (LAS unsigned char*)lds_raw;
    cg::grid_group grid = cg::this_grid();
    const int tid = threadIdx.x, lane = tid & 63, wave = __builtin_amdgcn_readfirstlane(tid >> 6);
    const int G = gridDim.x, bx = blockIdx.x;
    const int vcu = (G % 8 == 0) ? (bx % 8) * (G / 8) + bx / 8 : bx;
    const int gw = vcu * 8 + wave, NGW = G * 8;
    unsigned char* ws = p.ws;
    const int lo = p.ph_lo, hi = p.ph_hi;
    volatile LAS unsigned* bst = (volatile LAS unsigned*)(lds + LDS_BYTES - 64);
    if (tid < 2) bst[tid] = 0u;
    __syncthreads();
    const XcdBarrier xbar = xcd_barrier_post((unsigned*)(ws + WS_BAR), bst);
#ifndef P0SEL
#define P0SEL 15
#endif
#ifndef REPMASK
#define REPMASK 0
#endif
#define NREP(k) ((((REPMASK) >> (k)) & 1) ? 2 : 1)
#ifndef P6SEL
#define P6SEL 7
#endif
#ifndef PHMASK
#define PHMASK 0xffff
#endif
#define IN(k) (((PHMASK >> (k)) & 1) && lo <= (k) && (k) < hi)
#define SEAM(k) do { if (IN(k) && IN((k) + 1)) { if ((k) == 0) grid.sync(); else xcd_barrier(xbar); if ((REPMASK >> 15) & 1) xcd_barrier(xbar); } } while (0)
    bf16_t* XN = (bf16_t*)(ws + WS_XN); bf16_t* HB = (bf16_t*)(ws + WS_H);

    if (IN(0)) {
        LAS float* scr = (LAS float*)(lds + wave * 16384);
        constexpr int I_GU = 16 * 176, I_D = 44 * 32, I_INA = 16 * 16, I_INB = 16 * 48, I_UQ = 4 * 24, I_UK = 4 * 16, I_OUT = 16 * 32;
        constexpr int NITEMS = 2 * (I_GU + I_D) + I_INA + I_INB + I_UQ + 2 * I_UK + I_OUT;
        for (int rep = 0; rep < NREP(0); ++rep) if (P0SEL & 1) for (int it = gw; it < NITEMS; it += NGW) {
            int r = it;
            bool done = false;
#pragma unroll
            for (int f = 0; f < 2; ++f) {
                if (done) break;
                const float* wg = p.in[f ? 23 : 2]; const float* wu = p.in[f ? 24 : 3]; const float* wd = p.in[f ? 25 : 4];
                bf16_t* GU = (bf16_t*)(ws + (f ? WS_W2GU : WS_W1GU)); bf16_t* DD = (bf16_t*)(ws + (f ? WS_W2D : WS_W1D));
                if (r < I_GU) { const int kb = r / 176, nb = r - kb * 176, pn = nb >> 3, rb = nb & 7;
                    tr_item(rb < 4 ? wg : wu, FFH, 128 * pn + 32 * (rb & 3), 64 * kb, true, GU, DM, 32 * nb, scr, lane); done = true; break; }
                r -= I_GU;
                if (r < I_D) { const int kb = r / 32, nb = r - kb * 32; tr_item(wd, DM, 32 * nb, 64 * kb, true, DD, FFH, 32 * nb, scr, lane); done = true; break; }
                r -= I_D;
            }
            if (done) continue;
            if (r < I_INA) { const int kb = r / 16, nb = r - kb * 16; tr_item(p.in[6], 1952, 32 * nb, 64 * kb, nb < 13, (bf16_t*)(ws + WS_WINA), DM, 32 * nb, scr, lane); continue; } r -= I_INA;
            if (r < I_INB) { const int kb = r / 48, nb = r - kb * 48; tr_item(p.in[6], 1952, 416 + 32 * nb, 64 * kb, true, (bf16_t*)(ws + WS_WINB), DM, 32 * nb, scr, lane); continue; } r -= I_INB;
            if (r < I_UQ) { const int kb = r / 24, nb = r - kb * 24; tr_item(p.in[8], 768, 32 * nb, 64 * kb, true, (bf16_t*)(ws + WS_WUQ), 256, 32 * nb, scr, lane); continue; } r -= I_UQ;
            if (r < I_UK) { const int kb = r / 16, nb = r - kb * 16; tr_item(p.in[10], 1024, 128 * (nb >> 1) + 32 * (nb & 1), 64 * kb, kb < 2, (bf16_t*)(ws + WS_WUK), 256, 32 * nb, scr, lane); continue; } r -= I_UK;
            if (r < I_UK) { const int kb = r / 16, nb = r - kb * 16; tr_item(p.in[10], 1024, 128 * (nb >> 1) + 64 + 32 * (nb & 1), 64 * kb, kb < 2, (bf16_t*)(ws + WS_WUV), 256, 32 * nb, scr, lane); continue; } r -= I_UK;
            { const int kb = r / 32, nb = r - kb * 32; tr_item(p.in[21], DM, 32 * nb, 64 * kb, true, (bf16_t*)(ws + WS_WOUT), DM, 32 * nb, scr, lane); }
        }
        if (P0SEL & 2) { f32x2_t* tab = (f32x2_t*)(ws + WS_ROPE);
          for (int idx = gw * 64 + lane; idx < SEQ * 16; idx += NGW * 64) { const int s = idx >> 4, i = idx & 15;
              const float inv = exp2f(-(float)i * 0.8304820237218406f); const float ang = (float)s * inv; float sn, cs; sincos_rr(ang, sn, cs); tab[idx] = (f32x2_t){cs, sn}; } }
        __syncthreads();
        if (P0SEL & 4) for (int pb = bx; pb < 256; pb += G) filter_block(p, lds, pb, tid);
        for (int rep = 0; rep < NREP(13); ++rep) if (P0SEL & 8) for (int m = gw; m < MTOK; m += NGW) rms_row_bf16(p.in[0] + (size_t)m * DM, p.in[1], XN + (size_t)m * DM, lane);
    }
    SEAM(0);
    if (IN(1)) for (int rep = 0; rep < NREP(1); ++rep) { __syncthreads(); pg8::Gemm g{XN, (const bf16_t*)(ws + WS_W1GU), MTOK, 2 * FFH, DM}; pg8::StaticOrder S; S.init(MTOK, 2 * FFH, G, bx);
        pg8::EpiSwiGLU E{HB, FFH}; pg8::gemm_phase<pg8::EpiSwiGLU, pg8::StaticOrder>(lds, g, S, E); }
    SEAM(1);
    if (IN(2)) for (int rep = 0; rep < NREP(2); ++rep) { __syncthreads(); pg8::Gemm g{HB, (const bf16_t*)(ws + WS_W1D), MTOK, DM, FFH}; pg8::StaticOrder S; S.init(MTOK, DM, G, bx);
        pg8::EpiResid E{p.in[0], p.out, DM, 0.5f}; pg8::gemm_phase<pg8::EpiResid, pg8::StaticOrder>(lds, g, S, E); }
    SEAM(2);
    if (IN(3)) for (int rep = 0; rep < NREP(3); ++rep) { for (int m = gw; m < MTOK; m += NGW) rms_row_bf16(p.out + (size_t)m * DM, p.in[5], XN + (size_t)m * DM, lane); }
    SEAM(3);
    if (IN(4)) for (int rep = 0; rep < NREP(4); ++rep) { __syncthreads();
        { pg8::Gemm g{XN, (const bf16_t*)(ws + WS_WINA), MTOK, 512, DM}; pg8::StaticOrder S; S.init(MTOK, 512, G, bx);
          pg8::EpiF32 E{(float*)(ws + WS_UA), 512}; pg8::gemm_phase<pg8::EpiF32, pg8::StaticOrder>(lds, g, S, E); }
        { pg8::Gemm g{(const bf16_t*)(ws + WS_WINB), XN, 1536, MTOK, DM}; pg8::StaticOrder S; S.init(1536, MTOK, G, bx);
          pg8::EpiBf16P E{(bf16_t*)(ws + WS_UT), (size_t)MTOK}; pg8::gemm_phase<pg8::EpiBf16P, pg8::StaticOrder>(lds, g, S, E); } }
    SEAM(4);
    if (IN(5)) for (int rep = 0; rep < NREP(5); ++rep) {
        const float* UA = (const float*)(ws + WS_UA); bf16_t* CQN = (bf16_t*)(ws + WS_CQN); bf16_t* CKVN = (bf16_t*)(ws + WS_CKVN); bf16_t* KPE = (bf16_t*)(ws + WS_KPE);
        const f32x2_t* tab = (const f32x2_t*)(ws + WS_ROPE);
        const f32x4 gq = ((const f32x4*)p.in[7])[lane]; const f32x4 gk = lane < 32 ? ((const f32x4*)p.in[9])[lane] : (f32x4){0.f, 0.f, 0.f, 0.f};
        for (int row = gw; row < MTOK; row += NGW) {
            const f32x4* ur = (const f32x4*)(UA + (size_t)row * 512);
            const f32x4 a = ur[lane], bq = ur[64 + lane];
            const float rq = 1.0f / sqrtf(wave_sum((a.x * a.x + a.y * a.y) + (a.z * a.z + a.w * a.w)) * (1.0f / 256.0f) + EPSN);
            u32x2 w; w.x = pk2(a.x * rq * gq.x, a.y * rq * gq.y); w.y = pk2(a.z * rq * gq.z, a.w * rq * gq.w);
            *((u32x2*)(CQN + (size_t)row * 256) + lane) = w;
            const float skv = lane < 32 ? (bq.x * bq.x + bq.y * bq.y) + (bq.z * bq.z + bq.w * bq.w) : 0.f;
            const float rkv = 1.0f / sqrtf(wave_sum(skv) * (1.0f / 128.0f) + EPSN);
            u32x2 wk = (u32x2){0u, 0u};
            if (lane < 32) { wk.x = pk2(bq.x * rkv * gk.x, bq.y * rkv * gk.y); wk.y = pk2(bq.z * rkv * gk.z, bq.w * rkv * gk.w); }
            *((u32x2*)(CKVN + (size_t)row * 256) + lane) = wk;
            f32x4 pr; pr.x = __shfl_xor(bq.x, 4); pr.y = __shfl_xor(bq.y, 4); pr.z = __shfl_xor(bq.z, 4); pr.w = __shfl_xor(bq.w, 4);
            if (lane >= 32 && lane < 40) { const int pos = row & 4095; const bool first = lane < 36; const int i0 = 4 * ((lane - 32) & 3);
                float ov[4];
#pragma unroll
                for (int e = 0; e < 4; ++e) { const f32x2_t cs = tab[pos * 16 + i0 + e]; const float x1 = first ? bq[e] : pr[e], x2 = first ? pr[e] : bq[e]; ov[e] = first ? x1 * cs.x - x2 * cs.y : x1 * cs.y + x2 * cs.x; }
                u32x2 wo; wo.x = pk2(ov[0], ov[1]); wo.y = pk2(ov[2], ov[3]);
                *(u32x2*)(KPE + (size_t)row * 32 + 4 * (lane - 32)) = wo; }
        }
    }
    SEAM(5);
    if (IN(6)) for (int rep = 0; rep < NREP(6); ++rep) { __syncthreads();
        if (P6SEL & 1) { pg8::Gemm g{(const bf16_t*)(ws + WS_CQN), (const bf16_t*)(ws + WS_WUQ), MTOK, 768, 256}; pg8::StaticOrder S; S.init(MTOK, 768, G, bx);
          pg8::EpiF32 E{(float*)(ws + WS_Q), 768}; pg8::gemm_phase<pg8::EpiF32, pg8::StaticOrder>(lds, g, S, E); }
        if (P6SEL & 2) { pg8::Gemm g{(const bf16_t*)(ws + WS_CKVN), (const bf16_t*)(ws + WS_WUK), MTOK, 512, 256}; pg8::StaticOrder S; S.init(MTOK, 512, G, bx);
          pg8::EpiBf16P E{(bf16_t*)(ws + WS_KN), (size_t)512}; pg8::gemm_phase<pg8::EpiBf16P, pg8::StaticOrder>(lds, g, S, E); }
        if (P6SEL & 4) { pg8::Gemm g{(const bf16_t*)(ws + WS_WUV), (const bf16_t*)(ws + WS_CKVN), 512, MTOK, 256}; pg8::StaticOrder S; S.init(512, MTOK, G, bx);
          pg8::EpiBf16P E{(bf16_t*)(ws + WS_VT), (size_t)MTOK}; pg8::gemm_phase<pg8::EpiBf16P, pg8::StaticOrder>(lds, g, S, E); } }
    SEAM(6);
    if (IN(7)) { __syncthreads();
        for (int rep = 0; rep < NREP(7); ++rep) for (int u = vcu; u < 1024; u += G) attn_unit(p, lds, u, tid, lane, wave);
        __syncthreads();
        for (int rep = 0; rep < NREP(14); ++rep) for (int c = bx; c < 512; c += G) hyena_channel(p, lds, c, tid, lane, wave);
    }
    SEAM(7);
    if (IN(8)) for (int rep = 0; rep < NREP(8); ++rep) {
        const bf16_t* HYT = (const bf16_t*)(ws + WS_HYT); bf16_t* MIXN = (bf16_t*)(ws + WS_MIXN); const float* hg = p.in[20] + 512;
        for (int it = gw; it < 8 * (MTOK / 64); it += NGW) { const int grp = it & 7, row = (it >> 3) * 64 + lane;
            float v[64]; float ss = 0.f;
#pragma unroll
            for (int cc = 0; cc < 64; ++cc) { v[cc] = bf2f(HYT[(size_t)(64 * grp + cc) * MTOK + row]); ss += v[cc] * v[cc]; }
            const float rstd = 1.0f / sqrtf(ss * (1.0f / 64.0f) + EPSN);
            bf16_t* dst = MIXN + (size_t)row * 1024 + 512 + 64 * grp;
#pragma unroll
            for (int k = 0; k < 8; ++k) { const float* gp = hg + 64 * grp + 8 * k;
                u32x4 w; w.x = pk2(v[8 * k] * rstd * gp[0], v[8 * k + 1] * rstd * gp[1]); w.y = pk2(v[8 * k + 2] * rstd * gp[2], v[8 * k + 3] * rstd * gp[3]);
                w.z = pk2(v[8 * k + 4] * rstd * gp[4], v[8 * k + 5] * rstd * gp[5]); w.w = pk2(v[8 * k + 6] * rstd * gp[6], v[8 * k + 7] * rstd * gp[7]);
                *(u32x4*)(dst + 8 * k) = w; } }
    }
    SEAM(8);
    if (IN(9)) { __syncthreads(); pg8::Gemm g{(const bf16_t*)(ws + WS_MIXN), (const bf16_t*)(ws + WS_WOUT), MTOK, DM, DM}; pg8::StaticOrder S; S.init(MTOK, DM, G, bx);
        pg8::EpiResid E{p.out, p.out, DM, 1.0f}; pg8::gemm_phase<pg8::EpiResid, pg8::StaticOrder>(lds, g, S, E); }
    SEAM(9);
    if (IN(10)) for (int rep = 0; rep < NREP(10); ++rep) { for (int m = gw; m < MTOK; m += NGW) rms_row_bf16(p.out + (size_t)m * DM, p.in[22], XN + (size_t)m * DM, lane); }
    SEAM(10);
    if (IN(11)) for (int rep = 0; rep < NREP(11); ++rep) { __syncthreads(); pg8::Gemm g{XN, (const bf16_t*)(ws + WS_W2GU), MTOK, 2 * FFH, DM}; pg8::StaticOrder S; S.init(MTOK, 2 * FFH, G, bx);
        pg8::EpiSwiGLU E{HB, FFH}; pg8::gemm_phase<pg8::EpiSwiGLU, pg8::StaticOrder>(lds, g, S, E); }
    SEAM(11);
    if (IN(12)) { __syncthreads(); pg8::Gemm g{HB, (const bf16_t*)(ws + WS_W2D), MTOK, DM, FFH}; pg8::StaticOrder S; S.init(MTOK, DM, G, bx);
        pg8::EpiResid E{p.out, p.out, DM, 0.5f}; pg8::gemm_phase<pg8::EpiResid, pg8::StaticOrder>(lds, g, S, E); }
    SEAM(12);
    if (IN(13)) {
        const f32x4* gr = (const f32x4*)p.in[26] + lane;
        for (int m = gw; m < MTOK; m += NGW) { f32x4* xr = (f32x4*)(p.out + (size_t)m * DM) + lane; f32x4 v[4]; float s = 0.f;
#pragma unroll
            for (int j = 0; j < 4; ++j) { v[j] = xr[64 * j]; s += (v[j].x * v[j].x + v[j].y * v[j].y) + (v[j].z * v[j].z + v[j].w * v[j].w); }
            const float rstd = 1.0f / sqrtf(wave_sum(s) * (1.0f / DM) + EPSN);
#pragma unroll
            for (int j = 0; j < 4; ++j) xr[64 * j] = v[j] * rstd * gr[64 * j]; }
    }
#undef IN
#undef SEAM
}

#ifndef ONE_LAUNCH
#define ONE_LAUNCH 1
#endif
extern "C" void kernel_launch(void* const* d_in, const int* in_sizes, int n_in, void* d_out, int out_size, void* d_ws, size_t ws_size, hipStream_t stream) {
    static int grid = 0;
    if (grid == 0) {
        if (n_in != 27 || ws_size < WS_END) { fprintf(stderr, "kernel_launch: unexpected n_in %d or ws_size %zu\n", n_in, ws_size); grid = -1; return; }
        int dev = 0, cus = 0, per_cu = 0;
        (void)hipGetDevice(&dev); (void)hipDeviceGetAttribute(&cus, hipDeviceAttributeMultiprocessorCount, dev);
        if (hipFuncSetAttribute((const void*)fwd_megakernel, hipFuncAttributeMaxDynamicSharedMemorySize, LDS_BYTES) != hipSuccess) { fprintf(stderr, "kernel_launch: hipFuncSetAttribute failed\n"); grid = -1; return; }
        if (hipOccupancyMaxActiveBlocksPerMultiprocessor(&per_cu, (const void*)fwd_megakernel, 512, LDS_BYTES) != hipSuccess || per_cu < 1) { fprintf(stderr, "kernel_launch: occupancy query says %d\n", per_cu); (void)hipGetLastError(); grid = -1; return; }
        grid = cus;
    }
    if (grid < 0) return;
    (void)hipMemsetAsync((char*)d_ws + WS_CTL, 0, CTL_ZERO, stream);
    Params p{};
    for (int i = 0; i < 27; ++i) p.in[i] = (const float*)d_in[i];
    p.out = (float*)d_out; p.ws = (unsigned char*)d_ws;
#if ONE_LAUNCH
    p.ph_lo = 0; p.ph_hi = NPHASE;
    void* args[] = {&p};
    hipError_t e = hipLaunchCooperativeKernel((const void*)fwd_megakernel, dim3(grid), dim3(512), args, LDS_BYTES, stream);
    if (e != hipSuccess) fprintf(stderr, "cooperative launch failed: %s (grid %d)\n", hipGetErrorString(e), grid);
#else
    for (int k = 0; k < NPHASE; ++k) { p.ph_lo = k; p.ph_hi = k + 1; hipLaunchKernelGGL(fwd_megakernel, dim3(grid), dim3(512), LDS_BYTES, stream, p); }
#endif
}
```

```cpp
#include <hip/hip_runtime.h>
#include <hip/hip_cooperative_groups.h>
#include <cstdio>
namespace cg = cooperative_groups;
namespace pg8 {
#define PG8_LAS __attribute__((address_space(3)))
typedef unsigned short bf16_t;
typedef short bf16x8 __attribute__((ext_vector_type(8)));
typedef float f32x4 __attribute__((ext_vector_type(4)));
typedef unsigned u32x4 __attribute__((ext_vector_type(4)));
constexpr int BM = 256, BK = 64, HALF = 128, HTB = HALF * BK * 2  , STAGE_BYTES = 8 * HTB, NXCD = 8, WGM = 8;

__host__ __device__ __forceinline__ int lds_byte(int r, int c) { const int st = (r >> 4) * 2 + (c >> 5), rr = r & 15, cc = c & 31, ob = rr * 64 + cc * 2; return st * 1024 + (ob ^ (((ob >> 9) & 1) << 5)); }
__host__ __device__ __forceinline__ void stage_rc(int b, int& R, int& C) { const int st = b / 1024, sb = b % 1024, swz = sb ^ (((sb >> 9) & 1) << 5); R = (st >> 1) * 16 + swz / 64; C = (st & 1) * 32 + (swz % 64) / 2; }
__host__ __device__ __forceinline__ int perm32(int rho) { const int n = rho >> 4, i = rho & 15; return 8 * (i >> 2) + 4 * n + (i & 3); }

struct Unit { int pm, pn; };
struct Gemm { const bf16_t* A; const bf16_t* Bt; int M, N, K; };

struct StaticOrder {
    int nM, nN, nwg, G, c;
    __host__ __device__ void init(int M, int N, int G_, int c_) { nM = M / BM; nN = N / BM; nwg = nM * nN; G = G_; c = c_; }
    __host__ __device__ bool next(int i, Unit& u) const {
        const long L = (long)i * G + c; if (L >= nwg) return false;
        int wgid = (int)L; { const int q = nwg / NXCD, r = nwg % NXCD, xcd = wgid % NXCD, off = wgid / NXCD; wgid = (xcd < r ? xcd * (q + 1) : r * (q + 1) + (xcd - r) * q) + off; }
        const int nig = WGM * nN, gid = wgid / nig, fm = gid * WGM, gsz = (nM - fm) < WGM ? (nM - fm) : WGM;
        u.pm = fm + ((wgid % nig) % gsz); u.pn = (wgid % nig) / gsz; return true;
    }
    __device__ __forceinline__ void a_ready(const Unit&) const {}
    __device__ __forceinline__ void done(const Unit&) const {}
};
typedef unsigned u32x2 __attribute__((ext_vector_type(2)));
typedef __bf16 bf16x2_t __attribute__((ext_vector_type(2)));
typedef float f32x2_t __attribute__((ext_vector_type(2)));
__device__ __forceinline__ unsigned pk2(float lo, float hi) { f32x2_t v = {lo, hi}; bf16x2_t b = __builtin_convertvector(v, bf16x2_t); return __builtin_bit_cast(unsigned, b); }
__device__ __forceinline__ float silu_mul(float g, float u) { return g * __builtin_amdgcn_rcpf(1.0f + __expf(-g)) * u; }
struct EpiSwiGLU {
    static constexpr bool PERM = true, AFTER_DRAIN = false;
    bf16_t* H; int ldh;
    __device__ __forceinline__ void operator()(const f32x4 (&acc)[2][2][4][2], const Unit& u, int wr, int wc, int fr, int fq) const {
        const int row0 = u.pm * BM + wr * 64 + fr, col0 = u.pn * HALF + wc * 32 + 8 * fq;
#pragma unroll
        for (int ai = 0; ai < 2; ++ai)
#pragma unroll
            for (int m = 0; m < 4; ++m) { bf16_t* rowp = H + (size_t)(row0 + ai * HALF + m * 16) * ldh + col0;
                const f32x4 g0 = acc[ai][0][m][0], g1 = acc[ai][0][m][1], u0 = acc[ai][1][m][0], u1 = acc[ai][1][m][1];
                u32x4 w; w.x = pk2(silu_mul(g0[0], u0[0]), silu_mul(g0[1], u0[1])); w.y = pk2(silu_mul(g0[2], u0[2]), silu_mul(g0[3], u0[3]));
                w.z = pk2(silu_mul(g1[0], u1[0]), silu_mul(g1[1], u1[1])); w.w = pk2(silu_mul(g1[2], u1[2]), silu_mul(g1[3], u1[3]));
                *(u32x4*)rowp = w; }
    }
};
struct EpiResid {
    static constexpr bool PERM = false, AFTER_DRAIN = false;
    const float* base; float* out; int ldc; float alpha;
    __device__ __forceinline__ void operator()(const f32x4 (&acc)[2][2][4][2], const Unit& u, int wr, int wc, int fr, int fq) const {
        const int row0 = u.pm * BM + wr * 64 + fr, col0 = u.pn * BM + wc * 32 + 4 * fq;
#pragma unroll
        for (int ai = 0; ai < 2; ++ai)
#pragma unroll
            for (int m = 0; m < 4; ++m) { const size_t off = (size_t)(row0 + ai * HALF + m * 16) * ldc + col0;
#pragma unroll
                for (int bj = 0; bj < 2; ++bj)
#pragma unroll
                    for (int n = 0; n < 2; ++n) { const size_t o = off + bj * HALF + n * 16; const f32x4 b = *(const f32x4*)(base + o); *(f32x4*)(out + o) = b + alpha * acc[ai][bj][m][n]; }
                asm volatile("" ::: "memory"); }
    }
};
struct EpiUA {
    static constexpr bool PERM = false, AFTER_DRAIN = true;
    bf16_t* CQN; bf16_t* CKVN; bf16_t* KPE; const float* qg; const float* kvg; const f32x2_t* tab;
    __device__ __forceinline__ void fused(f32x4 (&acc)[2][2][4][2], const Unit& u, int wr, int wc, int fr, int fq, PG8_LAS unsigned char* lds, int wid, int lane) const {
        PG8_LAS float* P = (PG8_LAS float*)lds;
        const bool isq = (u.pn == 0);
#pragma unroll
        for (int ai = 0; ai < 2; ++ai)
#pragma unroll
            for (int m = 0; m < 4; ++m) { float sq = 0.f;
#pragma unroll
                for (int bj = 0; bj < 2; ++bj) if (isq || bj == 0)
#pragma unroll
                    for (int n = 0; n < 2; ++n) { const f32x4 v = acc[ai][bj][m][n]; sq += (v[0] * v[0] + v[1] * v[1]) + (v[2] * v[2] + v[3] * v[3]); }
                sq += __shfl_xor(sq, 16); sq += __shfl_xor(sq, 32);
                if (fq == 0) P[(ai * HALF + wr * 64 + m * 16 + fr) * 4 + wc] = sq; }
        __syncthreads();
        const float invn = isq ? (1.0f / 256.0f) : (1.0f / 128.0f);
        const int row0 = u.pm * BM + wr * 64 + fr;
#pragma unroll
        for (int ai = 0; ai < 2; ++ai)
#pragma unroll
            for (int m = 0; m < 4; ++m) { const int lr = ai * HALF + wr * 64 + m * 16 + fr, row = u.pm * BM + lr;
                const f32x4 pp = *(const PG8_LAS f32x4*)(P + lr * 4);
                const float rstd = 1.0f / sqrtf(((pp[0] + pp[1]) + (pp[2] + pp[3])) * invn + 1e-6f);
#pragma unroll
                for (int bj = 0; bj < 2; ++bj)
#pragma unroll
                    for (int n = 0; n < 2; ++n) { const int col = bj * HALF + wc * 32 + n * 16 + 4 * fq; const f32x4 v = acc[ai][bj][m][n];
                        u32x2 w = (u32x2){0u, 0u};
                        if (isq) { const f32x4 g = *(const f32x4*)(qg + col); w.x = pk2(v[0] * rstd * g[0], v[1] * rstd * g[1]); w.y = pk2(v[2] * rstd * g[2], v[3] * rstd * g[3]); *(u32x2*)(CQN + (size_t)row * 256 + col) = w; }
                        else { if (bj == 0) { const f32x4 g = *(const f32x4*)(kvg + col); w.x = pk2(v[0] * rstd * g[0], v[1] * rstd * g[1]); w.y = pk2(v[2] * rstd * g[2], v[3] * rstd * g[3]); }
                               *(u32x2*)(CKVN + (size_t)row * 256 + col) = w; } }
                if (!isq && wc == 0) { const int pos = row & 4095; const f32x4 x1 = acc[ai][1][m][0], x2 = acc[ai][1][m][1]; float y1[4], y2[4];
#pragma unroll
                    for (int e = 0; e < 4; ++e) { const f32x2_t cs = tab[pos * 16 + 4 * fq + e]; y1[e] = x1[e] * cs.x - x2[e] * cs.y; y2[e] = x1[e] * cs.y + x2[e] * cs.x; }
                    u32x2 a; a.x = pk2(y1[0], y1[1]); a.y = pk2(y1[2], y1[3]); u32x2 b; b.x = pk2(y2[0], y2[1]); b.y = pk2(y2[2], y2[3]);
                    *(u32x2*)(KPE + (size_t)row * 32 + 4 * fq) = a; *(u32x2*)(KPE + (size_t)row * 32 + 16 + 4 * fq) = b; }
                asm volatile("" ::: "memory"); }
        __syncthreads();
    }
};
struct EpiF32 {
    static constexpr bool PERM = false, AFTER_DRAIN = false;
    float* C; int ldc;
    __device__ __forceinline__ void operator()(const f32x4 (&acc)[2][2][4][2], const Unit& u, int wr, int wc, int fr, int fq) const {
        const int row0 = u.pm * BM + wr * 64 + fr, col0 = u.pn * BM + wc * 32 + 4 * fq;
#pragma unroll
        for (int ai = 0; ai < 2; ++ai)
#pragma unroll
            for (int m = 0; m < 4; ++m) { float* rowp = C + (size_t)(row0 + ai * HALF + m * 16) * ldc + col0;
#pragma unroll
                for (int bj = 0; bj < 2; ++bj)
#pragma unroll
                    for (int n = 0; n < 2; ++n) *(f32x4*)(rowp + bj * HALF + n * 16) = acc[ai][bj][m][n]; }
    }
};
struct EpiBf16P {
    static constexpr bool PERM = true, AFTER_DRAIN = false;
    bf16_t* O; size_t ldc;
    __device__ __forceinline__ void operator()(const f32x4 (&acc)[2][2][4][2], const Unit& u, int wr, int wc, int fr, int fq) const {
        const int row0 = u.pm * BM + wr * 64 + fr, col0 = u.pn * BM + wc * 32 + 8 * fq;
#pragma unroll
        for (int ai = 0; ai < 2; ++ai)
#pragma unroll
            for (int m = 0; m < 4; ++m) { bf16_t* rowp = O + (size_t)(row0 + ai * HALF + m * 16) * ldc + col0;
#pragma unroll
                for (int bj = 0; bj < 2; ++bj) { const f32x4 v0 = acc[ai][bj][m][0], v1 = acc[ai][bj][m][1];
                    u32x4 w; w.x = pk2(v0[0], v0[1]); w.y = pk2(v0[2], v0[3]); w.z = pk2(v1[0], v1[1]); w.w = pk2(v1[2], v1[3]);
                    *(u32x4*)(rowp + bj * HALF) = w; } }
    }
};
struct EpiQ {
    static constexpr bool PERM = false, AFTER_DRAIN = false;
    bf16_t* Q; const f32x2_t* tab; float scale;
    __device__ __forceinline__ void operator()(const f32x4 (&acc)[2][2][4][2], const Unit& u, int wr, int wc, int fr, int fq) const {
        const int row0 = u.pm * BM + wr * 64 + fr, colb = u.pn * BM + wc * 32;
#pragma unroll
        for (int ai = 0; ai < 2; ++ai)
#pragma unroll
            for (int m = 0; m < 4; ++m) { const int row = row0 + ai * HALF + m * 16, pos = row & 4095;
#pragma unroll
                for (int bj = 0; bj < 2; ++bj) { const int cgp = colb + bj * HALF; const bool pe = ((cgp >> 5) % 3) == 2;
                    f32x4 a = acc[ai][bj][m][0], b = acc[ai][bj][m][1];
                    if (pe) {
#pragma unroll
                        for (int e = 0; e < 4; ++e) { const f32x2_t cs = tab[pos * 16 + 4 * fq + e]; const float x1 = a[e], x2 = b[e]; a[e] = x1 * cs.x - x2 * cs.y; b[e] = x1 * cs.y + x2 * cs.x; } }
                    a = a * scale; b = b * scale;
                    bf16_t* qp = Q + (size_t)row * 768 + cgp + 4 * fq;
                    u32x2 w0; w0.x = pk2(a[0], a[1]); w0.y = pk2(a[2], a[3]); *(u32x2*)qp = w0;
                    u32x2 w1; w1.x = pk2(b[0], b[1]); w1.y = pk2(b[2], b[3]); *(u32x2*)(qp + 16) = w1;
                    asm volatile("" ::: "memory"); } }
    }
};
template <class Epi, class Sched>
__device__ __forceinline__ void gemm_phase(PG8_LAS unsigned char* lds, const Gemm g, const Sched& S, const Epi& E) {
    const int tid = threadIdx.x, wid = __builtin_amdgcn_readfirstlane(tid >> 6), lane = tid & 63, wr = wid >> 2, wc = wid & 3, fr = lane & 15, fq = lane >> 4;
    const int K = g.K, nt = K / BK;
    unsigned voffA[2], voffB[2];
#pragma unroll
    for (int i = 0; i < 2; ++i) { int R, C; stage_rc(tid * 16 + i * 8192, R, C); const int Rb = Epi::PERM ? ((R & ~31) + perm32(R & 31)) : R;
        voffA[i] = (unsigned)(R * K + C) * 2u; voffB[i] = (unsigned)(Rb * K + C) * 2u; }
    const size_t kstep = (size_t)(BK * 2);
    const size_t hstep = (size_t)HALF * K * 2;
    const size_t tstep = 2 * hstep;
    const unsigned ldsw = (unsigned)wid * 1024u;
    const int aoff = lds_byte(wr * 64 + fr, fq * 8), boff = lds_byte(wc * 32 + fr, fq * 8);
#define PG8_SA(b, h) (((b) * 2 + (h)) * HTB)
#define PG8_SB(b, h) ((4 + (b) * 2 + (h)) * HTB)
#define PG8_STAGE(bufoff, gbase, voff) do { _Pragma("unroll") for (int _i = 0; _i < 2; ++_i) \
        __builtin_amdgcn_global_load_lds((const unsigned*)((const char*)(gbase) + (voff)[_i]), (PG8_LAS unsigned*)(lds + (bufoff) + ldsw + _i * 8192), 16, 0, 0); } while (0)
#define PG8_LDA(dst, b, h) do { _Pragma("unroll") for (int m = 0; m < 4; ++m) _Pragma("unroll") for (int k = 0; k < 2; ++k) dst[m][k] = *(const PG8_LAS bf16x8*)(lds + PG8_SA(b, h) + aoff + m * 2048 + k * 1024); } while (0)
#define PG8_LDB(dst, b, h) do { _Pragma("unroll") for (int n = 0; n < 2; ++n) _Pragma("unroll") for (int k = 0; k < 2; ++k) dst[n][k] = *(const PG8_LAS bf16x8*)(lds + PG8_SB(b, h) + boff + n * 2048 + k * 1024); } while (0)
#define PG8_MMA(ai, bj, At, Bt) do { __builtin_amdgcn_s_setprio(1); _Pragma("unroll") for (int m = 0; m < 4; ++m) _Pragma("unroll") for (int n = 0; n < 2; ++n) _Pragma("unroll") for (int k = 0; k < 2; ++k) \
        acc[ai][bj][m][n] = __builtin_amdgcn_mfma_f32_16x16x32_bf16(Bt[n][k], At[m][k], acc[ai][bj][m][n], 0, 0, 0); __builtin_amdgcn_s_setprio(0); } while (0)
#define PG8_WAIT_V(n) asm volatile("s_waitcnt vmcnt(" #n ")" ::: "memory")
#define PG8_WAIT_L(n) asm volatile("s_waitcnt lgkmcnt(" #n ")" ::: "memory")
#define PG8_BAR __builtin_amdgcn_s_barrier()
#define PG8_SCHED __builtin_amdgcn_sched_barrier(0)
    Unit cur, nxt; int ui = 0;
    if (!S.next(0, cur)) return;
    f32x4 acc[2][2][4][2];
#pragma unroll
    for (int a = 0; a < 2; ++a)
#pragma unroll
        for (int b = 0; b < 2; ++b)
#pragma unroll
            for (int m = 0; m < 4; ++m)
#pragma unroll
                for (int n = 0; n < 2; ++n) acc[a][b][m][n] = (f32x4){0.f, 0.f, 0.f, 0.f};
    bf16x8 At[4][2], B0[2][2], B1[2][2];
    const char* cA = (const char*)g.A + (size_t)cur.pm * tstep; const char* cB = (const char*)g.Bt + (size_t)cur.pn * tstep;
    S.a_ready(cur);
    PG8_STAGE(PG8_SB(0, 0), cB, voffB); PG8_STAGE(PG8_SA(0, 0), cA, voffA); PG8_STAGE(PG8_SB(0, 1), cB + hstep, voffB); PG8_STAGE(PG8_SA(0, 1), cA + hstep, voffA);
    if (wr == 1) PG8_BAR;
    PG8_WAIT_V(4); PG8_BAR;
    PG8_STAGE(PG8_SB(1, 0), cB + kstep, voffB); PG8_STAGE(PG8_SA(1, 0), cA + kstep, voffA); PG8_STAGE(PG8_SB(1, 1), cB + hstep + kstep, voffB);
    PG8_WAIT_V(6); PG8_BAR;
    for (;;) {
        const bool has_next = S.next(ui + 1, nxt);
        const char* nA = has_next ? (const char*)g.A + (size_t)nxt.pm * tstep : cA; const char* nB = has_next ? (const char*)g.Bt + (size_t)nxt.pn * tstep : cB;
        for (int t = 0; t < nt; t += 2) {
            const bool last = (t == nt - 2);
            const char* a1 = cA + (size_t)(t + 1) * kstep;
            const char* a2 = last ? nA : cA + (size_t)(t + 2) * kstep; const char* b2 = last ? nB : cB + (size_t)(t + 2) * kstep;
            const char* a3 = a2 + kstep; const char* b3 = b2 + kstep;
            if (last && has_next) S.a_ready(nxt);
            PG8_LDB(B0, 0, 0); PG8_SCHED; PG8_LDA(At, 0, 0); PG8_STAGE(PG8_SA(1, 1), a1 + hstep, voffA);
            PG8_WAIT_L(8); PG8_BAR; PG8_WAIT_L(0); PG8_MMA(0, 0, At, B0); PG8_BAR; PG8_SCHED;
            PG8_LDB(B1, 0, 1); PG8_STAGE(PG8_SB(0, 0), b2, voffB);
            PG8_BAR; PG8_WAIT_L(0); PG8_MMA(0, 1, At, B1); PG8_BAR;
            PG8_LDA(At, 0, 1); PG8_STAGE(PG8_SA(0, 0), a2, voffA);
            PG8_BAR; PG8_WAIT_L(0); PG8_MMA(1, 0, At, B0); PG8_BAR; PG8_SCHED;
            PG8_STAGE(PG8_SB(0, 1), b2 + hstep, voffB);
            PG8_WAIT_V(6); PG8_BAR; PG8_MMA(1, 1, At, B1); PG8_BAR;
            PG8_LDB(B0, 1, 0); PG8_SCHED; PG8_LDA(At, 1, 0); PG8_STAGE(PG8_SA(0, 1), a2 + hstep, voffA);
            PG8_WAIT_L(8); PG8_BAR; PG8_WAIT_L(0); PG8_MMA(0, 0, At, B0); PG8_BAR; PG8_SCHED;
            PG8_LDB(B1, 1, 1); PG8_STAGE(PG8_SB(1, 0), b3, voffB);
            PG8_BAR; PG8_WAIT_L(0); PG8_MMA(0, 1, At, B1); PG8_BAR;
            PG8_LDA(At, 1, 1); PG8_STAGE(PG8_SA(1, 0), a3, voffA);
            PG8_BAR; PG8_WAIT_L(0); PG8_MMA(1, 0, At, B0); PG8_BAR; PG8_SCHED;
            PG8_STAGE(PG8_SB(1, 1), b3 + hstep, voffB);
            PG8_WAIT_V(6); PG8_BAR; PG8_MMA(1, 1, At, B1); PG8_BAR;
        }
        if constexpr (!Epi::AFTER_DRAIN) { E(acc, cur, wr, wc, fr, fq); S.done(cur); }
        if (!has_next) break;
#pragma unroll
        for (int a = 0; a < 2; ++a)
#pragma unroll
            for (int b = 0; b < 2; ++b)
#pragma unroll
                for (int m = 0; m < 4; ++m)
#pragma unroll
                    for (int n = 0; n < 2; ++n) acc[a][b][m][n] = (f32x4){0.f, 0.f, 0.f, 0.f};
        cur = nxt; cA = nA; cB = nB; ++ui;
    }
    PG8_WAIT_V(0);
    if (wr == 0) PG8_BAR;
    PG8_BAR;
    if constexpr (Epi::AFTER_DRAIN) { E.fused(acc, cur, wr, wc, fr, fq, lds, wid, lane); S.done(cur); }
#undef PG8_SA
#undef PG8_SB
#undef PG8_STAGE
#undef PG8_LDA
#undef PG8_LDB
#undef PG8_MMA
#undef PG8_WAIT_V
#undef PG8_WAIT_L
#undef PG8_BAR
#undef PG8_SCHED
}
}

#define LAS __attribute__((address_space(3)))
using pg8::bf16_t; using pg8::bf16x8; using pg8::f32x4; using pg8::u32x4; using pg8::u32x2; using pg8::f32x2_t; using pg8::pk2;
typedef float f32x16 __attribute__((ext_vector_type(16)));
constexpr int MTOK = 32768, DM = 1024, FFH = 2816, SEQ = 4096, NB = 8;
constexpr float EPSN = 1e-6f;
constexpr size_t MiB = 1u << 20;
constexpr size_t WS_CTL = 0, WS_BAR = 16384, CTL_ZERO = 32768;
constexpr size_t WS_W1GU = 2 * MiB, WS_W1D = 13 * MiB, WS_W2GU = 19 * MiB, WS_W2D = 30 * MiB;
constexpr size_t WS_WINA = 36 * MiB, WS_WINB = 37 * MiB, WS_WUQ = 40 * MiB, WS_WUK = 41 * MiB, WS_WUV = 41 * MiB + 512 * 1024, WS_WOUT = 42 * MiB;
constexpr size_t WS_ROPE = 44 * MiB, WS_FILT = 46 * MiB, WS_XN = 80 * MiB, WS_H = 144 * MiB;
constexpr size_t WS_UA = 144 * MiB, WS_UT = 208 * MiB, WS_KPE = 304 * MiB;
constexpr size_t WS_CQN = 320 * MiB, WS_CKVN = 336 * MiB, WS_Q = 352 * MiB  , WS_KN = 448 * MiB, WS_VT = 480 * MiB, WS_HYT = WS_UA  , WS_END = 512 * MiB;
constexpr size_t WS_MIXN = WS_XN;
constexpr int LDS_BYTES = 147456;
constexpr int NPHASE = 14;

__device__ __forceinline__ float wave_sum(float v) {
#pragma unroll
    for (int o = 1; o < 64; o <<= 1) v += __shfl_xor(v, o);
    return v;
}
__device__ __forceinline__ float bf2f(unsigned short b) { return __uint_as_float(((unsigned)b) << 16); }
__device__ __forceinline__ f32x16 mfma32(bf16x8 a, bf16x8 b, f32x16 c) { return __builtin_amdgcn_mfma_f32_32x32x16_bf16(a, b, c, 0, 0, 0); }
__device__ __forceinline__ void sincos_rr(float x, float& sn, float& cs) {
    const float n = rintf(x * 0.15915494309189535f);
    float r = fmaf(-n, 6.2831854820251465f, x); r = fmaf(-n, -1.7484555314695172e-7f, r);
    sn = __sinf(r); cs = __cosf(r);
}
#define LDS_WAIT() asm volatile("s_waitcnt lgkmcnt(0)" ::: "memory")

struct Params { const float* in[27]; float* out; unsigned char* ws; int ph_lo, ph_hi; };

__device__ __forceinline__ void tr_item(const float* src, int ldsrc, int scol0, int k0, bool valid, bf16_t* dst, int lddst, int drow0, LAS float* scr, int lane) {
    if (valid) {
#pragma unroll 8
        for (int i = 0; i < 32; ++i) { const int kk = 2 * i + (lane >> 5); scr[kk * 33 + (lane & 31)] = src[(size_t)(k0 + kk) * ldsrc + scol0 + (lane & 31)]; }
    } else {
#pragma unroll 8
        for (int i = 0; i < 32; ++i) { const int kk = 2 * i + (lane >> 5); scr[kk * 33 + (lane & 31)] = 0.f; }
    }
    LDS_WAIT();
    const int c = lane & 7;
#pragma unroll
    for (int j = 0; j < 4; ++j) { const int n = (lane >> 3) + 8 * j; const LAS float* s = scr + (8 * c) * 33 + n;
        u32x4 o; o.x = pk2(s[0 * 33], s[1 * 33]); o.y = pk2(s[2 * 33], s[3 * 33]); o.z = pk2(s[4 * 33], s[5 * 33]); o.w = pk2(s[6 * 33], s[7 * 33]);
        *(u32x4*)(dst + (size_t)(drow0 + n) * lddst + k0 + 8 * c) = o; }
    LDS_WAIT();
}

__device__ __forceinline__ void rms_row_bf16(const float* xrow, const float* g, bf16_t* orow, int lane) {
    const f32x4* xr = (const f32x4*)xrow + lane; const f32x4* gr = (const f32x4*)g + lane;
    f32x4 v[4]; float s = 0.f;
#pragma unroll
    for (int j = 0; j < 4; ++j) { v[j] = xr[64 * j]; s += (v[j].x * v[j].x + v[j].y * v[j].y) + (v[j].z * v[j].z + v[j].w * v[j].w); }
    const float rstd = 1.0f / sqrtf(wave_sum(s) * (1.0f / DM) + EPSN);
    u32x2* o8 = (u32x2*)orow + lane;
#pragma unroll
    for (int j = 0; j < 4; ++j) { const f32x4 gv = gr[64 * j]; u32x2 w; w.x = pk2(v[j].x * rstd * gv.x, v[j].y * rstd * gv.y); w.y = pk2(v[j].z * rstd * gv.z, v[j].w * rstd * gv.w); o8[64 * j] = w; }
}

__device__ __forceinline__ void filter_block(const Params& p, LAS unsigned char* lds, int pb, int tid) {
    LAS float* z = (LAS float*)(lds + 131072); LAS float* h1 = z + 528; LAS float* h2 = h1 + 1024;
    const float *w1 = p.in[13], *b1 = p.in[14], *w2 = p.in[15], *b2 = p.in[16], *w3 = p.in[17], *fr = p.in[18];
    float* FILT = (float*)(p.ws + WS_FILT); float* NORM = (float*)(p.ws + WS_CTL);
    for (int idx = tid; idx < 528; idx += 512) { const int pp = idx / 33, e = idx - pp * 33; const float t = (float)(pb * 16 + pp);
        float v;
        if (e == 0) v = t / 4095.0f;
        else { const int j = (e - 1) & 15; const float band = 1e-4f + (float)j * ((15.0f - 1e-4f) / 15.0f); const float ang = (6.283185307179586f * t / 4096.0f) * band; float sn, cs; sincos_rr(ang, sn, cs); v = (e <= 16) ? cs : -sn; }
        z[idx] = v; }
    __syncthreads();
    for (int idx = tid; idx < 1024; idx += 512) { const int pp = idx >> 6, j = idx & 63; float a = b1[j];
#pragma unroll 3
        for (int e = 0; e < 33; ++e) a += z[pp * 33 + e] * w1[e * 64 + j];
        float sn, cs; sincos_rr(fr[j] * a, sn, cs); h1[idx] = sn; }
    __syncthreads();
    for (int idx = tid; idx < 1024; idx += 512) { const int pp = idx >> 6, j = idx & 63; float a = b2[j];
#pragma unroll 4
        for (int i = 0; i < 64; ++i) a += h1[pp * 64 + i] * w2[i * 64 + j];
        float sn, cs; sincos_rr(fr[j] * a, sn, cs); h2[idx] = sn; }
    __syncthreads();
    const float dmin = 3.0701134573253945f, dmax = 15.350567286626973f;
#pragma unroll 1
    for (int m = 0; m < 4; ++m) { const int q = tid + 512 * m;
        float acc[16];
#pragma unroll
        for (int pp = 0; pp < 16; ++pp) acc[pp] = 0.f;
#pragma unroll 2
        for (int i = 0; i < 64; ++i) { const float w = w3[i * 2048 + q];
#pragma unroll
            for (int pp = 0; pp < 16; ++pp) acc[pp] += h2[pp * 64 + i] * w; }
        const int o = q >> 10, dir = (q >> 9) & 1, c = q & 511; const float delta = dmin + (float)c * ((dmax - dmin) / 511.0f);
        float sabs = 0.f;
#pragma unroll
        for (int pp = 0; pp < 16; ++pp) { const int t = pb * 16 + pp; const float v = acc[pp] * __expf(-((float)t / 4095.0f) * delta); acc[pp] = v; if (!(dir == 1 && t == 0)) sabs += fabsf(v); }
        float* dst = FILT + ((size_t)((o * 2 + dir) * 512 + c)) * 4096 + pb * 16;
#pragma unroll
        for (int k = 0; k < 4; ++k) *(f32x4*)(dst + 4 * k) = (f32x4){acc[4 * k], acc[4 * k + 1], acc[4 * k + 2], acc[4 * k + 3]};
        atomicAdd(&NORM[o * 512 + c], sabs); }
    __syncthreads();
}

constexpr int KL_STRIDE = 208, VL_STRIDE = 144, KL_BYTES = 64 * KL_STRIDE, VL_BYTES = 64 * VL_STRIDE, ATT_BUF = KL_BYTES + VL_BYTES;
__device__ __forceinline__ bf16x8 pack8(const f32x16& x, int s) {
    u32x4 p; p.x = pk2(x[8 * s], x[8 * s + 1]); p.y = pk2(x[8 * s + 2], x[8 * s + 3]); p.z = pk2(x[8 * s + 4], x[8 * s + 5]); p.w = pk2(x[8 * s + 6], x[8 * s + 7]);
    return __builtin_bit_cast(bf16x8, p);
}
__device__ __forceinline__ void attn_unit(const Params& p, LAS unsigned char* lds, int unit, int tid, int lane, int wave) {
    const int bh = unit >> 4, qb = unit & 15, b = bh >> 3, h = bh & 7, r = lane & 31, hh = lane >> 5;
    const float* Q = (const float*)(p.ws + WS_Q); const bf16_t* KN = (const bf16_t*)(p.ws + WS_KN); const bf16_t* KPE = (const bf16_t*)(p.ws + WS_KPE); const bf16_t* VT = (const bf16_t*)(p.ws + WS_VT);
    bf16_t* MIXN = (bf16_t*)(p.ws + WS_MIXN);
    const size_t tok0 = (size_t)b * SEQ, qrow = tok0 + qb * 256 + wave * 32 + r;
    bf16x8 qf[6];
    { const float QS = 0.14724352f;
      const float* qp = Q + qrow * 768 + 96 * h + 8 * hh;
#pragma unroll
      for (int ks = 0; ks < 4; ++ks) { const f32x4 a = *(const f32x4*)(qp + 16 * ks), b = *(const f32x4*)(qp + 16 * ks + 4);
          u32x4 w; w.x = pk2(a.x * QS, a.y * QS); w.y = pk2(a.z * QS, a.w * QS); w.z = pk2(b.x * QS, b.y * QS); w.w = pk2(b.z * QS, b.w * QS); qf[ks] = __builtin_bit_cast(bf16x8, w); }
      const f32x2_t* tab = (const f32x2_t*)(p.ws + WS_ROPE) + (size_t)((int)(qrow & 4095)) * 16 + 8 * hh;
      float x1[8], x2[8];
      { const f32x4 a = *(const f32x4*)(qp + 64), b = *(const f32x4*)(qp + 68), c = *(const f32x4*)(qp + 80), d = *(const f32x4*)(qp + 84);
        x1[0] = a.x; x1[1] = a.y; x1[2] = a.z; x1[3] = a.w; x1[4] = b.x; x1[5] = b.y; x1[6] = b.z; x1[7] = b.w;
        x2[0] = c.x; x2[1] = c.y; x2[2] = c.z; x2[3] = c.w; x2[4] = d.x; x2[5] = d.y; x2[6] = d.z; x2[7] = d.w; }
      float y1[8], y2[8];
#pragma unroll
      for (int j = 0; j < 8; ++j) { const f32x2_t cs = tab[j]; y1[j] = (x1[j] * cs.x - x2[j] * cs.y) * QS; y2[j] = (x1[j] * cs.y + x2[j] * cs.x) * QS; }
      u32x4 w; w.x = pk2(y1[0], y1[1]); w.y = pk2(y1[2], y1[3]); w.z = pk2(y1[4], y1[5]); w.w = pk2(y1[6], y1[7]); qf[4] = __builtin_bit_cast(bf16x8, w);
      w.x = pk2(y2[0], y2[1]); w.y = pk2(y2[2], y2[3]); w.z = pk2(y2[4], y2[5]); w.w = pk2(y2[6], y2[7]); qf[5] = __builtin_bit_cast(bf16x8, w); }
    const int kc1 = tid + 512; const bool has1 = tid < 256;
    const int key0 = tid / 12, part0 = tid - key0 * 12, key1 = kc1 / 12, part1 = kc1 - key1 * 12;
    const bf16_t* ks0 = part0 < 8 ? KN + (tok0 + key0) * 512 + 64 * h + 8 * part0 : KPE + (tok0 + key0) * 32 + 8 * (part0 - 8);
    const bf16_t* ks1 = part1 < 8 ? KN + (tok0 + key1) * 512 + 64 * h + 8 * part1 : KPE + (tok0 + key1) * 32 + 8 * (part1 - 8);
    const int kst0 = part0 < 8 ? 64 * 512 : 64 * 32, kst1 = part1 < 8 ? 64 * 512 : 64 * 32;
    const bf16_t* vs = VT + (size_t)(64 * h + (tid >> 3)) * MTOK + tok0 + 8 * (tid & 7);
    const int kd0 = key0 * KL_STRIDE + part0 * 16, kd1 = key1 * KL_STRIDE + part1 * 16, vd = KL_BYTES + (tid >> 3) * VL_STRIDE + (tid & 7) * 16;
    u32x4 rk0, rk1 = (u32x4){0u, 0u, 0u, 0u}, rv;
    rk0 = *(const u32x4*)ks0; if (has1) rk1 = *(const u32x4*)ks1; rv = *(const u32x4*)vs;
    *(LAS u32x4*)(lds + kd0) = rk0; if (has1) *(LAS u32x4*)(lds + kd1) = rk1; *(LAS u32x4*)(lds + vd) = rv;
    __syncthreads();
    f32x16 o0, o1;
#pragma unroll
    for (int i = 0; i < 16; ++i) { o0[i] = 0.f; o1[i] = 0.f; }
    f32x2_t lsum2 = {0.f, 0.f};
    for (int kt = 0; kt < 64; ++kt) {
        const int buf = kt & 1; const bool more = kt + 1 < 64;
        if (more) { rk0 = *(const u32x4*)(ks0 + (size_t)(kt + 1) * kst0); if (has1) rk1 = *(const u32x4*)(ks1 + (size_t)(kt + 1) * kst1); rv = *(const u32x4*)(vs + (kt + 1) * 64); }
        const LAS unsigned char* KLb = lds + buf * ATT_BUF; const LAS unsigned char* VLb = KLb + KL_BYTES;
        f32x16 s0, s1;
        { const f32x16 zero16 = {0.f, 0.f, 0.f, 0.f, 0.f, 0.f, 0.f, 0.f, 0.f, 0.f, 0.f, 0.f, 0.f, 0.f, 0.f, 0.f};
          const bf16x8 ka = *(const LAS bf16x8*)(KLb + r * KL_STRIDE + 16 * hh);
          const bf16x8 kb = *(const LAS bf16x8*)(KLb + (32 + r) * KL_STRIDE + 16 * hh);
          s0 = mfma32(ka, qf[0], zero16); s1 = mfma32(kb, qf[0], zero16); }
#pragma unroll
        for (int ks = 1; ks < 6; ++ks) {
            const bf16x8 ka = *(const LAS bf16x8*)(KLb + r * KL_STRIDE + 32 * ks + 16 * hh);
            const bf16x8 kb = *(const LAS bf16x8*)(KLb + (32 + r) * KL_STRIDE + 32 * ks + 16 * hh);
            s0 = mfma32(ka, qf[ks], s0); s1 = mfma32(kb, qf[ks], s1); }
#pragma unroll
        for (int i = 0; i < 16; ++i) { s0[i] = __builtin_amdgcn_exp2f(s0[i]); s1[i] = __builtin_amdgcn_exp2f(s1[i]); }
#pragma unroll
        for (int i = 0; i < 16; i += 2) { lsum2 += (f32x2_t){s0[i], s0[i + 1]}; lsum2 += (f32x2_t){s1[i], s1[i + 1]}; }
        bf16x8 pf[2][2];
        pf[0][0] = pack8(s0, 0); pf[0][1] = pack8(s0, 1); pf[1][0] = pack8(s1, 0); pf[1][1] = pack8(s1, 1);
#pragma unroll
        for (int sub = 0; sub < 2; ++sub)
#pragma unroll
            for (int s = 0; s < 2; ++s) {
                const LAS unsigned char* vp = VLb + r * VL_STRIDE + (32 * sub + 16 * s + 4 * hh) * 2;
                const u32x2 lo0 = *(const LAS u32x2*)vp, hi0 = *(const LAS u32x2*)(vp + 16);
                const u32x2 lo1 = *(const LAS u32x2*)(vp + 32 * VL_STRIDE), hi1 = *(const LAS u32x2*)(vp + 32 * VL_STRIDE + 16);
                const bf16x8 va0 = __builtin_bit_cast(bf16x8, ((u32x4){lo0.x, lo0.y, hi0.x, hi0.y}));
                const bf16x8 va1 = __builtin_bit_cast(bf16x8, ((u32x4){lo1.x, lo1.y, hi1.x, hi1.y}));
                o0 = mfma32(va0, pf[sub][s], o0); o1 = mfma32(va1, pf[sub][s], o1); }
        if (more) { LAS unsigned char* nb = lds + (buf ^ 1) * ATT_BUF; *(LAS u32x4*)(nb + kd0) = rk0; if (has1) *(LAS u32x4*)(nb + kd1) = rk1; *(LAS u32x4*)(nb + vd) = rv; }
        __syncthreads();
    }
    const float lsum = lsum2.x + lsum2.y; const float l = lsum + __shfl_xor(lsum, 32); const float inv = 1.0f / l;
    float ss = 0.f;
#pragma unroll
    for (int i = 0; i < 16; ++i) { o0[i] *= inv; o1[i] *= inv; ss += o0[i] * o0[i] + o1[i] * o1[i]; }
    ss += __shfl_xor(ss, 32);
    const float rstd = 1.0f / sqrtf(ss * (1.0f / 64.0f) + EPSN);
    const float* hg = p.in[20] + 64 * h;
#pragma unroll
    for (int g = 0; g < 4; ++g) {
        const int dv0 = 8 * g + 4 * hh, dv1 = 32 + dv0;
        const f32x4 g0 = *(const f32x4*)(hg + dv0), g1 = *(const f32x4*)(hg + dv1);
        u32x2 w0, w1;
        w0.x = pk2(o0[4 * g] * rstd * g0.x, o0[4 * g + 1] * rstd * g0.y); w0.y = pk2(o0[4 * g + 2] * rstd * g0.z, o0[4 * g + 3] * rstd * g0.w);
        w1.x = pk2(o1[4 * g] * rstd * g1.x, o1[4 * g + 1] * rstd * g1.y); w1.y = pk2(o1[4 * g + 2] * rstd * g1.z, o1[4 * g + 3] * rstd * g1.w);
        *(u32x2*)(MIXN + qrow * 1024 + 64 * h + dv0) = w0; *(u32x2*)(MIXN + qrow * 1024 + 64 * h + dv1) = w1; }
}

constexpr int UT_STRIDE = 8192 + 16, UTL_BYTES = 8 * UT_STRIDE, RL_OFF = UTL_BYTES, RL1_OFF = 16384 + 64  , ZR_OFF = RL_OFF + 32768 + 128;
typedef short bf16x8_a4 __attribute__((ext_vector_type(8), aligned(4)));
__device__ __forceinline__ void hy_load_filter(const Params& p, LAS unsigned char* lds, int o, int c, int tid) {
    LAS bf16_t* RL = (LAS bf16_t*)(lds + RL_OFF);
    const float* FILT = (const float*)(p.ws + WS_FILT); const float* NORM = (const float*)(p.ws + WS_CTL);
    const float invn = 1.0f / NORM[o * 512 + c];
    const float* hf = FILT + (size_t)((o * 2 + 0) * 512 + c) * 4096; const float* hb = FILT + (size_t)((o * 2 + 1) * 512 + c) * 4096;
    float fv[16];
#pragma unroll
    for (int k = 0; k < 16; ++k) { const int i = tid + 512 * k; const int j = i - 4095; fv[k] = (k < 8) ? hf[4095 - i] : hb[j > 4095 ? 4095 : j]; }
#pragma unroll
    for (int k = 0; k < 16; ++k) { const int i = tid + 512 * k; const float v = (i < 8191) ? fv[k] * invn : 0.f;
        const bf16_t hv = (bf16_t)(pk2(v, 0.f) & 0xffffu); RL[i] = hv; if (i > 0) RL[RL1_OFF / 2 + i - 1] = hv; }
    if (tid == 0) RL[RL1_OFF / 2 + 8191] = 0;
}
#define HY_RD2(lo, hi, addr, o0, o1, o2, o3) asm volatile("ds_read2_b32 %0, %2 offset0:" #o0 " offset1:" #o1 "\n\tds_read2_b32 %1, %2 offset0:" #o2 " offset1:" #o3 : "=&v"(lo), "=&v"(hi) : "v"(addr))
#define HY_RDB(dst, addr, off) asm volatile("ds_read_b128 %0, %1 offset:" #off : "=&v"(dst) : "v"(addr))
__device__ __forceinline__ void hy_conv(LAS unsigned char* lds, f32x16 (&acc)[2][2], int lane, int wave) {
    const int r = lane & 31, hh = lane >> 5, bb = r & 7, t1o = r >> 3;
#pragma unroll
    for (int a = 0; a < 2; ++a)
#pragma unroll
        for (int b = 0; b < 2; ++b)
#pragma unroll
            for (int i = 0; i < 16; ++i) acc[a][b][i] = 0.f;
    const unsigned lbase = (unsigned)(size_t)lds;
    const int e00 = 4095 + 8 * hh - r;
    const unsigned a_cst = lbase + RL_OFF + ((e00 & 1) ? (RL1_OFF + 2 * (e00 - 1)) : 2 * e00) - 64;
    const unsigned b_cst = lbase + bb * UT_STRIDE + 16 * hh, z_addr = lbase + ZR_OFF;
    u32x2 wl[6], wh[6]; u32x4 Bq[2][4];
    { const unsigned a0 = a_cst - 128 * (8 * wave - 63);
      asm volatile("" ::: "memory");
      HY_RD2(wl[4], wh[4], a0, 32, 33, 34, 35); HY_RD2(wl[5], wh[5], a0, 40, 41, 42, 43); }
    for (int q = 0; q < 71; ++q) {
        const int d1 = 8 * wave - 63 + q;
        const unsigned aa = a_cst - 128 * d1;
        HY_RD2(wl[0], wh[0], aa, 0, 1, 2, 3); HY_RD2(wl[1], wh[1], aa, 8, 9, 10, 11); HY_RD2(wl[2], wh[2], aa, 16, 17, 18, 19); HY_RD2(wl[3], wh[3], aa, 24, 25, 26, 27);
#pragma unroll
        for (int nt = 0; nt < 2; ++nt) { const int s1 = 8 * wave + 4 * nt + t1o - d1; const unsigned ba = ((unsigned)s1 < 64u) ? b_cst + 128 * s1 : z_addr;
            HY_RDB(Bq[nt][0], ba, 0); HY_RDB(Bq[nt][1], ba, 32); HY_RDB(Bq[nt][2], ba, 64); HY_RDB(Bq[nt][3], ba, 96); }
        asm volatile("s_waitcnt lgkmcnt(0)" : "+v"(wl[0]), "+v"(wh[0]), "+v"(wl[1]), "+v"(wh[1]), "+v"(wl[2]), "+v"(wh[2]), "+v"(wl[3]), "+v"(wh[3]), "+v"(wl[4]), "+v"(wh[4]), "+v"(wl[5]), "+v"(wh[5]));
        asm volatile("" : "+v"(Bq[0][0]), "+v"(Bq[0][1]), "+v"(Bq[0][2]), "+v"(Bq[0][3]), "+v"(Bq[1][0]), "+v"(Bq[1][1]), "+v"(Bq[1][2]), "+v"(Bq[1][3]));
        bf16x8 W6[6];
#pragma unroll
        for (int k = 0; k < 6; ++k) W6[k] = __builtin_bit_cast(bf16x8, ((u32x4){wl[k].x, wl[k].y, wh[k].x, wh[k].y}));
#pragma unroll
        for (int ks = 0; ks < 4; ++ks)
#pragma unroll
            for (int mt = 0; mt < 2; ++mt)
#pragma unroll
                for (int nt = 0; nt < 2; ++nt) acc[mt][nt] = mfma32(W6[ks - 2 * mt + 2], __builtin_bit_cast(bf16x8, Bq[nt][ks]), acc[mt][nt]);
        wl[4] = wl[0]; wh[4] = wh[0]; wl[5] = wl[1]; wh[5] = wh[1];
    }
}
__device__ __forceinline__ void hy_stage_col(const Params& p, LAS unsigned char* lds, int gc, int tid) {
    const bf16_t* UTg = (const bf16_t*)(p.ws + WS_UT);
    const float* cw = p.in[11]; const float w0 = cw[gc], w1 = cw[1536 + gc], w2 = cw[3072 + gc], cbv = p.in[12][gc];
    u32x4 raw[8]; unsigned pv[8], nx[8];
#pragma unroll
    for (int i = 0; i < 8; ++i) { const int ch = tid + 512 * i, b = ch >> 9, s0 = (ch & 511) * 8;
        const bf16_t* src = UTg + (size_t)gc * MTOK + b * SEQ + s0;
        raw[i] = *(const u32x4*)src; pv[i] = src[s0 > 0 ? -1 : 0]; nx[i] = src[s0 + 8 < SEQ ? 8 : 7]; }
#pragma unroll
    for (int i = 0; i < 8; ++i) { const int ch = tid + 512 * i, b = ch >> 9, s0 = (ch & 511) * 8;
        float f[10];
        f[0] = s0 > 0 ? __uint_as_float(pv[i] << 16) : 0.f; f[9] = s0 + 8 < SEQ ? __uint_as_float(nx[i] << 16) : 0.f;
        f[1] = __uint_as_float(raw[i].x << 16); f[2] = __uint_as_float(raw[i].x & 0xffff0000u); f[3] = __uint_as_float(raw[i].y << 16); f[4] = __uint_as_float(raw[i].y & 0xffff0000u);
        f[5] = __uint_as_float(raw[i].z << 16); f[6] = __uint_as_float(raw[i].z & 0xffff0000u); f[7] = __uint_as_float(raw[i].w << 16); f[8] = __uint_as_float(raw[i].w & 0xffff0000u);
        float v[8];
#pragma unroll
        for (int j = 0; j < 8; ++j) v[j] = cbv + w0 * f[j] + w1 * f[j + 1] + w2 * f[j + 2];
        u32x4 w; w.x = pk2(v[0], v[1]); w.y = pk2(v[2], v[3]); w.z = pk2(v[4], v[5]); w.w = pk2(v[6], v[7]);
        *(LAS u32x4*)(lds + b * UT_STRIDE + s0 * 2) = w; }
}
template <int MODE>
__device__ __forceinline__ void hy_own(LAS unsigned char* lds, f32x16 (&acc)[2][2], float dsk, int lane, int wave) {
    const int r = lane & 31, hh = lane >> 5, bb = r & 7, t1o = r >> 3;
#pragma unroll
    for (int mt = 0; mt < 2; ++mt)
#pragma unroll
        for (int nt = 0; nt < 2; ++nt)
#pragma unroll
            for (int g = 0; g < 4; ++g) {
                const int t = 64 * (8 * wave + 4 * nt + t1o) + 32 * mt + 8 * g + 4 * hh;
                LAS unsigned char* up = lds + bb * UT_STRIDE + t * 2;
                const u32x2 ur = *(const LAS u32x2*)up;
                float uv[4]; uv[0] = __uint_as_float(ur.x << 16); uv[1] = __uint_as_float(ur.x & 0xffff0000u); uv[2] = __uint_as_float(ur.y << 16); uv[3] = __uint_as_float(ur.y & 0xffff0000u);
                if (MODE == 0) {
#pragma unroll
                    for (int j = 0; j < 4; ++j) acc[mt][nt][4 * g + j] += uv[j] * dsk;
                } else { u32x2 w; w.x = pk2(acc[mt][nt][4 * g] * uv[0], acc[mt][nt][4 * g + 1] * uv[1]); w.y = pk2(acc[mt][nt][4 * g + 2] * uv[2], acc[mt][nt][4 * g + 3] * uv[3]); *(LAS u32x2*)up = w; }
            }
}
__device__ __forceinline__ void hy_copy_out(const Params& p, LAS unsigned char* lds, int c, int tid) {
    bf16_t* HYT = (bf16_t*)(p.ws + WS_HYT);
#pragma unroll
    for (int i = 0; i < 8; ++i) { const int ch = tid + 512 * i, b = ch >> 9, s0 = (ch & 511) * 8;
        *(u32x4*)(HYT + (size_t)c * MTOK + b * SEQ + s0) = *(const LAS u32x4*)(lds + b * UT_STRIDE + s0 * 2); }
}
__device__ __forceinline__ void hyena_channel(const Params& p, LAS unsigned char* lds, int c, int tid, int lane, int wave) {
    const float d0 = p.in[19][c], d1 = p.in[19][512 + c];
    hy_stage_col(p, lds, c, tid);
    if (tid < 32) *(LAS unsigned*)(lds + ZR_OFF + 4 * tid) = 0u;
    hy_load_filter(p, lds, 0, c, tid);
    __syncthreads();
    f32x16 acc[2][2];
    hy_conv(lds, acc, lane, wave);
    __syncthreads();
    hy_own<0>(lds, acc, d0, lane, wave);
    __syncthreads();
    hy_stage_col(p, lds, 512 + c, tid);
    hy_load_filter(p, lds, 1, c, tid);
    __syncthreads();
    hy_own<1>(lds, acc, 0.f, lane, wave);
    __syncthreads();
    hy_conv(lds, acc, lane, wave);
    __syncthreads();
    hy_own<0>(lds, acc, d1, lane, wave);
    __syncthreads();
    hy_stage_col(p, lds, 1024 + c, tid);
    __syncthreads();
    hy_own<1>(lds, acc, 0.f, lane, wave);
    __syncthreads();
    hy_copy_out(p, lds, c, tid);
    __syncthreads();
}

#define XB_TMO      128
#define XB_XCNT(j)  (256  + 64 * (j))
#define XB_XSUB(j)  (1280 + 64 * (j))
#define XB_XGEN(j)  (2304 + 64 * (j))
#define XB_TOP      3328
#define XB_TOPGEN   3392
#define XCD_BAR_WORDS 3456
#define XB_SPIN_CAP (1u << 18)

__device__ __forceinline__ unsigned xb_ld(unsigned* p)              { return __hip_atomic_load(p, __ATOMIC_RELAXED, __HIP_MEMORY_SCOPE_AGENT); }
__device__ __forceinline__ unsigned xb_add(unsigned* p, unsigned v) { return __hip_atomic_fetch_add(p, v, __ATOMIC_RELAXED, __HIP_MEMORY_SCOPE_AGENT); }
__device__ __forceinline__ unsigned xb_xcc_id() { return (unsigned)__builtin_amdgcn_s_getreg((3 << 11) | 20) & 0xFu; }
#define XB_SPIN(cond, bar) do { unsigned _sp = 0; while (cond) { __builtin_amdgcn_s_sleep(1); \
    if ((++_sp & 255u) == 0u) { if (xb_ld(&(bar)[XB_TMO])) break; if (_sp > XB_SPIN_CAP) { atomicAdd(&(bar)[XB_TMO], 1u); break; } } } } while (0)

struct XcdBarrier {
    unsigned* bar; unsigned x;
    volatile LAS unsigned* st;
};

__device__ __forceinline__ XcdBarrier xcd_barrier_post(unsigned* bar, volatile LAS unsigned* st) {
    XcdBarrier b; b.bar = bar; b.x = xb_xcc_id(); b.st = st;
    if (threadIdx.x == 0) (void)xb_add(&bar[XB_XCNT(b.x)], 1u);
    return b;
}
__device__ __forceinline__ void xcd_barrier_complete(unsigned* bar, unsigned x, unsigned& nloc, unsigned& nx) {
    const unsigned G = gridDim.x * gridDim.y * gridDim.z;
    unsigned sum, cnt, mine, sp = 0u;
    for (;;) {
        sum = 0u; cnt = 0u; mine = 0u;
#pragma unroll
        for (unsigned j = 0; j < 16; ++j) { const unsigned c = xb_ld(&bar[XB_XCNT(j)]); sum += c; cnt += (c > 0u) ? 1u : 0u; mine = (j == x) ? c : mine; }
        if (sum == G) break;
        __builtin_amdgcn_s_sleep(1);
        if ((++sp & 255u) == 0u) { if (xb_ld(&bar[XB_TMO])) break; if (sp > XB_SPIN_CAP) { atomicAdd(&bar[XB_TMO], 1u); break; } }
    }
    nloc = mine > 0u ? mine : 1u; nx = cnt > 0u ? cnt : 1u;
}

__device__ __forceinline__ void xcd_barrier(const XcdBarrier& b) {
    asm volatile("s_waitcnt vmcnt(0)" ::: "memory");
    __syncthreads();
    if (threadIdx.x == 0) {
        unsigned* bar = b.bar;
        __builtin_amdgcn_s_waitcnt(0);
        unsigned nloc = b.st[0], nx = b.st[1];
        if (nloc == 0u) { xcd_barrier_complete(bar, b.x, nloc, nx); b.st[0] = nloc; b.st[1] = nx; }
        const unsigned old = xb_add(&bar[XB_XSUB(b.x)], 1u);
        const unsigned gen = old / nloc;
        if (old + 1u == (gen + 1u) * nloc) {
            __builtin_amdgcn_fence(__ATOMIC_RELEASE, "agent");
            asm volatile("s_waitcnt vmcnt(0)" ::: "memory");
            const unsigned og = xb_add(&bar[XB_TOP], 1u);
            const unsigned tg = og / nx;
            if (og + 1u == (tg + 1u) * nx) xb_add(&bar[XB_TOPGEN], 1u);
            else XB_SPIN(xb_ld(&bar[XB_TOPGEN]) == tg, bar);
            __builtin_amdgcn_fence(__ATOMIC_ACQUIRE, "agent");
            xb_add(&bar[XB_XGEN(b.x)], 1u);
            asm volatile("s_waitcnt vmcnt(0)" ::: "memory");
        } else {
            XB_SPIN(xb_ld(&bar[XB_XGEN(b.x)]) == gen, bar);
            __builtin_amdgcn_fence(__ATOMIC_ACQUIRE, "agent");
            asm volatile("s_waitcnt vmcnt(0)" ::: "memory");
        }
    }
    __syncthreads();
}

__global__ void __launch_bounds__(512) fwd_megakernel(Params p) {
    extern __shared__ __attribute__((aligned(16))) unsigned char lds_raw[];
    LAS unsigned char* lds = (LAS unsigned char*)lds_raw;
    cg::grid_group grid = cg::this_grid();
    const int tid = threadIdx.x, lane = tid & 63, wave = __builtin_amdgcn_readfirstlane(tid >> 6);
    const int G = gridDim.x, bx = blockIdx.x;
    const int vcu = (G % 8 == 0) ? (bx % 8) * (G / 8) + bx / 8 : bx;
    const int gw = vcu * 8 + wave, NGW = G * 8;
    unsigned char* ws = p.ws;
    const int lo = p.ph_lo, hi = p.ph_hi;
    const bool fuse5 = (G == 256) && (lo <= 4 && 5 < hi);
    volatile LAS unsigned* bst = (volatile LAS unsigned*)(lds + LDS_BYTES - 64);
    if (tid < 2) bst[tid] = 0u;
    __syncthreads();
    const XcdBarrier xbar = xcd_barrier_post((unsigned*)(ws + WS_BAR), bst);
#ifndef P0SEL
#define P0SEL 15
#endif
#ifndef REPMASK
#define REPMASK 0
#endif
#define NREP(k) ((((REPMASK) >> (k)) & 1) ? 2 : 1)
#ifndef P6SEL
#define P6SEL 7
#endif
#ifndef PHMASK
#define PHMASK 0xffff
#endif
#define IN(k) (((PHMASK >> (k)) & 1) && lo <= (k) && (k) < hi)
#define SEAM(k) do { if (IN(k) && IN((k) + 1)) { if ((k) == 0) grid.sync(); else xcd_barrier(xbar); if ((REPMASK >> 15) & 1) xcd_barrier(xbar); } } while (0)
    bf16_t* XN = (bf16_t*)(ws + WS_XN); bf16_t* HB = (bf16_t*)(ws + WS_H);

    if (IN(0)) {
        LAS float* scr = (LAS float*)(lds + wave * 16384);
        constexpr int I_GU = 16 * 176, I_D = 44 * 32, I_INA = 16 * 16, I_INB = 16 * 48, I_UQ = 4 * 24, I_UK = 4 * 16, I_OUT = 16 * 32;
        constexpr int NITEMS = 2 * (I_GU + I_D) + I_INA + I_INB + I_UQ + 2 * I_UK + I_OUT;
        for (int rep = 0; rep < NREP(0); ++rep) if (P0SEL & 1) for (int it = gw; it < NITEMS; it += NGW) {
            int r = it;
            bool done = false;
#pragma unroll
            for (int f = 0; f < 2; ++f) {
                if (done) break;
                const float* wg = p.in[f ? 23 : 2]; const float* wu = p.in[f ? 24 : 3]; const float* wd = p.in[f ? 25 : 4];
                bf16_t* GU = (bf16_t*)(ws + (f ? WS_W2GU : WS_W1GU)); bf16_t* DD = (bf16_t*)(ws + (f ? WS_W2D : WS_W1D));
                if (r < I_GU) { const int kb = r / 176, nb = r - kb * 176, pn = nb >> 3, rb = nb & 7;
                    tr_item(rb < 4 ? wg : wu, FFH, 128 * pn + 32 * (rb & 3), 64 * kb, true, GU, DM, 32 * nb, scr, lane); done = true; break; }
                r -= I_GU;
                if (r < I_D) { const int kb = r / 32, nb = r - kb * 32; tr_item(wd, DM, 32 * nb, 64 * kb, true, DD, FFH, 32 * nb, scr, lane); done = true; break; }
                r -= I_D;
            }
            if (done) continue;
            if (r < I_INA) { const int kb = r / 16, nb = r - kb * 16; tr_item(p.in[6], 1952, 32 * nb, 64 * kb, nb < 13, (bf16_t*)(ws + WS_WINA), DM, 32 * nb, scr, lane); continue; } r -= I_INA;
            if (r < I_INB) { const int kb = r / 48, nb = r - kb * 48; tr_item(p.in[6], 1952, 416 + 32 * nb, 64 * kb, true, (bf16_t*)(ws + WS_WINB), DM, 32 * nb, scr, lane); continue; } r -= I_INB;
            if (r < I_UQ) { const int kb = r / 24, nb = r - kb * 24; tr_item(p.in[8], 768, 32 * nb, 64 * kb, true, (bf16_t*)(ws + WS_WUQ), 256, 32 * nb, scr, lane); continue; } r -= I_UQ;
            if (r < I_UK) { const int kb = r / 16, nb = r - kb * 16; tr_item(p.in[10], 1024, 128 * (nb >> 1) + 32 * (nb & 1), 64 * kb, kb < 2, (bf16_t*)(ws + WS_WUK), 256, 32 * nb, scr, lane); continue; } r -= I_UK;
            if (r < I_UK) { const int kb = r / 16, nb = r - kb * 16; tr_item(p.in[10], 1024, 128 * (nb >> 1) + 64 + 32 * (nb & 1), 64 * kb, kb < 2, (bf16_t*)(ws + WS_WUV), 256, 32 * nb, scr, lane); continue; } r -= I_UK;
            { const int kb = r / 32, nb = r - kb * 32; tr_item(p.in[21], DM, 32 * nb, 64 * kb, true, (bf16_t*)(ws + WS_WOUT), DM, 32 * nb, scr, lane); }
        }
        if (P0SEL & 2) { f32x2_t* tab = (f32x2_t*)(ws + WS_ROPE);
          for (int idx = gw * 64 + lane; idx < SEQ * 16; idx += NGW * 64) { const int s = idx >> 4, i = idx & 15;
              const float inv = exp2f(-(float)i * 0.8304820237218406f); const float ang = (float)s * inv; float sn, cs; sincos_rr(ang, sn, cs); tab[idx] = (f32x2_t){cs, sn}; } }
        __syncthreads();
        if (P0SEL & 4) for (int pb = bx; pb < 256; pb += G) filter_block(p, lds, pb, tid);
        for (int rep = 0; rep < NREP(13); ++rep) if (P0SEL & 8) for (int m = gw; m < MTOK; m += NGW) rms_row_bf16(p.in[0] + (size_t)m * DM, p.in[1], XN + (size_t)m * DM, lane);
    }
    SEAM(0);
    if (IN(1)) for (int rep = 0; rep < NREP(1); ++rep) { __syncthreads(); pg8::Gemm g{XN, (const bf16_t*)(ws + WS_W1GU), MTOK, 2 * FFH, DM}; pg8::StaticOrder S; S.init(MTOK, 2 * FFH, G, bx);
        pg8::EpiSwiGLU E{HB, FFH}; pg8::gemm_phase<pg8::EpiSwiGLU, pg8::StaticOrder>(lds, g, S, E); }
    SEAM(1);
    if (IN(2)) for (int rep = 0; rep < NREP(2); ++rep) { __syncthreads(); pg8::Gemm g{HB, (const bf16_t*)(ws + WS_W1D), MTOK, DM, FFH}; pg8::StaticOrder S; S.init(MTOK, DM, G, bx);
        pg8::EpiResid E{p.in[0], p.out, DM, 0.5f}; pg8::gemm_phase<pg8::EpiResid, pg8::StaticOrder>(lds, g, S, E); }
    SEAM(2);
    if (IN(3)) for (int rep = 0; rep < NREP(3); ++rep) { for (int m = gw; m < MTOK; m += NGW) rms_row_bf16(p.out + (size_t)m * DM, p.in[5], XN + (size_t)m * DM, lane); }
    SEAM(3);
    if (IN(4)) for (int rep = 0; rep < NREP(4); ++rep) { __syncthreads();
        if (fuse5) { pg8::Gemm g{XN, (const bf16_t*)(ws + WS_WINA), MTOK, 512, DM}; pg8::StaticOrder S; S.init(MTOK, 512, G, bx);
          pg8::EpiUA E{(bf16_t*)(ws + WS_CQN), (bf16_t*)(ws + WS_CKVN), (bf16_t*)(ws + WS_KPE), p.in[7], p.in[9], (const f32x2_t*)(ws + WS_ROPE)};
          pg8::gemm_phase<pg8::EpiUA, pg8::StaticOrder>(lds, g, S, E); }
        else { pg8::Gemm g{XN, (const bf16_t*)(ws + WS_WINA), MTOK, 512, DM}; pg8::StaticOrder S; S.init(MTOK, 512, G, bx);
          pg8::EpiF32 E{(float*)(ws + WS_UA), 512}; pg8::gemm_phase<pg8::EpiF32, pg8::StaticOrder>(lds, g, S, E); }
        { pg8::Gemm g{(const bf16_t*)(ws + WS_WINB), XN, 1536, MTOK, DM}; pg8::StaticOrder S; S.init(1536, MTOK, G, bx);
          pg8::EpiBf16P E{(bf16_t*)(ws + WS_UT), (size_t)MTOK}; pg8::gemm_phase<pg8::EpiBf16P, pg8::StaticOrder>(lds, g, S, E); } }
    SEAM(4);
    if (IN(5) && !fuse5) for (int rep = 0; rep < NREP(5); ++rep) {
        const float* UA = (const float*)(ws + WS_UA); bf16_t* CQN = (bf16_t*)(ws + WS_CQN); bf16_t* CKVN = (bf16_t*)(ws + WS_CKVN); bf16_t* KPE = (bf16_t*)(ws + WS_KPE);
        const f32x2_t* tab = (const f32x2_t*)(ws + WS_ROPE);
        const f32x4 gq = ((const f32x4*)p.in[7])[lane]; const f32x4 gk = lane < 32 ? ((const f32x4*)p.in[9])[lane] : (f32x4){0.f, 0.f, 0.f, 0.f};
        for (int row = gw; row < MTOK; row += NGW) {
            const f32x4* ur = (const f32x4*)(UA + (size_t)row * 512);
            const f32x4 a = ur[lane], bq = ur[64 + lane];
            const float rq = 1.0f / sqrtf(wave_sum((a.x * a.x + a.y * a.y) + (a.z * a.z + a.w * a.w)) * (1.0f / 256.0f) + EPSN);
            u32x2 w; w.x = pk2(a.x * rq * gq.x, a.y * rq * gq.y); w.y = pk2(a.z * rq * gq.z, a.w * rq * gq.w);
            *((u32x2*)(CQN + (size_t)row * 256) + lane) = w;
            const float skv = lane < 32 ? (bq.x * bq.x + bq.y * bq.y) + (bq.z * bq.z + bq.w * bq.w) : 0.f;
            const float rkv = 1.0f / sqrtf(wave_sum(skv) * (1.0f / 128.0f) + EPSN);
            u32x2 wk = (u32x2){0u, 0u};
            if (lane < 32) { wk.x = pk2(bq.x * rkv * gk.x, bq.y * rkv * gk.y); wk.y = pk2(bq.z * rkv * gk.z, bq.w * rkv * gk.w); }
            *((u32x2*)(CKVN + (size_t)row * 256) + lane) = wk;
            f32x4 pr; pr.x = __shfl_xor(bq.x, 4); pr.y = __shfl_xor(bq.y, 4); pr.z = __shfl_xor(bq.z, 4); pr.w = __shfl_xor(bq.w, 4);
            if (lane >= 32 && lane < 40) { const int pos = row & 4095; const bool first = lane < 36; const int i0 = 4 * ((lane - 32) & 3);
                float ov[4];
#pragma unroll
                for (int e = 0; e < 4; ++e) { const f32x2_t cs = tab[pos * 16 + i0 + e]; const float x1 = first ? bq[e] : pr[e], x2 = first ? pr[e] : bq[e]; ov[e] = first ? x1 * cs.x - x2 * cs.y : x1 * cs.y + x2 * cs.x; }
                u32x2 wo; wo.x = pk2(ov[0], ov[1]); wo.y = pk2(ov[2], ov[3]);
                *(u32x2*)(KPE + (size_t)row * 32 + 4 * (lane - 32)) = wo; }
        }
    }
    if (!fuse5) SEAM(5);
    if (IN(6)) for (int rep = 0; rep < NREP(6); ++rep) { __syncthreads();
        if (P6SEL & 1) { pg8::Gemm g{(const bf16_t*)(ws + WS_CQN), (const bf16_t*)(ws + WS_WUQ), MTOK, 768, 256}; pg8::StaticOrder S; S.init(MTOK, 768, G, bx);
          pg8::EpiF32 E{(float*)(ws + WS_Q), 768}; pg8::gemm_phase<pg8::EpiF32, pg8::StaticOrder>(lds, g, S, E); }
        if (P6SEL & 2) { pg8::Gemm g{(const bf16_t*)(ws + WS_CKVN), (const bf16_t*)(ws + WS_WUK), MTOK, 512, 256}; pg8::StaticOrder S; S.init(MTOK, 512, G, bx);
          pg8::EpiBf16P E{(bf16_t*)(ws + WS_KN), (size_t)512}; pg8::gemm_phase<pg8::EpiBf16P, pg8::StaticOrder>(lds, g, S, E); }
        if (P6SEL & 4) { pg8::Gemm g{(const bf16_t*)(ws + WS_WUV), (const bf16_t*)(ws + WS_CKVN), 512, MTOK, 256}; pg8::StaticOrder S; S.init(512, MTOK, G, bx);
          pg8::EpiBf16P E{(bf16_t*)(ws + WS_VT), (size_t)MTOK}; pg8::gemm_phase<pg8::EpiBf16P, pg8::StaticOrder>(lds, g, S, E); } }
    SEAM(6);
    if (IN(7)) { __syncthreads();
        for (int rep = 0; rep < NREP(7); ++rep) for (int u = vcu; u < 1024; u += G) attn_unit(p, lds, u, tid, lane, wave);
        __syncthreads();
        for (int rep = 0; rep < NREP(14); ++rep) for (int c = bx; c < 512; c += G) hyena_channel(p, lds, c, tid, lane, wave);
    }
    SEAM(7);
    if (IN(8)) for (int rep = 0; rep < NREP(8); ++rep) {
        const bf16_t* HYT = (const bf16_t*)(ws + WS_HYT); bf16_t* MIXN = (bf16_t*)(ws + WS_MIXN); const float* hg = p.in[20] + 512;
        for (int it = gw; it < 8 * (MTOK / 64); it += NGW) { const int grp = it & 7, row = (it >> 3) * 64 + lane;
            float v[64]; float ss = 0.f;
#pragma unroll
            for (int cc = 0; cc < 64; ++cc) { v[cc] = bf2f(HYT[(size_t)(64 * grp + cc) * MTOK + row]); ss += v[cc] * v[cc]; }
            const float rstd = 1.0f / sqrtf(ss * (1.0f / 64.0f) + EPSN);
            bf16_t* dst = MIXN + (size_t)row * 1024 + 512 + 64 * grp;
#pragma unroll
            for (int k = 0; k < 8; ++k) { const float* gp = hg + 64 * grp + 8 * k;
                u32x4 w; w.x = pk2(v[8 * k] * rstd * gp[0], v[8 * k + 1] * rstd * gp[1]); w.y = pk2(v[8 * k + 2] * rstd * gp[2], v[8 * k + 3] * rstd * gp[3]);
                w.z = pk2(v[8 * k + 4] * rstd * gp[4], v[8 * k + 5] * rstd * gp[5]); w.w = pk2(v[8 * k + 6] * rstd * gp[6], v[8 * k + 7] * rstd * gp[7]);
                *(u32x4*)(dst + 8 * k) = w; } }
    }
    SEAM(8);
    if (IN(9)) { __syncthreads(); pg8::Gemm g{(const bf16_t*)(ws + WS_MIXN), (const bf16_t*)(ws + WS_WOUT), MTOK, DM, DM}; pg8::StaticOrder S; S.init(MTOK, DM, G, bx);
        pg8::EpiResid E{p.out, p.out, DM, 1.0f}; pg8::gemm_phase<pg8::EpiResid, pg8::StaticOrder>(lds, g, S, E); }
    SEAM(9);
    if (IN(10)) for (int rep = 0; rep < NREP(10); ++rep) { for (int m = gw; m < MTOK; m += NGW) rms_row_bf16(p.out + (size_t)m * DM, p.in[22], XN + (size_t)m * DM, lane); }
    SEAM(10);
    if (IN(11)) for (int rep = 0; rep < NREP(11); ++rep) { __syncthreads(); pg8::Gemm g{XN, (const bf16_t*)(ws + WS_W2GU), MTOK, 2 * FFH, DM}; pg8::StaticOrder S; S.init(MTOK, 2 * FFH, G, bx);
        pg8::EpiSwiGLU E{HB, FFH}; pg8::gemm_phase<pg8::EpiSwiGLU, pg8::StaticOrder>(lds, g, S, E); }
    SEAM(11);
    if (IN(12)) { __syncthreads(); pg8::Gemm g{HB, (const bf16_t*)(ws + WS_W2D), MTOK, DM, FFH}; pg8::StaticOrder S; S.init(MTOK, DM, G, bx);
        pg8::EpiResid E{p.out, p.out, DM, 0.5f}; pg8::gemm_phase<pg8::EpiResid, pg8::StaticOrder>(lds, g, S, E); }
    SEAM(12);
    if (IN(13)) {
        const f32x4* gr = (const f32x4*)p.in[26] + lane;
        for (int m = gw; m < MTOK; m += NGW) { f32x4* xr = (f32x4*)(p.out + (size_t)m * DM) + lane; f32x4 v[4]; float s = 0.f;
#pragma unroll
            for (int j = 0; j < 4; ++j) { v[j] = xr[64 * j]; s += (v[j].x * v[j].x + v[j].y * v[j].y) + (v[j].z * v[j].z + v[j].w * v[j].w); }
            const float rstd = 1.0f / sqrtf(wave_sum(s) * (1.0f / DM) + EPSN);
#pragma unroll
            for (int j = 0; j < 4; ++j) xr[64 * j] = v[j] * rstd * gr[64 * j]; }
    }
#undef IN
#undef SEAM
}

#ifndef ONE_LAUNCH
#define ONE_LAUNCH 1
#endif
extern "C" void kernel_launch(void* const* d_in, const int* in_sizes, int n_in, void* d_out, int out_size, void* d_ws, size_t ws_size, hipStream_t stream) {
    static int grid = 0;
    if (grid == 0) {
        if (n_in != 27 || ws_size < WS_END) { fprintf(stderr, "kernel_launch: unexpected n_in %d or ws_size %zu\n", n_in, ws_size); grid = -1; return; }
        int dev = 0, cus = 0, per_cu = 0;
        (void)hipGetDevice(&dev); (void)hipDeviceGetAttribute(&cus, hipDeviceAttributeMultiprocessorCount, dev);
        if (hipFuncSetAttribute((const void*)fwd_megakernel, hipFuncAttributeMaxDynamicSharedMemorySize, LDS_BYTES) != hipSuccess) { fprintf(stderr, "kernel_launch: hipFuncSetAttribute failed\n"); grid = -1; return; }
        if (hipOccupancyMaxActiveBlocksPerMultiprocessor(&per_cu, (const void*)fwd_megakernel, 512, LDS_BYTES) != hipSuccess || per_cu < 1) { fprintf(stderr, "kernel_launch: occupancy query says %d\n", per_cu); (void)hipGetLastError(); grid = -1; return; }
        grid = cus;
    }
    if (grid < 0) return;
    (void)hipMemsetAsync((char*)d_ws + WS_CTL, 0, CTL_ZERO, stream);
    Params p{};
    for (int i = 0; i < 27; ++i) p.in[i] = (const float*)d_in[i];
    p.out = (float*)d_out; p.ws = (unsigned char*)d_ws;
#if ONE_LAUNCH
    p.ph_lo = 0; p.ph_hi = NPHASE;
    void* args[] = {&p};
    hipError_t e = hipLaunchCooperativeKernel((const void*)fwd_megakernel, dim3(grid), dim3(512), args, LDS_BYTES, stream);
    if (e != hipSuccess) fprintf(stderr, "cooperative launch failed: %s (grid %d)\n", hipGetErrorString(e), grid);
#else
    for (int k = 0; k < NPHASE; ++k) { p.ph_lo = k; p.ph_hi = k + 1; hipLaunchKernelGGL(fwd_megakernel, dim3(grid), dim3(512), LDS_BYTES, stream, p); }
#endif
}
```

```cpp
#include <hip/hip_runtime.h>
#include <hip/hip_cooperative_groups.h>
#include <cstdio>
namespace cg = cooperative_groups;
namespace pg8 {
#define PG8_LAS __attribute__((address_space(3)))
typedef unsigned short bf16_t;
typedef short bf16x8 __attribute__((ext_vector_type(8)));
typedef float f32x4 __attribute__((ext_vector_type(4)));
typedef unsigned u32x4 __attribute__((ext_vector_type(4)));
constexpr int BM = 256, BK = 64, HALF = 128, HTB = HALF * BK * 2  , STAGE_BYTES = 8 * HTB, NXCD = 8, WGM = 8;

__host__ __device__ __forceinline__ int lds_byte(int r, int c) { const int st = (r >> 4) * 2 + (c >> 5), rr = r & 15, cc = c & 31, ob = rr * 64 + cc * 2; return st * 1024 + (ob ^ (((ob >> 9) & 1) << 5)); }
__host__ __device__ __forceinline__ void stage_rc(int b, int& R, int& C) { const int st = b / 1024, sb = b % 1024, swz = sb ^ (((sb >> 9) & 1) << 5); R = (st >> 1) * 16 + swz / 64; C = (st & 1) * 32 + (swz % 64) / 2; }
__host__ __device__ __forceinline__ int perm32(int rho) { const int n = rho >> 4, i = rho & 15; return 8 * (i >> 2) + 4 * n + (i & 3); }

struct Unit { int pm, pn; };
struct Gemm { const bf16_t* A; const bf16_t* Bt; int M, N, K; };

struct StaticOrder {
    int nM, nN, nwg, G, c;
    __host__ __device__ void init(int M, int N, int G_, int c_) { nM = M / BM; nN = N / BM; nwg = nM * nN; G = G_; c = c_; }
    __host__ __device__ bool next(int i, Unit& u) const {
        const long L = (long)i * G + c; if (L >= nwg) return false;
        int wgid = (int)L; { const int q = nwg / NXCD, r = nwg % NXCD, xcd = wgid % NXCD, off = wgid / NXCD; wgid = (xcd < r ? xcd * (q + 1) : r * (q + 1) + (xcd - r) * q) + off; }
        const int nig = WGM * nN, gid = wgid / nig, fm = gid * WGM, gsz = (nM - fm) < WGM ? (nM - fm) : WGM;
        u.pm = fm + ((wgid % nig) % gsz); u.pn = (wgid % nig) / gsz; return true;
    }
    __device__ __forceinline__ void a_ready(const Unit&) const {}
    __device__ __forceinline__ void done(const Unit&) const {}
};
typedef unsigned u32x2 __attribute__((ext_vector_type(2)));
typedef __bf16 bf16x2_t __attribute__((ext_vector_type(2)));
typedef float f32x2_t __attribute__((ext_vector_type(2)));
__device__ __forceinline__ unsigned pk2(float lo, float hi) { f32x2_t v = {lo, hi}; bf16x2_t b = __builtin_convertvector(v, bf16x2_t); return __builtin_bit_cast(unsigned, b); }
__device__ __forceinline__ float silu_mul(float g, float u) { return g * __builtin_amdgcn_rcpf(1.0f + __expf(-g)) * u; }
struct EpiSwiGLU {
    static constexpr bool PERM = true, AFTER_DRAIN = false;
    bf16_t* H; int ldh;
    __device__ __forceinline__ void operator()(const f32x4 (&acc)[2][2][4][2], const Unit& u, int wr, int wc, int fr, int fq) const {
        const int row0 = u.pm * BM + wr * 64 + fr, col0 = u.pn * HALF + wc * 32 + 8 * fq;
#pragma unroll
        for (int ai = 0; ai < 2; ++ai)
#pragma unroll
            for (int m = 0; m < 4; ++m) { bf16_t* rowp = H + (size_t)(row0 + ai * HALF + m * 16) * ldh + col0;
                const f32x4 g0 = acc[ai][0][m][0], g1 = acc[ai][0][m][1], u0 = acc[ai][1][m][0], u1 = acc[ai][1][m][1];
                u32x4 w; w.x = pk2(silu_mul(g0[0], u0[0]), silu_mul(g0[1], u0[1])); w.y = pk2(silu_mul(g0[2], u0[2]), silu_mul(g0[3], u0[3]));
                w.z = pk2(silu_mul(g1[0], u1[0]), silu_mul(g1[1], u1[1])); w.w = pk2(silu_mul(g1[2], u1[2]), silu_mul(g1[3], u1[3]));
                *(u32x4*)rowp = w; }
    }
};
struct EpiResid {
    static constexpr bool PERM = false, AFTER_DRAIN = false;
    const float* base; float* out; int ldc; float alpha;
    __device__ __forceinline__ void operator()(const f32x4 (&acc)[2][2][4][2], const Unit& u, int wr, int wc, int fr, int fq) const {
        const int row0 = u.pm * BM + wr * 64 + fr, col0 = u.pn * BM + wc * 32 + 4 * fq;
#pragma unroll
        for (int ai = 0; ai < 2; ++ai)
#pragma unroll
            for (int m = 0; m < 4; ++m) { const size_t off = (size_t)(row0 + ai * HALF + m * 16) * ldc + col0;
#pragma unroll
                for (int bj = 0; bj < 2; ++bj)
#pragma unroll
                    for (int n = 0; n < 2; ++n) { const size_t o = off + bj * HALF + n * 16; const f32x4 b = *(const f32x4*)(base + o); *(f32x4*)(out + o) = b + alpha * acc[ai][bj][m][n]; }
                asm volatile("" ::: "memory"); }
    }
};
struct EpiUA {
    static constexpr bool PERM = false, AFTER_DRAIN = true;
    bf16_t* CQN; bf16_t* CKVN; bf16_t* KPE; const float* qg; const float* kvg; const f32x2_t* tab;
    __device__ __forceinline__ void fused(f32x4 (&acc)[2][2][4][2], const Unit& u, int wr, int wc, int fr, int fq, PG8_LAS unsigned char* lds, int wid, int lane) const {
        PG8_LAS float* P = (PG8_LAS float*)lds;
        const bool isq = (u.pn == 0);
#pragma unroll
        for (int ai = 0; ai < 2; ++ai)
#pragma unroll
            for (int m = 0; m < 4; ++m) { float sq = 0.f;
#pragma unroll
                for (int bj = 0; bj < 2; ++bj) if (isq || bj == 0)
#pragma unroll
                    for (int n = 0; n < 2; ++n) { const f32x4 v = acc[ai][bj][m][n]; sq += (v[0] * v[0] + v[1] * v[1]) + (v[2] * v[2] + v[3] * v[3]); }
                sq += __shfl_xor(sq, 16); sq += __shfl_xor(sq, 32);
                if (fq == 0) P[(ai * HALF + wr * 64 + m * 16 + fr) * 4 + wc] = sq; }
        __syncthreads();
        const float invn = isq ? (1.0f / 256.0f) : (1.0f / 128.0f);
        const int row0 = u.pm * BM + wr * 64 + fr;
#pragma unroll
        for (int ai = 0; ai < 2; ++ai)
#pragma unroll
            for (int m = 0; m < 4; ++m) { const int lr = ai * HALF + wr * 64 + m * 16 + fr, row = u.pm * BM + lr;
                const f32x4 pp = *(const PG8_LAS f32x4*)(P + lr * 4);
                const float rstd = 1.0f / sqrtf(((pp[0] + pp[1]) + (pp[2] + pp[3])) * invn + 1e-6f);
#pragma unroll
                for (int bj = 0; bj < 2; ++bj)
#pragma unroll
                    for (int n = 0; n < 2; ++n) { const int col = bj * HALF + wc * 32 + n * 16 + 4 * fq; const f32x4 v = acc[ai][bj][m][n];
                        u32x2 w = (u32x2){0u, 0u};
                        if (isq) { const f32x4 g = *(const f32x4*)(qg + col); w.x = pk2(v[0] * rstd * g[0], v[1] * rstd * g[1]); w.y = pk2(v[2] * rstd * g[2], v[3] * rstd * g[3]); *(u32x2*)(CQN + (size_t)row * 256 + col) = w; }
                        else { if (bj == 0) { const f32x4 g = *(const f32x4*)(kvg + col); w.x = pk2(v[0] * rstd * g[0], v[1] * rstd * g[1]); w.y = pk2(v[2] * rstd * g[2], v[3] * rstd * g[3]); }
                               *(u32x2*)(CKVN + (size_t)row * 256 + col) = w; } }
                if (!isq && wc == 0) { const int pos = row & 4095; const f32x4 x1 = acc[ai][1][m][0], x2 = acc[ai][1][m][1]; float y1[4], y2[4];
#pragma unroll
                    for (int e = 0; e < 4; ++e) { const f32x2_t cs = tab[pos * 16 + 4 * fq + e]; y1[e] = x1[e] * cs.x - x2[e] * cs.y; y2[e] = x1[e] * cs.y + x2[e] * cs.x; }
                    u32x2 a; a.x = pk2(y1[0], y1[1]); a.y = pk2(y1[2], y1[3]); u32x2 b; b.x = pk2(y2[0], y2[1]); b.y = pk2(y2[2], y2[3]);
                    *(u32x2*)(KPE + (size_t)row * 32 + 4 * fq) = a; *(u32x2*)(KPE + (size_t)row * 32 + 16 + 4 * fq) = b; }
                asm volatile("" ::: "memory"); }
        __syncthreads();
    }
};
struct EpiF32 {
    static constexpr bool PERM = false, AFTER_DRAIN = false;
    float* C; int ldc;
    __device__ __forceinline__ void operator()(const f32x4 (&acc)[2][2][4][2], const Unit& u, int wr, int wc, int fr, int fq) const {
        const int row0 = u.pm * BM + wr * 64 + fr, col0 = u.pn * BM + wc * 32 + 4 * fq;
#pragma unroll
        for (int ai = 0; ai < 2; ++ai)
#pragma unroll
            for (int m = 0; m < 4; ++m) { float* rowp = C + (size_t)(row0 + ai * HALF + m * 16) * ldc + col0;
#pragma unroll
                for (int bj = 0; bj < 2; ++bj)
#pragma unroll
                    for (int n = 0; n < 2; ++n) *(f32x4*)(rowp + bj * HALF + n * 16) = acc[ai][bj][m][n]; }
    }
};
struct EpiBf16P {
    static constexpr bool PERM = true, AFTER_DRAIN = false;
    bf16_t* O; size_t ldc;
    __device__ __forceinline__ void operator()(const f32x4 (&acc)[2][2][4][2], const Unit& u, int wr, int wc, int fr, int fq) const {
        const int row0 = u.pm * BM + wr * 64 + fr, col0 = u.pn * BM + wc * 32 + 8 * fq;
#pragma unroll
        for (int ai = 0; ai < 2; ++ai)
#pragma unroll
            for (int m = 0; m < 4; ++m) { bf16_t* rowp = O + (size_t)(row0 + ai * HALF + m * 16) * ldc + col0;
#pragma unroll
                for (int bj = 0; bj < 2; ++bj) { const f32x4 v0 = acc[ai][bj][m][0], v1 = acc[ai][bj][m][1];
                    u32x4 w; w.x = pk2(v0[0], v0[1]); w.y = pk2(v0[2], v0[3]); w.z = pk2(v1[0], v1[1]); w.w = pk2(v1[2], v1[3]);
                    *(u32x4*)(rowp + bj * HALF) = w; } }
    }
};
struct EpiQ {
    static constexpr bool PERM = false, AFTER_DRAIN = false;
    bf16_t* Q; const f32x2_t* tab; float scale;
    __device__ __forceinline__ void operator()(const f32x4 (&acc)[2][2][4][2], const Unit& u, int wr, int wc, int fr, int fq) const {
        const int row0 = u.pm * BM + wr * 64 + fr, colb = u.pn * BM + wc * 32;
#pragma unroll
        for (int ai = 0; ai < 2; ++ai)
#pragma unroll
            for (int m = 0; m < 4; ++m) { const int row = row0 + ai * HALF + m * 16, pos = row & 4095;
#pragma unroll
                for (int bj = 0; bj < 2; ++bj) { const int cgp = colb + bj * HALF; const bool pe = ((cgp >> 5) % 3) == 2;
                    f32x4 a = acc[ai][bj][m][0], b = acc[ai][bj][m][1];
                    if (pe) {
#pragma unroll
                        for (int e = 0; e < 4; ++e) { const f32x2_t cs = tab[pos * 16 + 4 * fq + e]; const float x1 = a[e], x2 = b[e]; a[e] = x1 * cs.x - x2 * cs.y; b[e] = x1 * cs.y + x2 * cs.x; } }
                    a = a * scale; b = b * scale;
                    bf16_t* qp = Q + (size_t)row * 768 + cgp + 4 * fq;
                    u32x2 w0; w0.x = pk2(a[0], a[1]); w0.y = pk2(a[2], a[3]); *(u32x2*)qp = w0;
                    u32x2 w1; w1.x = pk2(b[0], b[1]); w1.y = pk2(b[2], b[3]); *(u32x2*)(qp + 16) = w1;
                    asm volatile("" ::: "memory"); } }
    }
};
template <class Epi, class Sched>
__device__ __forceinline__ void gemm_phase(PG8_LAS unsigned char* lds, const Gemm g, const Sched& S, const Epi& E) {
    const int tid = threadIdx.x, wid = __builtin_amdgcn_readfirstlane(tid >> 6), lane = tid & 63, wr = wid >> 2, wc = wid & 3, fr = lane & 15, fq = lane >> 4;
    const int K = g.K, nt = K / BK;
    unsigned voffA[2], voffB[2];
#pragma unroll
    for (int i = 0; i < 2; ++i) { int R, C; stage_rc(tid * 16 + i * 8192, R, C); const int Rb = Epi::PERM ? ((R & ~31) + perm32(R & 31)) : R;
        voffA[i] = (unsigned)(R * K + C) * 2u; voffB[i] = (unsigned)(Rb * K + C) * 2u; }
    const size_t kstep = (size_t)(BK * 2);
    const size_t hstep = (size_t)HALF * K * 2;
    const size_t tstep = 2 * hstep;
    const unsigned ldsw = (unsigned)wid * 1024u;
    const int aoff = lds_byte(wr * 64 + fr, fq * 8), boff = lds_byte(wc * 32 + fr, fq * 8);
#define PG8_SA(b, h) (((b) * 2 + (h)) * HTB)
#define PG8_SB(b, h) ((4 + (b) * 2 + (h)) * HTB)
#define PG8_STAGE(bufoff, gbase, voff) do { _Pragma("unroll") for (int _i = 0; _i < 2; ++_i) \
        __builtin_amdgcn_global_load_lds((const unsigned*)((const char*)(gbase) + (voff)[_i]), (PG8_LAS unsigned*)(lds + (bufoff) + ldsw + _i * 8192), 16, 0, 0); } while (0)
#define PG8_LDA(dst, b, h) do { _Pragma("unroll") for (int m = 0; m < 4; ++m) _Pragma("unroll") for (int k = 0; k < 2; ++k) dst[m][k] = *(const PG8_LAS bf16x8*)(lds + PG8_SA(b, h) + aoff + m * 2048 + k * 1024); } while (0)
#define PG8_LDB(dst, b, h) do { _Pragma("unroll") for (int n = 0; n < 2; ++n) _Pragma("unroll") for (int k = 0; k < 2; ++k) dst[n][k] = *(const PG8_LAS bf16x8*)(lds + PG8_SB(b, h) + boff + n * 2048 + k * 1024); } while (0)
#define PG8_MMA(ai, bj, At, Bt) do { __builtin_amdgcn_s_setprio(1); _Pragma("unroll") for (int m = 0; m < 4; ++m) _Pragma("unroll") for (int n = 0; n < 2; ++n) _Pragma("unroll") for (int k = 0; k < 2; ++k) \
        acc[ai][bj][m][n] = __builtin_amdgcn_mfma_f32_16x16x32_bf16(Bt[n][k], At[m][k], acc[ai][bj][m][n], 0, 0, 0); __builtin_amdgcn_s_setprio(0); } while (0)
#define PG8_WAIT_V(n) asm volatile("s_waitcnt vmcnt(" #n ")" ::: "memory")
#define PG8_WAIT_L(n) asm volatile("s_waitcnt lgkmcnt(" #n ")" ::: "memory")
#define PG8_BAR __builtin_amdgcn_s_barrier()
#define PG8_SCHED __builtin_amdgcn_sched_barrier(0)
    Unit cur, nxt; int ui = 0;
    if (!S.next(0, cur)) return;
    f32x4 acc[2][2][4][2];
#pragma unroll
    for (int a = 0; a < 2; ++a)
#pragma unroll
        for (int b = 0; b < 2; ++b)
#pragma unroll
            for (int m = 0; m < 4; ++m)
#pragma unroll
                for (int n = 0; n < 2; ++n) acc[a][b][m][n] = (f32x4){0.f, 0.f, 0.f, 0.f};
    bf16x8 At[4][2], B0[2][2], B1[2][2];
    const char* cA = (const char*)g.A + (size_t)cur.pm * tstep; const char* cB = (const char*)g.Bt + (size_t)cur.pn * tstep;
    S.a_ready(cur);
    PG8_STAGE(PG8_SB(0, 0), cB, voffB); PG8_STAGE(PG8_SA(0, 0), cA, voffA); PG8_STAGE(PG8_SB(0, 1), cB + hstep, voffB); PG8_STAGE(PG8_SA(0, 1), cA + hstep, voffA);
    if (wr == 1) PG8_BAR;
    PG8_WAIT_V(4); PG8_BAR;
    PG8_STAGE(PG8_SB(1, 0), cB + kstep, voffB); PG8_STAGE(PG8_SA(1, 0), cA + kstep, voffA); PG8_STAGE(PG8_SB(1, 1), cB + hstep + kstep, voffB);
    PG8_WAIT_V(6); PG8_BAR;
    for (;;) {
        const bool has_next = S.next(ui + 1, nxt);
        const char* nA = has_next ? (const char*)g.A + (size_t)nxt.pm * tstep : cA; const char* nB = has_next ? (const char*)g.Bt + (size_t)nxt.pn * tstep : cB;
        for (int t = 0; t < nt; t += 2) {
            const bool last = (t == nt - 2);
            const char* a1 = cA + (size_t)(t + 1) * kstep;
            const char* a2 = last ? nA : cA + (size_t)(t + 2) * kstep; const char* b2 = last ? nB : cB + (size_t)(t + 2) * kstep;
            const char* a3 = a2 + kstep; const char* b3 = b2 + kstep;
            if (last && has_next) S.a_ready(nxt);
            PG8_LDB(B0, 0, 0); PG8_SCHED; PG8_LDA(At, 0, 0); PG8_STAGE(PG8_SA(1, 1), a1 + hstep, voffA);
            PG8_WAIT_L(8); PG8_BAR; PG8_WAIT_L(0); PG8_MMA(0, 0, At, B0); PG8_BAR; PG8_SCHED;
            PG8_LDB(B1, 0, 1); PG8_STAGE(PG8_SB(0, 0), b2, voffB);
            PG8_BAR; PG8_WAIT_L(0); PG8_MMA(0, 1, At, B1); PG8_BAR;
            PG8_LDA(At, 0, 1); PG8_STAGE(PG8_SA(0, 0), a2, voffA);
            PG8_BAR; PG8_WAIT_L(0); PG8_MMA(1, 0, At, B0); PG8_BAR; PG8_SCHED;
            PG8_STAGE(PG8_SB(0, 1), b2 + hstep, voffB);
            PG8_WAIT_V(6); PG8_BAR; PG8_MMA(1, 1, At, B1); PG8_BAR;
            PG8_LDB(B0, 1, 0); PG8_SCHED; PG8_LDA(At, 1, 0); PG8_STAGE(PG8_SA(0, 1), a2 + hstep, voffA);
            PG8_WAIT_L(8); PG8_BAR; PG8_WAIT_L(0); PG8_MMA(0, 0, At, B0); PG8_BAR; PG8_SCHED;
            PG8_LDB(B1, 1, 1); PG8_STAGE(PG8_SB(1, 0), b3, voffB);
            PG8_BAR; PG8_WAIT_L(0); PG8_MMA(0, 1, At, B1); PG8_BAR;
            PG8_LDA(At, 1, 1); PG8_STAGE(PG8_SA(1, 0), a3, voffA);
            PG8_BAR; PG8_WAIT_L(0); PG8_MMA(1, 0, At, B0); PG8_BAR; PG8_SCHED;
            PG8_STAGE(PG8_SB(1, 1), b3 + hstep, voffB);
            PG8_WAIT_V(6); PG8_BAR; PG8_MMA(1, 1, At, B1); PG8_BAR;
        }
        if constexpr (!Epi::AFTER_DRAIN) { E(acc, cur, wr, wc, fr, fq); S.done(cur); }
        if (!has_next) break;
#pragma unroll
        for (int a = 0; a < 2; ++a)
#pragma unroll
            for (int b = 0; b < 2; ++b)
#pragma unroll
                for (int m = 0; m < 4; ++m)
#pragma unroll
                    for (int n = 0; n < 2; ++n) acc[a][b][m][n] = (f32x4){0.f, 0.f, 0.f, 0.f};
        cur = nxt; cA = nA; cB = nB; ++ui;
    }
    PG8_WAIT_V(0);
    if (wr == 0) PG8_BAR;
    PG8_BAR;
    if constexpr (Epi::AFTER_DRAIN) { E.fused(acc, cur, wr, wc, fr, fq, lds, wid, lane); S.done(cur); }
#undef PG8_SA
#undef PG8_SB
#undef PG8_STAGE
#undef PG8_LDA
#undef PG8_LDB
#undef PG8_MMA
#undef PG8_WAIT_V
#undef PG8_WAIT_L
#undef PG8_BAR
#undef PG8_SCHED
}
}

#define LAS __attribute__((address_space(3)))
using pg8::bf16_t; using pg8::bf16x8; using pg8::f32x4; using pg8::u32x4; using pg8::u32x2; using pg8::f32x2_t; using pg8::pk2;
typedef float f32x16 __attribute__((ext_vector_type(16)));
constexpr int MTOK = 32768, DM = 1024, FFH = 2816, SEQ = 4096, NB = 8;
constexpr float EPSN = 1e-6f;
constexpr size_t MiB = 1u << 20;
constexpr size_t WS_CTL = 0, WS_BAR = 16384, CTL_ZERO = 32768;
constexpr size_t WS_W1GU = 2 * MiB, WS_W1D = 13 * MiB, WS_W2GU = 19 * MiB, WS_W2D = 30 * MiB;
constexpr size_t WS_WINA = 36 * MiB, WS_WINB = 37 * MiB, WS_WUQ = 40 * MiB, WS_WUK = 41 * MiB, WS_WUV = 41 * MiB + 512 * 1024, WS_WOUT = 42 * MiB;
constexpr size_t WS_ROPE = 44 * MiB, WS_FILT = 46 * MiB, WS_XN = 80 * MiB, WS_H = 144 * MiB;
constexpr size_t WS_UA = 144 * MiB, WS_UT = 208 * MiB, WS_KPE = 304 * MiB;
constexpr size_t WS_CQN = 320 * MiB, WS_CKVN = 336 * MiB, WS_Q = 352 * MiB  , WS_KN = 448 * MiB, WS_VT = 480 * MiB, WS_HYT = WS_UA  , WS_END = 512 * MiB;
constexpr size_t WS_MIXN = WS_XN;
constexpr int LDS_BYTES = 147456;
constexpr int NPHASE = 14;

__device__ __forceinline__ float wave_sum(float v) {
#pragma unroll
    for (int o = 1; o < 64; o <<= 1) v += __shfl_xor(v, o);
    return v;
}
__device__ __forceinline__ float bf2f(unsigned short b) { return __uint_as_float(((unsigned)b) << 16); }
__device__ __forceinline__ f32x16 mfma32(bf16x8 a, bf16x8 b, f32x16 c) { return __builtin_amdgcn_mfma_f32_32x32x16_bf16(a, b, c, 0, 0, 0); }
__device__ __forceinline__ void sincos_rr(float x, float& sn, float& cs) {
    const float n = rintf(x * 0.15915494309189535f);
    float r = fmaf(-n, 6.2831854820251465f, x); r = fmaf(-n, -1.7484555314695172e-7f, r);
    sn = __sinf(r); cs = __cosf(r);
}
#define LDS_WAIT() asm volatile("s_waitcnt lgkmcnt(0)" ::: "memory")

struct Params { const float* in[27]; float* out; unsigned char* ws; int ph_lo, ph_hi; };

__device__ __forceinline__ void tr_item(const float* src, int ldsrc, int scol0, int k0, bool valid, bf16_t* dst, int lddst, int drow0, LAS float* scr, int lane) {
    if (valid) {
#pragma unroll 8
        for (int i = 0; i < 32; ++i) { const int kk = 2 * i + (lane >> 5); scr[kk * 33 + (lane & 31)] = src[(size_t)(k0 + kk) * ldsrc + scol0 + (lane & 31)]; }
    } else {
#pragma unroll 8
        for (int i = 0; i < 32; ++i) { const int kk = 2 * i + (lane >> 5); scr[kk * 33 + (lane & 31)] = 0.f; }
    }
    LDS_WAIT();
    const int c = lane & 7;
#pragma unroll
    for (int j = 0; j < 4; ++j) { const int n = (lane >> 3) + 8 * j; const LAS float* s = scr + (8 * c) * 33 + n;
        u32x4 o; o.x = pk2(s[0 * 33], s[1 * 33]); o.y = pk2(s[2 * 33], s[3 * 33]); o.z = pk2(s[4 * 33], s[5 * 33]); o.w = pk2(s[6 * 33], s[7 * 33]);
        *(u32x4*)(dst + (size_t)(drow0 + n) * lddst + k0 + 8 * c) = o; }
    LDS_WAIT();
}

__device__ __forceinline__ void rms_rows2_bf16(const float* xa, const float* xb, const float* g, bf16_t* oa, bf16_t* ob, int lane) {
    const f32x4* ra = (const f32x4*)xa + lane; const f32x4* rb = (const f32x4*)xb + lane; const f32x4* gr = (const f32x4*)g + lane;
    f32x4 va[4], vb[4]; float sa = 0.f, sb = 0.f;
#pragma unroll
    for (int j = 0; j < 4; ++j) { va[j] = ra[64 * j]; vb[j] = rb[64 * j]; }
#pragma unroll
    for (int j = 0; j < 4; ++j) { sa += (va[j].x * va[j].x + va[j].y * va[j].y) + (va[j].z * va[j].z + va[j].w * va[j].w); sb += (vb[j].x * vb[j].x + vb[j].y * vb[j].y) + (vb[j].z * vb[j].z + vb[j].w * vb[j].w); }
    const float rsa = 1.0f / sqrtf(wave_sum(sa) * (1.0f / DM) + EPSN), rsb = 1.0f / sqrtf(wave_sum(sb) * (1.0f / DM) + EPSN);
    u32x2* pa = (u32x2*)oa + lane; u32x2* pb = (u32x2*)ob + lane;
#pragma unroll
    for (int j = 0; j < 4; ++j) { const f32x4 gv = gr[64 * j]; u32x2 w;
        w.x = pk2(va[j].x * rsa * gv.x, va[j].y * rsa * gv.y); w.y = pk2(va[j].z * rsa * gv.z, va[j].w * rsa * gv.w); pa[64 * j] = w;
        w.x = pk2(vb[j].x * rsb * gv.x, vb[j].y * rsb * gv.y); w.y = pk2(vb[j].z * rsb * gv.z, vb[j].w * rsb * gv.w); pb[64 * j] = w; }
}
__device__ __forceinline__ void rms_row_bf16(const float* xrow, const float* g, bf16_t* orow, int lane) {
    const f32x4* xr = (const f32x4*)xrow + lane; const f32x4* gr = (const f32x4*)g + lane;
    f32x4 v[4]; float s = 0.f;
#pragma unroll
    for (int j = 0; j < 4; ++j) { v[j] = xr[64 * j]; s += (v[j].x * v[j].x + v[j].y * v[j].y) + (v[j].z * v[j].z + v[j].w * v[j].w); }
    const float rstd = 1.0f / sqrtf(wave_sum(s) * (1.0f / DM) + EPSN);
    u32x2* o8 = (u32x2*)orow + lane;
#pragma unroll
    for (int j = 0; j < 4; ++j) { const f32x4 gv = gr[64 * j]; u32x2 w; w.x = pk2(v[j].x * rstd * gv.x, v[j].y * rstd * gv.y); w.y = pk2(v[j].z * rstd * gv.z, v[j].w * rstd * gv.w); o8[64 * j] = w; }
}

__device__ __forceinline__ void filter_block(const Params& p, LAS unsigned char* lds, int pb, int tid) {
    LAS float* z = (LAS float*)(lds + 131072); LAS float* h1 = z + 528; LAS float* h2 = h1 + 1024;
    const float *w1 = p.in[13], *b1 = p.in[14], *w2 = p.in[15], *b2 = p.in[16], *w3 = p.in[17], *fr = p.in[18];
    float* FILT = (float*)(p.ws + WS_FILT); float* NORM = (float*)(p.ws + WS_CTL);
    for (int idx = tid; idx < 528; idx += 512) { const int pp = idx / 33, e = idx - pp * 33; const float t = (float)(pb * 16 + pp);
        float v;
        if (e == 0) v = t / 4095.0f;
        else { const int j = (e - 1) & 15; const float band = 1e-4f + (float)j * ((15.0f - 1e-4f) / 15.0f); const float ang = (6.283185307179586f * t / 4096.0f) * band; float sn, cs; sincos_rr(ang, sn, cs); v = (e <= 16) ? cs : -sn; }
        z[idx] = v; }
    __syncthreads();
    for (int idx = tid; idx < 1024; idx += 512) { const int pp = idx >> 6, j = idx & 63; float a = b1[j];
#pragma unroll 3
        for (int e = 0; e < 33; ++e) a += z[pp * 33 + e] * w1[e * 64 + j];
        float sn, cs; sincos_rr(fr[j] * a, sn, cs); h1[idx] = sn; }
    __syncthreads();
    for (int idx = tid; idx < 1024; idx += 512) { const int pp = idx >> 6, j = idx & 63; float a = b2[j];
#pragma unroll 4
        for (int i = 0; i < 64; ++i) a += h1[pp * 64 + i] * w2[i * 64 + j];
        float sn, cs; sincos_rr(fr[j] * a, sn, cs); h2[idx] = sn; }
    __syncthreads();
    const float dmin = 3.0701134573253945f, dmax = 15.350567286626973f;
#pragma unroll 1
    for (int m = 0; m < 4; ++m) { const int q = tid + 512 * m;
        float acc[16];
#pragma unroll
        for (int pp = 0; pp < 16; ++pp) acc[pp] = 0.f;
#pragma unroll 2
        for (int i = 0; i < 64; ++i) { const float w = w3[i * 2048 + q];
#pragma unroll
            for (int pp = 0; pp < 16; ++pp) acc[pp] += h2[pp * 64 + i] * w; }
        const int o = q >> 10, dir = (q >> 9) & 1, c = q & 511; const float delta = dmin + (float)c * ((dmax - dmin) / 511.0f);
        float sabs = 0.f;
#pragma unroll
        for (int pp = 0; pp < 16; ++pp) { const int t = pb * 16 + pp; const float v = acc[pp] * __expf(-((float)t / 4095.0f) * delta); acc[pp] = v; if (!(dir == 1 && t == 0)) sabs += fabsf(v); }
        float* dst = FILT + ((size_t)((o * 2 + dir) * 512 + c)) * 4096 + pb * 16;
#pragma unroll
        for (int k = 0; k < 4; ++k) *(f32x4*)(dst + 4 * k) = (f32x4){acc[4 * k], acc[4 * k + 1], acc[4 * k + 2], acc[4 * k + 3]};
        atomicAdd(&NORM[o * 512 + c], sabs); }
    __syncthreads();
}

constexpr int KL_STRIDE = 208, VL_STRIDE = 144, KL_BYTES = 64 * KL_STRIDE, VL_BYTES = 64 * VL_STRIDE, ATT_BUF = KL_BYTES + VL_BYTES;
__device__ __forceinline__ bf16x8 pack8(const f32x16& x, int s) {
    u32x4 p; p.x = pk2(x[8 * s], x[8 * s + 1]); p.y = pk2(x[8 * s + 2], x[8 * s + 3]); p.z = pk2(x[8 * s + 4], x[8 * s + 5]); p.w = pk2(x[8 * s + 6], x[8 * s + 7]);
    return __builtin_bit_cast(bf16x8, p);
}
__device__ __forceinline__ void attn_unit(const Params& p, LAS unsigned char* lds, int unit, int tid, int lane, int wave) {
    const int bh = unit >> 4, qb = unit & 15, b = bh >> 3, h = bh & 7, r = lane & 31, hh = lane >> 5;
    const float* Q = (const float*)(p.ws + WS_Q); const bf16_t* KN = (const bf16_t*)(p.ws + WS_KN); const bf16_t* KPE = (const bf16_t*)(p.ws + WS_KPE); const bf16_t* VT = (const bf16_t*)(p.ws + WS_VT);
    bf16_t* MIXN = (bf16_t*)(p.ws + WS_MIXN);
    const size_t tok0 = (size_t)b * SEQ, qrow = tok0 + qb * 256 + wave * 32 + r;
    bf16x8 qf[6];
    { const float QS = 0.14724352f;
      const float* qp = Q + qrow * 768 + 96 * h + 8 * hh;
#pragma unroll
      for (int ks = 0; ks < 4; ++ks) { const f32x4 a = *(const f32x4*)(qp + 16 * ks), b = *(const f32x4*)(qp + 16 * ks + 4);
          u32x4 w; w.x = pk2(a.x * QS, a.y * QS); w.y = pk2(a.z * QS, a.w * QS); w.z = pk2(b.x * QS, b.y * QS); w.w = pk2(b.z * QS, b.w * QS); qf[ks] = __builtin_bit_cast(bf16x8, w); }
      const f32x2_t* tab = (const f32x2_t*)(p.ws + WS_ROPE) + (size_t)((int)(qrow & 4095)) * 16 + 8 * hh;
      float x1[8], x2[8];
      { const f32x4 a = *(const f32x4*)(qp + 64), b = *(const f32x4*)(qp + 68), c = *(const f32x4*)(qp + 80), d = *(const f32x4*)(qp + 84);
        x1[0] = a.x; x1[1] = a.y; x1[2] = a.z; x1[3] = a.w; x1[4] = b.x; x1[5] = b.y; x1[6] = b.z; x1[7] = b.w;
        x2[0] = c.x; x2[1] = c.y; x2[2] = c.z; x2[3] = c.w; x2[4] = d.x; x2[5] = d.y; x2[6] = d.z; x2[7] = d.w; }
      float y1[8], y2[8];
#pragma unroll
      for (int j = 0; j < 8; ++j) { const f32x2_t cs = tab[j]; y1[j] = (x1[j] * cs.x - x2[j] * cs.y) * QS; y2[j] = (x1[j] * cs.y + x2[j] * cs.x) * QS; }
      u32x4 w; w.x = pk2(y1[0], y1[1]); w.y = pk2(y1[2], y1[3]); w.z = pk2(y1[4], y1[5]); w.w = pk2(y1[6], y1[7]); qf[4] = __builtin_bit_cast(bf16x8, w);
      w.x = pk2(y2[0], y2[1]); w.y = pk2(y2[2], y2[3]); w.z = pk2(y2[4], y2[5]); w.w = pk2(y2[6], y2[7]); qf[5] = __builtin_bit_cast(bf16x8, w); }
    const int kc1 = tid + 512; const bool has1 = tid < 256;
    const int key0 = tid / 12, part0 = tid - key0 * 12, key1 = kc1 / 12, part1 = kc1 - key1 * 12;
    const bf16_t* ks0 = part0 < 8 ? KN + (tok0 + key0) * 512 + 64 * h + 8 * part0 : KPE + (tok0 + key0) * 32 + 8 * (part0 - 8);
    const bf16_t* ks1 = part1 < 8 ? KN + (tok0 + key1) * 512 + 64 * h + 8 * part1 : KPE + (tok0 + key1) * 32 + 8 * (part1 - 8);
    const int kst0 = part0 < 8 ? 64 * 512 : 64 * 32, kst1 = part1 < 8 ? 64 * 512 : 64 * 32;
    const bf16_t* vs = VT + (size_t)(64 * h + (tid >> 3)) * MTOK + tok0 + 8 * (tid & 7);
    const int kd0 = key0 * KL_STRIDE + part0 * 16, kd1 = key1 * KL_STRIDE + part1 * 16, vd = KL_BYTES + (tid >> 3) * VL_STRIDE + (tid & 7) * 16;
    u32x4 rk0, rk1 = (u32x4){0u, 0u, 0u, 0u}, rv;
    rk0 = *(const u32x4*)ks0; if (has1) rk1 = *(const u32x4*)ks1; rv = *(const u32x4*)vs;
    *(LAS u32x4*)(lds + kd0) = rk0; if (has1) *(LAS u32x4*)(lds + kd1) = rk1; *(LAS u32x4*)(lds + vd) = rv;
    __syncthreads();
    f32x16 o0, o1;
#pragma unroll
    for (int i = 0; i < 16; ++i) { o0[i] = 0.f; o1[i] = 0.f; }
    f32x2_t lsum2 = {0.f, 0.f};
    for (int kt = 0; kt < 64; ++kt) {
        const int buf = kt & 1; const bool more = kt + 1 < 64;
        if (more) { rk0 = *(const u32x4*)(ks0 + (size_t)(kt + 1) * kst0); if (has1) rk1 = *(const u32x4*)(ks1 + (size_t)(kt + 1) * kst1); rv = *(const u32x4*)(vs + (kt + 1) * 64); }
        const LAS unsigned char* KLb = lds + buf * ATT_BUF; const LAS unsigned char* VLb = KLb + KL_BYTES;
        f32x16 s0, s1;
        { const f32x16 zero16 = {0.f, 0.f, 0.f, 0.f, 0.f, 0.f, 0.f, 0.f, 0.f, 0.f, 0.f, 0.f, 0.f, 0.f, 0.f, 0.f};
          const bf16x8 ka = *(const LAS bf16x8*)(KLb + r * KL_STRIDE + 16 * hh);
          const bf16x8 kb = *(const LAS bf16x8*)(KLb + (32 + r) * KL_STRIDE + 16 * hh);
          s0 = mfma32(ka, qf[0], zero16); s1 = mfma32(kb, qf[0], zero16); }
#pragma unroll
        for (int ks = 1; ks < 6; ++ks) {
            const bf16x8 ka = *(const LAS bf16x8*)(KLb + r * KL_STRIDE + 32 * ks + 16 * hh);
            const bf16x8 kb = *(const LAS bf16x8*)(KLb + (32 + r) * KL_STRIDE + 32 * ks + 16 * hh);
            s0 = mfma32(ka, qf[ks], s0); s1 = mfma32(kb, qf[ks], s1); }
#pragma unroll
        for (int i = 0; i < 16; ++i) { s0[i] = __builtin_amdgcn_exp2f(s0[i]); s1[i] = __builtin_amdgcn_exp2f(s1[i]); }
#pragma unroll
        for (int i = 0; i < 16; i += 2) { lsum2 += (f32x2_t){s0[i], s0[i + 1]}; lsum2 += (f32x2_t){s1[i], s1[i + 1]}; }
        bf16x8 pf[2][2];
        pf[0][0] = pack8(s0, 0); pf[0][1] = pack8(s0, 1); pf[1][0] = pack8(s1, 0); pf[1][1] = pack8(s1, 1);
#pragma unroll
        for (int sub = 0; sub < 2; ++sub)
#pragma unroll
            for (int s = 0; s < 2; ++s) {
                const LAS unsigned char* vp = VLb + r * VL_STRIDE + (32 * sub + 16 * s + 4 * hh) * 2;
                const u32x2 lo0 = *(const LAS u32x2*)vp, hi0 = *(const LAS u32x2*)(vp + 16);
                const u32x2 lo1 = *(const LAS u32x2*)(vp + 32 * VL_STRIDE), hi1 = *(const LAS u32x2*)(vp + 32 * VL_STRIDE + 16);
                const bf16x8 va0 = __builtin_bit_cast(bf16x8, ((u32x4){lo0.x, lo0.y, hi0.x, hi0.y}));
                const bf16x8 va1 = __builtin_bit_cast(bf16x8, ((u32x4){lo1.x, lo1.y, hi1.x, hi1.y}));
                o0 = mfma32(va0, pf[sub][s], o0); o1 = mfma32(va1, pf[sub][s], o1); }
        if (more) { LAS unsigned char* nb = lds + (buf ^ 1) * ATT_BUF; *(LAS u32x4*)(nb + kd0) = rk0; if (has1) *(LAS u32x4*)(nb + kd1) = rk1; *(LAS u32x4*)(nb + vd) = rv; }
        __syncthreads();
    }
    const float lsum = lsum2.x + lsum2.y; const float l = lsum + __shfl_xor(lsum, 32); const float inv = 1.0f / l;
    float ss = 0.f;
#pragma unroll
    for (int i = 0; i < 16; ++i) { o0[i] *= inv; o1[i] *= inv; ss += o0[i] * o0[i] + o1[i] * o1[i]; }
    ss += __shfl_xor(ss, 32);
    const float rstd = 1.0f / sqrtf(ss * (1.0f / 64.0f) + EPSN);
    const float* hg = p.in[20] + 64 * h;
#pragma unroll
    for (int g = 0; g < 4; ++g) {
        const int dv0 = 8 * g + 4 * hh, dv1 = 32 + dv0;
        const f32x4 g0 = *(const f32x4*)(hg + dv0), g1 = *(const f32x4*)(hg + dv1);
        u32x2 w0, w1;
        w0.x = pk2(o0[4 * g] * rstd * g0.x, o0[4 * g + 1] * rstd * g0.y); w0.y = pk2(o0[4 * g + 2] * rstd * g0.z, o0[4 * g + 3] * rstd * g0.w);
        w1.x = pk2(o1[4 * g] * rstd * g1.x, o1[4 * g + 1] * rstd * g1.y); w1.y = pk2(o1[4 * g + 2] * rstd * g1.z, o1[4 * g + 3] * rstd * g1.w);
        *(u32x2*)(MIXN + qrow * 1024 + 64 * h + dv0) = w0; *(u32x2*)(MIXN + qrow * 1024 + 64 * h + dv1) = w1; }
}

constexpr int UT_STRIDE = 8192 + 16, UTL_BYTES = 8 * UT_STRIDE, RL_OFF = UTL_BYTES, RL1_OFF = 16384 + 64  , ZR_OFF = RL_OFF + 32768 + 128;
typedef short bf16x8_a4 __attribute__((ext_vector_type(8), aligned(4)));
__device__ __forceinline__ void hy_load_filter(const Params& p, LAS unsigned char* lds, int o, int c, int tid) {
    LAS bf16_t* RL = (LAS bf16_t*)(lds + RL_OFF);
    const float* FILT = (const float*)(p.ws + WS_FILT); const float* NORM = (const float*)(p.ws + WS_CTL);
    const float invn = 1.0f / NORM[o * 512 + c];
    const float* hf = FILT + (size_t)((o * 2 + 0) * 512 + c) * 4096; const float* hb = FILT + (size_t)((o * 2 + 1) * 512 + c) * 4096;
    float fv[16];
#pragma unroll
    for (int k = 0; k < 16; ++k) { const int i = tid + 512 * k; const int j = i - 4095; fv[k] = (k < 8) ? hf[4095 - i] : hb[j > 4095 ? 4095 : j]; }
#pragma unroll
    for (int k = 0; k < 16; ++k) { const int i = tid + 512 * k; const float v = (i < 8191) ? fv[k] * invn : 0.f;
        const bf16_t hv = (bf16_t)(pk2(v, 0.f) & 0xffffu); RL[i] = hv; if (i > 0) RL[RL1_OFF / 2 + i - 1] = hv; }
    if (tid == 0) RL[RL1_OFF / 2 + 8191] = 0;
}
#define HY_RD2(lo, hi, addr, o0, o1, o2, o3) asm volatile("ds_read2_b32 %0, %2 offset0:" #o0 " offset1:" #o1 "\n\tds_read2_b32 %1, %2 offset0:" #o2 " offset1:" #o3 : "=&v"(lo), "=&v"(hi) : "v"(addr))
#define HY_RDB(dst, addr, off) asm volatile("ds_read_b128 %0, %1 offset:" #off : "=&v"(dst) : "v"(addr))
__device__ __forceinline__ void hy_conv(LAS unsigned char* lds, f32x16 (&acc)[2][2], int lane, int wave) {
    const int r = lane & 31, hh = lane >> 5, bb = r & 7, t1o = r >> 3;
#pragma unroll
    for (int a = 0; a < 2; ++a)
#pragma unroll
        for (int b = 0; b < 2; ++b)
#pragma unroll
            for (int i = 0; i < 16; ++i) acc[a][b][i] = 0.f;
    const unsigned lbase = (unsigned)(size_t)lds;
    const int e00 = 4095 + 8 * hh - r;
    const unsigned a_cst = lbase + RL_OFF + ((e00 & 1) ? (RL1_OFF + 2 * (e00 - 1)) : 2 * e00) - 64;
    const unsigned b_cst = lbase + bb * UT_STRIDE + 16 * hh, z_addr = lbase + ZR_OFF;
    u32x2 wl[6], wh[6]; u32x4 Bq[2][4];
    { const unsigned a0 = a_cst - 128 * (8 * wave - 63);
      asm volatile("" ::: "memory");
      HY_RD2(wl[4], wh[4], a0, 32, 33, 34, 35); HY_RD2(wl[5], wh[5], a0, 40, 41, 42, 43); }
    for (int q = 0; q < 71; ++q) {
        const int d1 = 8 * wave - 63 + q;
        const unsigned aa = a_cst - 128 * d1;
        HY_RD2(wl[0], wh[0], aa, 0, 1, 2, 3); HY_RD2(wl[1], wh[1], aa, 8, 9, 10, 11); HY_RD2(wl[2], wh[2], aa, 16, 17, 18, 19); HY_RD2(wl[3], wh[3], aa, 24, 25, 26, 27);
#pragma unroll
        for (int nt = 0; nt < 2; ++nt) { const int s1 = 8 * wave + 4 * nt + t1o - d1; const unsigned ba = ((unsigned)s1 < 64u) ? b_cst + 128 * s1 : z_addr;
            HY_RDB(Bq[nt][0], ba, 0); HY_RDB(Bq[nt][1], ba, 32); HY_RDB(Bq[nt][2], ba, 64); HY_RDB(Bq[nt][3], ba, 96); }
        asm volatile("s_waitcnt lgkmcnt(0)" : "+v"(wl[0]), "+v"(wh[0]), "+v"(wl[1]), "+v"(wh[1]), "+v"(wl[2]), "+v"(wh[2]), "+v"(wl[3]), "+v"(wh[3]), "+v"(wl[4]), "+v"(wh[4]), "+v"(wl[5]), "+v"(wh[5]));
        asm volatile("" : "+v"(Bq[0][0]), "+v"(Bq[0][1]), "+v"(Bq[0][2]), "+v"(Bq[0][3]), "+v"(Bq[1][0]), "+v"(Bq[1][1]), "+v"(Bq[1][2]), "+v"(Bq[1][3]));
        bf16x8 W6[6];
#pragma unroll
        for (int k = 0; k < 6; ++k) W6[k] = __builtin_bit_cast(bf16x8, ((u32x4){wl[k].x, wl[k].y, wh[k].x, wh[k].y}));
#pragma unroll
        for (int ks = 0; ks < 4; ++ks)
#pragma unroll
            for (int mt = 0; mt < 2; ++mt)
#pragma unroll
                for (int nt = 0; nt < 2; ++nt) acc[mt][nt] = mfma32(W6[ks - 2 * mt + 2], __builtin_bit_cast(bf16x8, Bq[nt][ks]), acc[mt][nt]);
        wl[4] = wl[0]; wh[4] = wh[0]; wl[5] = wl[1]; wh[5] = wh[1];
    }
}
__device__ __forceinline__ void hy_stage_col(const Params& p, LAS unsigned char* lds, int gc, int tid) {
    const bf16_t* UTg = (const bf16_t*)(p.ws + WS_UT);
    const float* cw = p.in[11]; const float w0 = cw[gc], w1 = cw[1536 + gc], w2 = cw[3072 + gc], cbv = p.in[12][gc];
    u32x4 raw[8]; unsigned pv[8], nx[8];
#pragma unroll
    for (int i = 0; i < 8; ++i) { const int ch = tid + 512 * i, b = ch >> 9, s0 = (ch & 511) * 8;
        const bf16_t* src = UTg + (size_t)gc * MTOK + b * SEQ + s0;
        raw[i] = *(const u32x4*)src; pv[i] = src[s0 > 0 ? -1 : 0]; nx[i] = src[s0 + 8 < SEQ ? 8 : 7]; }
#pragma unroll
    for (int i = 0; i < 8; ++i) { const int ch = tid + 512 * i, b = ch >> 9, s0 = (ch & 511) * 8;
        float f[10];
        f[0] = s0 > 0 ? __uint_as_float(pv[i] << 16) : 0.f; f[9] = s0 + 8 < SEQ ? __uint_as_float(nx[i] << 16) : 0.f;
        f[1] = __uint_as_float(raw[i].x << 16); f[2] = __uint_as_float(raw[i].x & 0xffff0000u); f[3] = __uint_as_float(raw[i].y << 16); f[4] = __uint_as_float(raw[i].y & 0xffff0000u);
        f[5] = __uint_as_float(raw[i].z << 16); f[6] = __uint_as_float(raw[i].z & 0xffff0000u); f[7] = __uint_as_float(raw[i].w << 16); f[8] = __uint_as_float(raw[i].w & 0xffff0000u);
        float v[8];
#pragma unroll
        for (int j = 0; j < 8; ++j) v[j] = cbv + w0 * f[j] + w1 * f[j + 1] + w2 * f[j + 2];
        u32x4 w; w.x = pk2(v[0], v[1]); w.y = pk2(v[2], v[3]); w.z = pk2(v[4], v[5]); w.w = pk2(v[6], v[7]);
        *(LAS u32x4*)(lds + b * UT_STRIDE + s0 * 2) = w; }
}
template <int MODE>
__device__ __forceinline__ void hy_own(LAS unsigned char* lds, f32x16 (&acc)[2][2], float dsk, int lane, int wave) {
    const int r = lane & 31, hh = lane >> 5, bb = r & 7, t1o = r >> 3;
#pragma unroll
    for (int mt = 0; mt < 2; ++mt)
#pragma unroll
        for (int nt = 0; nt < 2; ++nt)
#pragma unroll
            for (int g = 0; g < 4; ++g) {
                const int t = 64 * (8 * wave + 4 * nt + t1o) + 32 * mt + 8 * g + 4 * hh;
                LAS unsigned char* up = lds + bb * UT_STRIDE + t * 2;
                const u32x2 ur = *(const LAS u32x2*)up;
                float uv[4]; uv[0] = __uint_as_float(ur.x << 16); uv[1] = __uint_as_float(ur.x & 0xffff0000u); uv[2] = __uint_as_float(ur.y << 16); uv[3] = __uint_as_float(ur.y & 0xffff0000u);
                if (MODE == 0) {
#pragma unroll
                    for (int j = 0; j < 4; ++j) acc[mt][nt][4 * g + j] += uv[j] * dsk;
                } else { u32x2 w; w.x = pk2(acc[mt][nt][4 * g] * uv[0], acc[mt][nt][4 * g + 1] * uv[1]); w.y = pk2(acc[mt][nt][4 * g + 2] * uv[2], acc[mt][nt][4 * g + 3] * uv[3]); *(LAS u32x2*)up = w; }
            }
}
__device__ __forceinline__ void hy_copy_out(const Params& p, LAS unsigned char* lds, int c, int tid) {
    bf16_t* HYT = (bf16_t*)(p.ws + WS_HYT);
#pragma unroll
    for (int i = 0; i < 8; ++i) { const int ch = tid + 512 * i, b = ch >> 9, s0 = (ch & 511) * 8;
        *(u32x4*)(HYT + (size_t)c * MTOK + b * SEQ + s0) = *(const LAS u32x4*)(lds + b * UT_STRIDE + s0 * 2); }
}
__device__ __forceinline__ void hyena_channel(const Params& p, LAS unsigned char* lds, int c, int tid, int lane, int wave) {
    const float d0 = p.in[19][c], d1 = p.in[19][512 + c];
    hy_stage_col(p, lds, c, tid);
    if (tid < 32) *(LAS unsigned*)(lds + ZR_OFF + 4 * tid) = 0u;
    hy_load_filter(p, lds, 0, c, tid);
    __syncthreads();
    f32x16 acc[2][2];
    hy_conv(lds, acc, lane, wave);
    __syncthreads();
    hy_own<0>(lds, acc, d0, lane, wave);
    __syncthreads();
    hy_stage_col(p, lds, 512 + c, tid);
    hy_load_filter(p, lds, 1, c, tid);
    __syncthreads();
    hy_own<1>(lds, acc, 0.f, lane, wave);
    __syncthreads();
    hy_conv(lds, acc, lane, wave);
    __syncthreads();
    hy_own<0>(lds, acc, d1, lane, wave);
    __syncthreads();
    hy_stage_col(p, lds, 1024 + c, tid);
    __syncthreads();
    hy_own<1>(lds, acc, 0.f, lane, wave);
    __syncthreads();
    hy_copy_out(p, lds, c, tid);
    __syncthreads();
}

#define XB_TMO      128
#define XB_XCNT(j)  (256  + 64 * (j))
#define XB_XSUB(j)  (1280 + 64 * (j))
#define XB_XGEN(j)  (2304 + 64 * (j))
#define XB_TOP      3328
#define XB_TOPGEN   3392
#define XCD_BAR_WORDS 3456
#define XB_SPIN_CAP (1u << 18)

__device__ __forceinline__ unsigned xb_ld(unsigned* p)              { return __hip_atomic_load(p, __ATOMIC_RELAXED, __HIP_MEMORY_SCOPE_AGENT); }
__device__ __forceinline__ unsigned xb_add(unsigned* p, unsigned v) { return __hip_atomic_fetch_add(p, v, __ATOMIC_RELAXED, __HIP_MEMORY_SCOPE_AGENT); }
__device__ __forceinline__ unsigned xb_xcc_id() { return (unsigned)__builtin_amdgcn_s_getreg((3 << 11) | 20) & 0xFu; }
#define XB_SPIN(cond, bar) do { unsigned _sp = 0; while (cond) { __builtin_amdgcn_s_sleep(1); \
    if ((++_sp & 255u) == 0u) { if (xb_ld(&(bar)[XB_TMO])) break; if (_sp > XB_SPIN_CAP) { atomicAdd(&(bar)[XB_TMO], 1u); break; } } } } while (0)

struct XcdBarrier {
    unsigned* bar; unsigned x;
    volatile LAS unsigned* st;
};

__device__ __forceinline__ XcdBarrier xcd_barrier_post(unsigned* bar, volatile LAS unsigned* st) {
    XcdBarrier b; b.bar = bar; b.x = xb_xcc_id(); b.st = st;
    if (threadIdx.x == 0) (void)xb_add(&bar[XB_XCNT(b.x)], 1u);
    return b;
}
__device__ __forceinline__ void xcd_barrier_complete(unsigned* bar, unsigned x, unsigned& nloc, unsigned& nx) {
    const unsigned G = gridDim.x * gridDim.y * gridDim.z;
    unsigned sum, cnt, mine, sp = 0u;
    for (;;) {
        sum = 0u; cnt = 0u; mine = 0u;
#pragma unroll
        for (unsigned j = 0; j < 16; ++j) { const unsigned c = xb_ld(&bar[XB_XCNT(j)]); sum += c; cnt += (c > 0u) ? 1u : 0u; mine = (j == x) ? c : mine; }
        if (sum == G) break;
        __builtin_amdgcn_s_sleep(1);
        if ((++sp & 255u) == 0u) { if (xb_ld(&bar[XB_TMO])) break; if (sp > XB_SPIN_CAP) { atomicAdd(&bar[XB_TMO], 1u); break; } }
    }
    nloc = mine > 0u ? mine : 1u; nx = cnt > 0u ? cnt : 1u;
}

__device__ __forceinline__ void xcd_barrier(const XcdBarrier& b) {
    asm volatile("s_waitcnt vmcnt(0)" ::: "memory");
    __syncthreads();
    if (threadIdx.x == 0) {
        unsigned* bar = b.bar;
        __builtin_amdgcn_s_waitcnt(0);
        unsigned nloc = b.st[0], nx = b.st[1];
        if (nloc == 0u) { xcd_barrier_complete(bar, b.x, nloc, nx); b.st[0] = nloc; b.st[1] = nx; }
        const unsigned old = xb_add(&bar[XB_XSUB(b.x)], 1u);
        const unsigned gen = old / nloc;
        if (old + 1u == (gen + 1u) * nloc) {
            __builtin_amdgcn_fence(__ATOMIC_RELEASE, "agent");
            asm volatile("s_waitcnt vmcnt(0)" ::: "memory");
            const unsigned og = xb_add(&bar[XB_TOP], 1u);
            const unsigned tg = og / nx;
            if (og + 1u == (tg + 1u) * nx) xb_add(&bar[XB_TOPGEN], 1u);
            else XB_SPIN(xb_ld(&bar[XB_TOPGEN]) == tg, bar);
            __builtin_amdgcn_fence(__ATOMIC_ACQUIRE, "agent");
            xb_add(&bar[XB_XGEN(b.x)], 1u);
            asm volatile("s_waitcnt vmcnt(0)" ::: "memory");
        } else {
            XB_SPIN(xb_ld(&bar[XB_XGEN(b.x)]) == gen, bar);
            __builtin_amdgcn_fence(__ATOMIC_ACQUIRE, "agent");
            asm volatile("s_waitcnt vmcnt(0)" ::: "memory");
        }
    }
    __syncthreads();
}

__global__ void __launch_bounds__(512) fwd_megakernel(Params p) {
    extern __shared__ __attribute__((aligned(16))) unsigned char lds_raw[];
    LAS unsigned char* lds = (LAS unsigned char*)lds_raw;
    cg::grid_group grid = cg::this_grid();
    const int tid = threadIdx.x, lane = tid & 63, wave = __builtin_amdgcn_readfirstlane(tid >> 6);
    const int G = gridDim.x, bx = blockIdx.x;
    const int vcu = (G % 8 == 0) ? (bx % 8) * (G / 8) + bx / 8 : bx;
    const int gw = vcu * 8 + wave, NGW = G * 8;
    unsigned char* ws = p.ws;
    const int lo = p.ph_lo, hi = p.ph_hi;
    const bool fuse5 = (G == 256) && (lo <= 4 && 5 < hi);
    volatile LAS unsigned* bst = (volatile LAS unsigned*)(lds + LDS_BYTES - 64);
    if (tid < 2) bst[tid] = 0u;
    __syncthreads();
    const XcdBarrier xbar = xcd_barrier_post((unsigned*)(ws + WS_BAR), bst);
#ifndef P0SEL
#define P0SEL 15
#endif
#ifndef REPMASK
#define REPMASK 0
#endif
#define NREP(k) ((((REPMASK) >> (k)) & 1) ? 2 : 1)
#ifndef P6SEL
#define P6SEL 7
#endif
#ifndef PHMASK
#define PHMASK 0xffff
#endif
#define IN(k) (((PHMASK >> (k)) & 1) && lo <= (k) && (k) < hi)
#define SEAM(k) do { if (IN(k) && IN((k) + 1)) { if ((k) == 0) grid.sync(); else xcd_barrier(xbar); if ((REPMASK >> 15) & 1) xcd_barrier(xbar); } } while (0)
    bf16_t* XN = (bf16_t*)(ws + WS_XN); bf16_t* HB = (bf16_t*)(ws + WS_H);

    if (IN(0)) {
        LAS float* scr = (LAS float*)(lds + wave * 16384);
        constexpr int I_GU = 16 * 176, I_D = 44 * 32, I_INA = 16 * 16, I_INB = 16 * 48, I_UQ = 4 * 24, I_UK = 4 * 16, I_OUT = 16 * 32;
        constexpr int NITEMS = 2 * (I_GU + I_D) + I_INA + I_INB + I_UQ + 2 * I_UK + I_OUT;
        for (int rep = 0; rep < NREP(0); ++rep) if (P0SEL & 1) for (int it = gw; it < NITEMS; it += NGW) {
            int r = it;
            bool done = false;
#pragma unroll
            for (int f = 0; f < 2; ++f) {
                if (done) break;
                const float* wg = p.in[f ? 23 : 2]; const float* wu = p.in[f ? 24 : 3]; const float* wd = p.in[f ? 25 : 4];
                bf16_t* GU = (bf16_t*)(ws + (f ? WS_W2GU : WS_W1GU)); bf16_t* DD = (bf16_t*)(ws + (f ? WS_W2D : WS_W1D));
                if (r < I_GU) { const int kb = r / 176, nb = r - kb * 176, pn = nb >> 3, rb = nb & 7;
                    tr_item(rb < 4 ? wg : wu, FFH, 128 * pn + 32 * (rb & 3), 64 * kb, true, GU, DM, 32 * nb, scr, lane); done = true; break; }
                r -= I_GU;
                if (r < I_D) { const int kb = r / 32, nb = r - kb * 32; tr_item(wd, DM, 32 * nb, 64 * kb, true, DD, FFH, 32 * nb, scr, lane); done = true; break; }
                r -= I_D;
            }
            if (done) continue;
            if (r < I_INA) { const int kb = r / 16, nb = r - kb * 16; tr_item(p.in[6], 1952, 32 * nb, 64 * kb, nb < 13, (bf16_t*)(ws + WS_WINA), DM, 32 * nb, scr, lane); continue; } r -= I_INA;
            if (r < I_INB) { const int kb = r / 48, nb = r - kb * 48; tr_item(p.in[6], 1952, 416 + 32 * nb, 64 * kb, true, (bf16_t*)(ws + WS_WINB), DM, 32 * nb, scr, lane); continue; } r -= I_INB;
            if (r < I_UQ) { const int kb = r / 24, nb = r - kb * 24; tr_item(p.in[8], 768, 32 * nb, 64 * kb, true, (bf16_t*)(ws + WS_WUQ), 256, 32 * nb, scr, lane); continue; } r -= I_UQ;
            if (r < I_UK) { const int kb = r / 16, nb = r - kb * 16; tr_item(p.in[10], 1024, 128 * (nb >> 1) + 32 * (nb & 1), 64 * kb, kb < 2, (bf16_t*)(ws + WS_WUK), 256, 32 * nb, scr, lane); continue; } r -= I_UK;
            if (r < I_UK) { const int kb = r / 16, nb = r - kb * 16; tr_item(p.in[10], 1024, 128 * (nb >> 1) + 64 + 32 * (nb & 1), 64 * kb, kb < 2, (bf16_t*)(ws + WS_WUV), 256, 32 * nb, scr, lane); continue; } r -= I_UK;
            { const int kb = r / 32, nb = r - kb * 32; tr_item(p.in[21], DM, 32 * nb, 64 * kb, true, (bf16_t*)(ws + WS_WOUT), DM, 32 * nb, scr, lane); }
        }
        if (P0SEL & 2) { f32x2_t* tab = (f32x2_t*)(ws + WS_ROPE);
          for (int idx = gw * 64 + lane; idx < SEQ * 16; idx += NGW * 64) { const int s = idx >> 4, i = idx & 15;
              const float inv = exp2f(-(float)i * 0.8304820237218406f); const float ang = (float)s * inv; float sn, cs; sincos_rr(ang, sn, cs); tab[idx] = (f32x2_t){cs, sn}; } }
        __syncthreads();
        if (P0SEL & 4) for (int pb = bx; pb < 256; pb += G) filter_block(p, lds, pb, tid);
        for (int rep = 0; rep < NREP(13); ++rep) if (P0SEL & 8) for (int m = gw; m + NGW < MTOK; m += 2 * NGW) rms_rows2_bf16(p.in[0] + (size_t)m * DM, p.in[0] + (size_t)(m + NGW) * DM, p.in[1], XN + (size_t)m * DM, XN + (size_t)(m + NGW) * DM, lane);
    }
    SEAM(0);
    if (IN(1)) for (int rep = 0; rep < NREP(1); ++rep) { __syncthreads(); pg8::Gemm g{XN, (const bf16_t*)(ws + WS_W1GU), MTOK, 2 * FFH, DM}; pg8::StaticOrder S; S.init(MTOK, 2 * FFH, G, bx);
        pg8::EpiSwiGLU E{HB, FFH}; pg8::gemm_phase<pg8::EpiSwiGLU, pg8::StaticOrder>(lds, g, S, E); }
    SEAM(1);
    if (IN(2)) for (int rep = 0; rep < NREP(2); ++rep) { __syncthreads(); pg8::Gemm g{HB, (const bf16_t*)(ws + WS_W1D), MTOK, DM, FFH}; pg8::StaticOrder S; S.init(MTOK, DM, G, bx);
        pg8::EpiResid E{p.in[0], p.out, DM, 0.5f}; pg8::gemm_phase<pg8::EpiResid, pg8::StaticOrder>(lds, g, S, E); }
    SEAM(2);
    if (IN(3)) for (int rep = 0; rep < NREP(3); ++rep) { for (int m = gw; m + NGW < MTOK; m += 2 * NGW) rms_rows2_bf16(p.out + (size_t)m * DM, p.out + (size_t)(m + NGW) * DM, p.in[5], XN + (size_t)m * DM, XN + (size_t)(m + NGW) * DM, lane); }
    SEAM(3);
    if (IN(4)) for (int rep = 0; rep < NREP(4); ++rep) { __syncthreads();
        if (fuse5) { pg8::Gemm g{XN, (const bf16_t*)(ws + WS_WINA), MTOK, 512, DM}; pg8::StaticOrder S; S.init(MTOK, 512, G, bx);
          pg8::EpiUA E{(bf16_t*)(ws + WS_CQN), (bf16_t*)(ws + WS_CKVN), (bf16_t*)(ws + WS_KPE), p.in[7], p.in[9], (const f32x2_t*)(ws + WS_ROPE)};
          pg8::gemm_phase<pg8::EpiUA, pg8::StaticOrder>(lds, g, S, E); }
        else { pg8::Gemm g{XN, (const bf16_t*)(ws + WS_WINA), MTOK, 512, DM}; pg8::StaticOrder S; S.init(MTOK, 512, G, bx);
          pg8::EpiF32 E{(float*)(ws + WS_UA), 512}; pg8::gemm_phase<pg8::EpiF32, pg8::StaticOrder>(lds, g, S, E); }
        { pg8::Gemm g{(const bf16_t*)(ws + WS_WINB), XN, 1536, MTOK, DM}; pg8::StaticOrder S; S.init(1536, MTOK, G, bx);
          pg8::EpiBf16P E{(bf16_t*)(ws + WS_UT), (size_t)MTOK}; pg8::gemm_phase<pg8::EpiBf16P, pg8::StaticOrder>(lds, g, S, E); } }
    SEAM(4);
    if (IN(5) && !fuse5) for (int rep = 0; rep < NREP(5); ++rep) {
        const float* UA = (const float*)(ws + WS_UA); bf16_t* CQN = (bf16_t*)(ws + WS_CQN); bf16_t* CKVN = (bf16_t*)(ws + WS_CKVN); bf16_t* KPE = (bf16_t*)(ws + WS_KPE);
        const f32x2_t* tab = (const f32x2_t*)(ws + WS_ROPE);
        const f32x4 gq = ((const f32x4*)p.in[7])[lane]; const f32x4 gk = lane < 32 ? ((const f32x4*)p.in[9])[lane] : (f32x4){0.f, 0.f, 0.f, 0.f};
        for (int row = gw; row < MTOK; row += NGW) {
            const f32x4* ur = (const f32x4*)(UA + (size_t)row * 512);
            const f32x4 a = ur[lane], bq = ur[64 + lane];
            const float rq = 1.0f / sqrtf(wave_sum((a.x * a.x + a.y * a.y) + (a.z * a.z + a.w * a.w)) * (1.0f / 256.0f) + EPSN);
            u32x2 w; w.x = pk2(a.x * rq * gq.x, a.y * rq * gq.y); w.y = pk2(a.z * rq * gq.z, a.w * rq * gq.w);
            *((u32x2*)(CQN + (size_t)row * 256) + lane) = w;
            const float skv = lane < 32 ? (bq.x * bq.x + bq.y * bq.y) + (bq.z * bq.z + bq.w * bq.w) : 0.f;
            const float rkv = 1.0f / sqrtf(wave_sum(skv) * (1.0f / 128.0f) + EPSN);
            u32x2 wk = (u32x2){0u, 0u};
            if (lane < 32) { wk.x = pk2(bq.x * rkv * gk.x, bq.y * rkv * gk.y); wk.y = pk2(bq.z * rkv * gk.z, bq.w * rkv * gk.w); }
            *((u32x2*)(CKVN + (size_t)row * 256) + lane) = wk;
            f32x4 pr; pr.x = __shfl_xor(bq.x, 4); pr.y = __shfl_xor(bq.y, 4); pr.z = __shfl_xor(bq.z, 4); pr.w = __shfl_xor(bq.w, 4);
            if (lane >= 32 && lane < 40) { const int pos = row & 4095; const bool first = lane < 36; const int i0 = 4 * ((lane - 32) & 3);
                float ov[4];
#pragma unroll
                for (int e = 0; e < 4; ++e) { const f32x2_t cs = tab[pos * 16 + i0 + e]; const float x1 = first ? bq[e] : pr[e], x2 = first ? pr[e] : bq[e]; ov[e] = first ? x1 * cs.x - x2 * cs.y : x1 * cs.y + x2 * cs.x; }
                u32x2 wo; wo.x = pk2(ov[0], ov[1]); wo.y = pk2(ov[2], ov[3]);
                *(u32x2*)(KPE + (size_t)row * 32 + 4 * (lane - 32)) = wo; }
        }
    }
    if (!fuse5) SEAM(5);
    if (IN(6)) for (int rep = 0; rep < NREP(6); ++rep) { __syncthreads();
        if (P6SEL & 1) { pg8::Gemm g{(const bf16_t*)(ws + WS_CQN), (const bf16_t*)(ws + WS_WUQ), MTOK, 768, 256}; pg8::StaticOrder S; S.init(MTOK, 768, G, bx);
          pg8::EpiF32 E{(float*)(ws + WS_Q), 768}; pg8::gemm_phase<pg8::EpiF32, pg8::StaticOrder>(lds, g, S, E); }
        if (P6SEL & 2) { pg8::Gemm g{(const bf16_t*)(ws + WS_CKVN), (const bf16_t*)(ws + WS_WUK), MTOK, 512, 256}; pg8::StaticOrder S; S.init(MTOK, 512, G, bx);
          pg8::EpiBf16P E{(bf16_t*)(ws + WS_KN), (size_t)512}; pg8::gemm_phase<pg8::EpiBf16P, pg8::StaticOrder>(lds, g, S, E); }
        if (P6SEL & 4) { pg8::Gemm g{(const bf16_t*)(ws + WS_WUV), (const bf16_t*)(ws + WS_CKVN), 512, MTOK, 256}; pg8::StaticOrder S; S.init(512, MTOK, G, bx);
          pg8::EpiBf16P E{(bf16_t*)(ws + WS_VT), (size_t)MTOK}; pg8::gemm_phase<pg8::EpiBf16P, pg8::StaticOrder>(lds, g, S, E); } }
    SEAM(6);
    if (IN(7)) { __syncthreads();
        for (int rep = 0; rep < NREP(7); ++rep) for (int u = vcu; u < 1024; u += G) attn_unit(p, lds, u, tid, lane, wave);
        __syncthreads();
        for (int rep = 0; rep < NREP(14); ++rep) for (int c = bx; c < 512; c += G) hyena_channel(p, lds, c, tid, lane, wave);
    }
    SEAM(7);
    if (IN(8)) for (int rep = 0; rep < NREP(8); ++rep) {
        const bf16_t* HYT = (const bf16_t*)(ws + WS_HYT); bf16_t* MIXN = (bf16_t*)(ws + WS_MIXN); const float* hg = p.in[20] + 512;
        for (int it = gw; it < 8 * (MTOK / 64); it += NGW) { const int grp = it & 7, row = (it >> 3) * 64 + lane;
            float v[64]; float ss = 0.f;
#pragma unroll
            for (int cc = 0; cc < 64; ++cc) { v[cc] = bf2f(HYT[(size_t)(64 * grp + cc) * MTOK + row]); ss += v[cc] * v[cc]; }
            const float rstd = 1.0f / sqrtf(ss * (1.0f / 64.0f) + EPSN);
            bf16_t* dst = MIXN + (size_t)row * 1024 + 512 + 64 * grp;
#pragma unroll
            for (int k = 0; k < 8; ++k) { const float* gp = hg + 64 * grp + 8 * k;
                u32x4 w; w.x = pk2(v[8 * k] * rstd * gp[0], v[8 * k + 1] * rstd * gp[1]); w.y = pk2(v[8 * k + 2] * rstd * gp[2], v[8 * k + 3] * rstd * gp[3]);
                w.z = pk2(v[8 * k + 4] * rstd * gp[4], v[8 * k + 5] * rstd * gp[5]); w.w = pk2(v[8 * k + 6] * rstd * gp[6], v[8 * k + 7] * rstd * gp[7]);
                *(u32x4*)(dst + 8 * k) = w; } }
    }
    SEAM(8);
    if (IN(9)) { __syncthreads(); pg8::Gemm g{(const bf16_t*)(ws + WS_MIXN), (const bf16_t*)(ws + WS_WOUT), MTOK, DM, DM}; pg8::StaticOrder S; S.init(MTOK, DM, G, bx);
        pg8::EpiResid E{p.out, p.out, DM, 1.0f}; pg8::gemm_phase<pg8::EpiResid, pg8::StaticOrder>(lds, g, S, E); }
    SEAM(9);
    if (IN(10)) for (int rep = 0; rep < NREP(10); ++rep) { for (int m = gw; m + NGW < MTOK; m += 2 * NGW) rms_rows2_bf16(p.out + (size_t)m * DM, p.out + (size_t)(m + NGW) * DM, p.in[22], XN + (size_t)m * DM, XN + (size_t)(m + NGW) * DM, lane); }
    SEAM(10);
    if (IN(11)) for (int rep = 0; rep < NREP(11); ++rep) { __syncthreads(); pg8::Gemm g{XN, (const bf16_t*)(ws + WS_W2GU), MTOK, 2 * FFH, DM}; pg8::StaticOrder S; S.init(MTOK, 2 * FFH, G, bx);
        pg8::EpiSwiGLU E{HB, FFH}; pg8::gemm_phase<pg8::EpiSwiGLU, pg8::StaticOrder>(lds, g, S, E); }
    SEAM(11);
    if (IN(12)) { __syncthreads(); pg8::Gemm g{HB, (const bf16_t*)(ws + WS_W2D), MTOK, DM, FFH}; pg8::StaticOrder S; S.init(MTOK, DM, G, bx);
        pg8::EpiResid E{p.out, p.out, DM, 0.5f}; pg8::gemm_phase<pg8::EpiResid, pg8::StaticOrder>(lds, g, S, E); }
    SEAM(12);
    if (IN(13)) {
        const f32x4* gr = (const f32x4*)p.in[26] + lane;
        for (int m = gw; m + NGW < MTOK; m += 2 * NGW) { f32x4* xr = (f32x4*)(p.out + (size_t)m * DM) + lane; f32x4* yr = (f32x4*)(p.out + (size_t)(m + NGW) * DM) + lane; f32x4 v[4], w[4]; float s = 0.f, t = 0.f;
#pragma unroll
            for (int j = 0; j < 4; ++j) { v[j] = xr[64 * j]; w[j] = yr[64 * j]; }
#pragma unroll
            for (int j = 0; j < 4; ++j) { s += (v[j].x * v[j].x + v[j].y * v[j].y) + (v[j].z * v[j].z + v[j].w * v[j].w); t += (w[j].x * w[j].x + w[j].y * w[j].y) + (w[j].z * w[j].z + w[j].w * w[j].w); }
            const float rs = 1.0f / sqrtf(wave_sum(s) * (1.0f / DM) + EPSN), rt = 1.0f / sqrtf(wave_sum(t) * (1.0f / DM) + EPSN);
#pragma unroll
            for (int j = 0; j < 4; ++j) { const f32x4 gv = gr[64 * j]; xr[64 * j] = v[j] * rs * gv; yr[64 * j] = w[j] * rt * gv; } }
    }
#undef IN
#undef SEAM
}

#ifndef ONE_LAUNCH
#define ONE_LAUNCH 1
#endif
extern "C" void kernel_launch(void* const* d_in, const int* in_sizes, int n_in, void* d_out, int out_size, void* d_ws, size_t ws_size, hipStream_t stream) {
    static int grid = 0;
    if (grid == 0) {
        if (n_in != 27 || ws_size < WS_END) { fprintf(stderr, "kernel_launch: unexpected n_in %d or ws_size %zu\n", n_in, ws_size); grid = -1; return; }
        int dev = 0, cus = 0, per_cu = 0;
        (void)hipGetDevice(&dev); (void)hipDeviceGetAttribute(&cus, hipDeviceAttributeMultiprocessorCount, dev);
        if (hipFuncSetAttribute((const void*)fwd_megakernel, hipFuncAttributeMaxDynamicSharedMemorySize, LDS_BYTES) != hipSuccess) { fprintf(stderr, "kernel_launch: hipFuncSetAttribute failed\n"); grid = -1; return; }
        if (hipOccupancyMaxActiveBlocksPerMultiprocessor(&per_cu, (const void*)fwd_megakernel, 512, LDS_BYTES) != hipSuccess || per_cu < 1) { fprintf(stderr, "kernel_launch: occupancy query says %d\n", per_cu); (void)hipGetLastError(); grid = -1; return; }
        grid = cus;
    }
    if (grid < 0) return;
    (void)hipMemsetAsync((char*)d_ws + WS_CTL, 0, CTL_ZERO, stream);
    Params p{};
    for (int i = 0; i < 27; ++i) p.in[i] = (const float*)d_in[i];
    p.out = (float*)d_out; p.ws = (unsigned char*)d_ws;
#if ONE_LAUNCH
    p.ph_lo = 0; p.ph_hi = NPHASE;
    void* args[] = {&p};
    hipError_t e = hipLaunchCooperativeKernel((const void*)fwd_megakernel, dim3(grid), dim3(512), args, LDS_BYTES, stream);
    if (e != hipSuccess) fprintf(stderr, "cooperative launch failed: %s (grid %d)\n", hipGetErrorString(e), grid);
#else
    for (int k = 0; k < NPHASE; ++k) { p.ph_lo = k; p.ph_hi = k + 1; hipLaunchKernelGGL(fwd_megakernel, dim3(grid), dim3(512), LDS_BYTES, stream, p); }
#endif
}
```

```cpp
#include <hip/hip_runtime.h>
#include <hip/hip_cooperative_groups.h>
#include <cstdio>
namespace cg = cooperative_groups;
namespace pg8 {
#define PG8_LAS __attribute__((address_space(3)))
typedef unsigned short bf16_t;
typedef short bf16x8 __attribute__((ext_vector_type(8)));
typedef float f32x4 __attribute__((ext_vector_type(4)));
typedef unsigned u32x4 __attribute__((ext_vector_type(4)));
constexpr int BM = 256, BK = 64, HALF = 128, HTB = HALF * BK * 2  , STAGE_BYTES = 8 * HTB, NXCD = 8, WGM = 8;

__host__ __device__ __forceinline__ int lds_byte(int r, int c) { const int st = (r >> 4) * 2 + (c >> 5), rr = r & 15, cc = c & 31, ob = rr * 64 + cc * 2; return st * 1024 + (ob ^ (((ob >> 9) & 1) << 5)); }
__host__ __device__ __forceinline__ void stage_rc(int b, int& R, int& C) { const int st = b / 1024, sb = b % 1024, swz = sb ^ (((sb >> 9) & 1) << 5); R = (st >> 1) * 16 + swz / 64; C = (st & 1) * 32 + (swz % 64) / 2; }
__host__ __device__ __forceinline__ int perm32(int rho) { const int n = rho >> 4, i = rho & 15; return 8 * (i >> 2) + 4 * n + (i & 3); }

struct Unit { int pm, pn; };
struct Gemm { const bf16_t* A; const bf16_t* Bt; int M, N, K; int a_tiled = 0; };

struct StaticOrder {
    int nM, nN, nwg, G, c;
    __host__ __device__ void init(int M, int N, int G_, int c_) { nM = M / BM; nN = N / BM; nwg = nM * nN; G = G_; c = c_; }
    __host__ __device__ bool next(int i, Unit& u) const {
        const long L = (long)i * G + c; if (L >= nwg) return false;
        int wgid = (int)L; { const int q = nwg / NXCD, r = nwg % NXCD, xcd = wgid % NXCD, off = wgid / NXCD; wgid = (xcd < r ? xcd * (q + 1) : r * (q + 1) + (xcd - r) * q) + off; }
        const int nig = WGM * nN, gid = wgid / nig, fm = gid * WGM, gsz = (nM - fm) < WGM ? (nM - fm) : WGM;
        u.pm = fm + ((wgid % nig) % gsz); u.pn = (wgid % nig) / gsz; return true;
    }
    __device__ __forceinline__ void a_ready(const Unit&) const {}
    __device__ __forceinline__ void done(const Unit&) const {}
};
typedef unsigned u32x2 __attribute__((ext_vector_type(2)));
typedef __bf16 bf16x2_t __attribute__((ext_vector_type(2)));
typedef float f32x2_t __attribute__((ext_vector_type(2)));
__device__ __forceinline__ unsigned pk2(float lo, float hi) { f32x2_t v = {lo, hi}; bf16x2_t b = __builtin_convertvector(v, bf16x2_t); return __builtin_bit_cast(unsigned, b); }
__device__ __forceinline__ float silu_mul(float g, float u) { return g * __builtin_amdgcn_rcpf(1.0f + __expf(-g)) * u; }
struct EpiSwiGLU {
    static constexpr bool PERM = true, AFTER_DRAIN = false;
    bf16_t* H; int ldh;
    __device__ __forceinline__ void operator()(const f32x4 (&acc)[2][2][4][2], const Unit& u, int wr, int wc, int fr, int fq) const {
        const int row0 = u.pm * BM + wr * 64 + fr, col0 = u.pn * HALF + wc * 32 + 8 * fq;
#pragma unroll
        for (int ai = 0; ai < 2; ++ai)
#pragma unroll
            for (int m = 0; m < 4; ++m) {
                bf16_t* rowp = H + (size_t)u.pm * BM * ldh + (size_t)(col0 >> 6) * (BM * BK) + (size_t)(wr * 64 + fr + ai * HALF + m * 16) * BK + (col0 & 63);
                const f32x4 g0 = acc[ai][0][m][0], g1 = acc[ai][0][m][1], u0 = acc[ai][1][m][0], u1 = acc[ai][1][m][1];
                u32x4 w; w.x = pk2(silu_mul(g0[0], u0[0]), silu_mul(g0[1], u0[1])); w.y = pk2(silu_mul(g0[2], u0[2]), silu_mul(g0[3], u0[3]));
                w.z = pk2(silu_mul(g1[0], u1[0]), silu_mul(g1[1], u1[1])); w.w = pk2(silu_mul(g1[2], u1[2]), silu_mul(g1[3], u1[3]));
                *(u32x4*)rowp = w; }
    }
};
struct EpiResid {
    static constexpr bool PERM = false, AFTER_DRAIN = false;
    const float* base; float* out; int ldc; float alpha;
    __device__ __forceinline__ void operator()(const f32x4 (&acc)[2][2][4][2], const Unit& u, int wr, int wc, int fr, int fq) const {
        const int row0 = u.pm * BM + wr * 64 + fr, col0 = u.pn * BM + wc * 32 + 4 * fq;
#pragma unroll
        for (int ai = 0; ai < 2; ++ai)
#pragma unroll
            for (int m = 0; m < 4; ++m) { const size_t off = (size_t)(row0 + ai * HALF + m * 16) * ldc + col0;
#pragma unroll
                for (int bj = 0; bj < 2; ++bj)
#pragma unroll
                    for (int n = 0; n < 2; ++n) { const size_t o = off + bj * HALF + n * 16; const f32x4 b = *(const f32x4*)(base + o); *(f32x4*)(out + o) = b + alpha * acc[ai][bj][m][n]; }
                asm volatile("" ::: "memory"); }
    }
};
struct EpiUA {
    static constexpr bool PERM = false, AFTER_DRAIN = true;
    bf16_t* CQN; bf16_t* CKVN; bf16_t* KPE; const float* qg; const float* kvg; const f32x2_t* tab;
    __device__ __forceinline__ void fused(f32x4 (&acc)[2][2][4][2], const Unit& u, int wr, int wc, int fr, int fq, PG8_LAS unsigned char* lds, int wid, int lane) const {
        PG8_LAS float* P = (PG8_LAS float*)lds;
        const bool isq = (u.pn == 0);
#pragma unroll
        for (int ai = 0; ai < 2; ++ai)
#pragma unroll
            for (int m = 0; m < 4; ++m) { float sq = 0.f;
#pragma unroll
                for (int bj = 0; bj < 2; ++bj) if (isq || bj == 0)
#pragma unroll
                    for (int n = 0; n < 2; ++n) { const f32x4 v = acc[ai][bj][m][n]; sq += (v[0] * v[0] + v[1] * v[1]) + (v[2] * v[2] + v[3] * v[3]); }
                sq += __shfl_xor(sq, 16); sq += __shfl_xor(sq, 32);
                if (fq == 0) P[(ai * HALF + wr * 64 + m * 16 + fr) * 4 + wc] = sq; }
        __syncthreads();
        const float invn = isq ? (1.0f / 256.0f) : (1.0f / 128.0f);
        const int row0 = u.pm * BM + wr * 64 + fr;
#pragma unroll
        for (int ai = 0; ai < 2; ++ai)
#pragma unroll
            for (int m = 0; m < 4; ++m) { const int lr = ai * HALF + wr * 64 + m * 16 + fr, row = u.pm * BM + lr;
                const f32x4 pp = *(const PG8_LAS f32x4*)(P + lr * 4);
                const float rstd = 1.0f / sqrtf(((pp[0] + pp[1]) + (pp[2] + pp[3])) * invn + 1e-6f);
#pragma unroll
                for (int bj = 0; bj < 2; ++bj)
#pragma unroll
                    for (int n = 0; n < 2; ++n) { const int col = bj * HALF + wc * 32 + n * 16 + 4 * fq; const f32x4 v = acc[ai][bj][m][n];
                        u32x2 w = (u32x2){0u, 0u};
                        if (isq) { const f32x4 g = *(const f32x4*)(qg + col); w.x = pk2(v[0] * rstd * g[0], v[1] * rstd * g[1]); w.y = pk2(v[2] * rstd * g[2], v[3] * rstd * g[3]); *(u32x2*)(CQN + (size_t)row * 256 + col) = w; }
                        else { if (bj == 0) { const f32x4 g = *(const f32x4*)(kvg + col); w.x = pk2(v[0] * rstd * g[0], v[1] * rstd * g[1]); w.y = pk2(v[2] * rstd * g[2], v[3] * rstd * g[3]); }
                               *(u32x2*)(CKVN + (size_t)row * 256 + col) = w; } }
                if (!isq && wc == 0) { const int pos = row & 4095; const f32x4 x1 = acc[ai][1][m][0], x2 = acc[ai][1][m][1]; float y1[4], y2[4];
#pragma unroll
                    for (int e = 0; e < 4; ++e) { const f32x2_t cs = tab[pos * 16 + 4 * fq + e]; y1[e] = x1[e] * cs.x - x2[e] * cs.y; y2[e] = x1[e] * cs.y + x2[e] * cs.x; }
                    u32x2 a; a.x = pk2(y1[0], y1[1]); a.y = pk2(y1[2], y1[3]); u32x2 b; b.x = pk2(y2[0], y2[1]); b.y = pk2(y2[2], y2[3]);
                    *(u32x2*)(KPE + (size_t)row * 32 + 4 * fq) = a; *(u32x2*)(KPE + (size_t)row * 32 + 16 + 4 * fq) = b; }
                asm volatile("" ::: "memory"); }
        __syncthreads();
    }
};
struct EpiF32 {
    static constexpr bool PERM = false, AFTER_DRAIN = false;
    float* C; int ldc;
    __device__ __forceinline__ void operator()(const f32x4 (&acc)[2][2][4][2], const Unit& u, int wr, int wc, int fr, int fq) const {
        const int row0 = u.pm * BM + wr * 64 + fr, col0 = u.pn * BM + wc * 32 + 4 * fq;
#pragma unroll
        for (int ai = 0; ai < 2; ++ai)
#pragma unroll
            for (int m = 0; m < 4; ++m) { float* rowp = C + (size_t)(row0 + ai * HALF + m * 16) * ldc + col0;
#pragma unroll
                for (int bj = 0; bj < 2; ++bj)
#pragma unroll
                    for (int n = 0; n < 2; ++n) *(f32x4*)(rowp + bj * HALF + n * 16) = acc[ai][bj][m][n]; }
    }
};
struct EpiBf16P {
    static constexpr bool PERM = true, AFTER_DRAIN = false;
    bf16_t* O; size_t ldc;
    __device__ __forceinline__ void operator()(const f32x4 (&acc)[2][2][4][2], const Unit& u, int wr, int wc, int fr, int fq) const {
        const int row0 = u.pm * BM + wr * 64 + fr, col0 = u.pn * BM + wc * 32 + 8 * fq;
#pragma unroll
        for (int ai = 0; ai < 2; ++ai)
#pragma unroll
            for (int m = 0; m < 4; ++m) { bf16_t* rowp = O + (size_t)(row0 + ai * HALF + m * 16) * ldc + col0;
#pragma unroll
                for (int bj = 0; bj < 2; ++bj) { const f32x4 v0 = acc[ai][bj][m][0], v1 = acc[ai][bj][m][1];
                    u32x4 w; w.x = pk2(v0[0], v0[1]); w.y = pk2(v0[2], v0[3]); w.z = pk2(v1[0], v1[1]); w.w = pk2(v1[2], v1[3]);
                    *(u32x4*)(rowp + bj * HALF) = w; } }
    }
};
struct EpiQ {
    static constexpr bool PERM = false, AFTER_DRAIN = false;
    bf16_t* Q; const f32x2_t* tab; float scale;
    __device__ __forceinline__ void operator()(const f32x4 (&acc)[2][2][4][2], const Unit& u, int wr, int wc, int fr, int fq) const {
        const int row0 = u.pm * BM + wr * 64 + fr, colb = u.pn * BM + wc * 32;
#pragma unroll
        for (int ai = 0; ai < 2; ++ai)
#pragma unroll
            for (int m = 0; m < 4; ++m) { const int row = row0 + ai * HALF + m * 16, pos = row & 4095;
#pragma unroll
                for (int bj = 0; bj < 2; ++bj) { const int cgp = colb + bj * HALF; const bool pe = ((cgp >> 5) % 3) == 2;
                    f32x4 a = acc[ai][bj][m][0], b = acc[ai][bj][m][1];
                    if (pe) {
#pragma unroll
                        for (int e = 0; e < 4; ++e) { const f32x2_t cs = tab[pos * 16 + 4 * fq + e]; const float x1 = a[e], x2 = b[e]; a[e] = x1 * cs.x - x2 * cs.y; b[e] = x1 * cs.y + x2 * cs.x; } }
                    a = a * scale; b = b * scale;
                    bf16_t* qp = Q + (size_t)row * 768 + cgp + 4 * fq;
                    u32x2 w0; w0.x = pk2(a[0], a[1]); w0.y = pk2(a[2], a[3]); *(u32x2*)qp = w0;
                    u32x2 w1; w1.x = pk2(b[0], b[1]); w1.y = pk2(b[2], b[3]); *(u32x2*)(qp + 16) = w1;
                    asm volatile("" ::: "memory"); } }
    }
};
template <class Epi, class Sched>
__device__ __forceinline__ void gemm_phase(PG8_LAS unsigned char* lds, const Gemm g, const Sched& S, const Epi& E) {
    const int tid = threadIdx.x, wid = __builtin_amdgcn_readfirstlane(tid >> 6), lane = tid & 63, wr = wid >> 2, wc = wid & 3, fr = lane & 15, fq = lane >> 4;
    const int K = g.K, nt = K / BK;
    unsigned voffA[2], voffB[2];
#pragma unroll
    for (int i = 0; i < 2; ++i) { int R, C; stage_rc(tid * 16 + i * 8192, R, C); const int Rb = Epi::PERM ? ((R & ~31) + perm32(R & 31)) : R;
        voffA[i] = (unsigned)(R * (g.a_tiled ? BK : K) + C) * 2u; voffB[i] = (unsigned)(Rb * K + C) * 2u; }
    const size_t kstepB = (size_t)(BK * 2), kstepA = g.a_tiled ? (size_t)BM * BK * 2 : kstepB;
    const size_t hstepB = (size_t)HALF * K * 2, hstepA = g.a_tiled ? (size_t)HALF * BK * 2 : hstepB;
    const size_t tstepB = 2 * hstepB, tstepA = tstepB;
    const unsigned ldsw = (unsigned)wid * 1024u;
    const int aoff = lds_byte(wr * 64 + fr, fq * 8), boff = lds_byte(wc * 32 + fr, fq * 8);
#define PG8_SA(b, h) (((b) * 2 + (h)) * HTB)
#define PG8_SB(b, h) ((4 + (b) * 2 + (h)) * HTB)
#define PG8_STAGE(bufoff, gbase, voff) do { _Pragma("unroll") for (int _i = 0; _i < 2; ++_i) \
        __builtin_amdgcn_global_load_lds((const unsigned*)((const char*)(gbase) + (voff)[_i]), (PG8_LAS unsigned*)(lds + (bufoff) + ldsw + _i * 8192), 16, 0, 0); } while (0)
#define PG8_LDA(dst, b, h) do { _Pragma("unroll") for (int m = 0; m < 4; ++m) _Pragma("unroll") for (int k = 0; k < 2; ++k) dst[m][k] = *(const PG8_LAS bf16x8*)(lds + PG8_SA(b, h) + aoff + m * 2048 + k * 1024); } while (0)
#define PG8_LDB(dst, b, h) do { _Pragma("unroll") for (int n = 0; n < 2; ++n) _Pragma("unroll") for (int k = 0; k < 2; ++k) dst[n][k] = *(const PG8_LAS bf16x8*)(lds + PG8_SB(b, h) + boff + n * 2048 + k * 1024); } while (0)
#define PG8_MMA(ai, bj, At, Bt) do { __builtin_amdgcn_s_setprio(1); _Pragma("unroll") for (int m = 0; m < 4; ++m) _Pragma("unroll") for (int n = 0; n < 2; ++n) _Pragma("unroll") for (int k = 0; k < 2; ++k) \
        acc[ai][bj][m][n] = __builtin_amdgcn_mfma_f32_16x16x32_bf16(Bt[n][k], At[m][k], acc[ai][bj][m][n], 0, 0, 0); __builtin_amdgcn_s_setprio(0); } while (0)
#define PG8_WAIT_V(n) asm volatile("s_waitcnt vmcnt(" #n ")" ::: "memory")
#define PG8_WAIT_L(n) asm volatile("s_waitcnt lgkmcnt(" #n ")" ::: "memory")
#define PG8_BAR __builtin_amdgcn_s_barrier()
#define PG8_SCHED __builtin_amdgcn_sched_barrier(0)
    Unit cur, nxt; int ui = 0;
    if (!S.next(0, cur)) return;
    f32x4 acc[2][2][4][2];
#pragma unroll
    for (int a = 0; a < 2; ++a)
#pragma unroll
        for (int b = 0; b < 2; ++b)
#pragma unroll
            for (int m = 0; m < 4; ++m)
#pragma unroll
                for (int n = 0; n < 2; ++n) acc[a][b][m][n] = (f32x4){0.f, 0.f, 0.f, 0.f};
    bf16x8 At[4][2], B0[2][2], B1[2][2];
    const char* cA = (const char*)g.A + (size_t)cur.pm * tstepA; const char* cB = (const char*)g.Bt + (size_t)cur.pn * tstepB;
    S.a_ready(cur);
    PG8_STAGE(PG8_SB(0, 0), cB, voffB); PG8_STAGE(PG8_SA(0, 0), cA, voffA); PG8_STAGE(PG8_SB(0, 1), cB + hstepB, voffB); PG8_STAGE(PG8_SA(0, 1), cA + hstepA, voffA);
    if (wr == 1) PG8_BAR;
    PG8_WAIT_V(4); PG8_BAR;
    PG8_STAGE(PG8_SB(1, 0), cB + kstepB, voffB); PG8_STAGE(PG8_SA(1, 0), cA + kstepA, voffA); PG8_STAGE(PG8_SB(1, 1), cB + hstepB + kstepB, voffB);
    PG8_WAIT_V(6); PG8_BAR;
    for (;;) {
        const bool has_next = S.next(ui + 1, nxt);
        const char* nA = has_next ? (const char*)g.A + (size_t)nxt.pm * tstepA : cA; const char* nB = has_next ? (const char*)g.Bt + (size_t)nxt.pn * tstepB : cB;
        for (int t = 0; t < nt; t += 2) {
            const bool last = (t == nt - 2);
            const char* a1 = cA + (size_t)(t + 1) * kstepA;
            const char* a2 = last ? nA : cA + (size_t)(t + 2) * kstepA; const char* b2 = last ? nB : cB + (size_t)(t + 2) * kstepB;
            const char* a3 = a2 + kstepA; const char* b3 = b2 + kstepB;
            if (last && has_next) S.a_ready(nxt);
            PG8_LDB(B0, 0, 0); PG8_SCHED; PG8_LDA(At, 0, 0); PG8_STAGE(PG8_SA(1, 1), a1 + hstepA, voffA);
            PG8_WAIT_L(8); PG8_BAR; PG8_WAIT_L(0); PG8_MMA(0, 0, At, B0); PG8_BAR; PG8_SCHED;
            PG8_LDB(B1, 0, 1); PG8_STAGE(PG8_SB(0, 0), b2, voffB);
            PG8_BAR; PG8_WAIT_L(0); PG8_MMA(0, 1, At, B1); PG8_BAR;
            PG8_LDA(At, 0, 1); PG8_STAGE(PG8_SA(0, 0), a2, voffA);
            PG8_BAR; PG8_WAIT_L(0); PG8_MMA(1, 0, At, B0); PG8_BAR; PG8_SCHED;
            PG8_STAGE(PG8_SB(0, 1), b2 + hstepB, voffB);
            PG8_WAIT_V(6); PG8_BAR; PG8_MMA(1, 1, At, B1); PG8_BAR;
            PG8_LDB(B0, 1, 0); PG8_SCHED; PG8_LDA(At, 1, 0); PG8_STAGE(PG8_SA(0, 1), a2 + hstepA, voffA);
            PG8_WAIT_L(8); PG8_BAR; PG8_WAIT_L(0); PG8_MMA(0, 0, At, B0); PG8_BAR; PG8_SCHED;
            PG8_LDB(B1, 1, 1); PG8_STAGE(PG8_SB(1, 0), b3, voffB);
            PG8_BAR; PG8_WAIT_L(0); PG8_MMA(0, 1, At, B1); PG8_BAR;
            PG8_LDA(At, 1, 1); PG8_STAGE(PG8_SA(1, 0), a3, voffA);
            PG8_BAR; PG8_WAIT_L(0); PG8_MMA(1, 0, At, B0); PG8_BAR; PG8_SCHED;
            PG8_STAGE(PG8_SB(1, 1), b3 + hstepB, voffB);
            PG8_WAIT_V(6); PG8_BAR; PG8_MMA(1, 1, At, B1); PG8_BAR;
        }
        if constexpr (!Epi::AFTER_DRAIN) { E(acc, cur, wr, wc, fr, fq); S.done(cur); }
        if (!has_next) break;
#pragma unroll
        for (int a = 0; a < 2; ++a)
#pragma unroll
            for (int b = 0; b < 2; ++b)
#pragma unroll
                for (int m = 0; m < 4; ++m)
#pragma unroll
                    for (int n = 0; n < 2; ++n) acc[a][b][m][n] = (f32x4){0.f, 0.f, 0.f, 0.f};
        cur = nxt; cA = nA; cB = nB; ++ui;
    }
    PG8_WAIT_V(0);
    if (wr == 0) PG8_BAR;
    PG8_BAR;
    if constexpr (Epi::AFTER_DRAIN) { E.fused(acc, cur, wr, wc, fr, fq, lds, wid, lane); S.done(cur); }
#undef PG8_SA
#undef PG8_SB
#undef PG8_STAGE
#undef PG8_LDA
#undef PG8_LDB
#undef PG8_MMA
#undef PG8_WAIT_V
#undef PG8_WAIT_L
#undef PG8_BAR
#undef PG8_SCHED
}
}

#define LAS __attribute__((address_space(3)))
using pg8::bf16_t; using pg8::bf16x8; using pg8::f32x4; using pg8::u32x4; using pg8::u32x2; using pg8::f32x2_t; using pg8::pk2;
typedef float f32x16 __attribute__((ext_vector_type(16)));
constexpr int MTOK = 32768, DM = 1024, FFH = 2816, SEQ = 4096, NB = 8;
constexpr float EPSN = 1e-6f;
constexpr size_t MiB = 1u << 20;
constexpr size_t WS_CTL = 0, WS_BAR = 16384, CTL_ZERO = 32768;
constexpr size_t WS_W1GU = 2 * MiB, WS_W1D = 13 * MiB, WS_W2GU = 19 * MiB, WS_W2D = 30 * MiB;
constexpr size_t WS_WINA = 36 * MiB, WS_WINB = 37 * MiB, WS_WUQ = 40 * MiB, WS_WUK = 41 * MiB, WS_WUV = 41 * MiB + 512 * 1024, WS_WOUT = 42 * MiB;
constexpr size_t WS_ROPE = 44 * MiB, WS_FILT = 46 * MiB, WS_XN = 80 * MiB, WS_H = 144 * MiB;
constexpr size_t WS_UA = 144 * MiB, WS_UT = 208 * MiB, WS_KPE = 304 * MiB;
constexpr size_t WS_CQN = 320 * MiB, WS_CKVN = 336 * MiB, WS_Q = 352 * MiB  , WS_KN = 448 * MiB, WS_VT = 480 * MiB, WS_HYT = WS_UA  , WS_END = 512 * MiB;
constexpr size_t WS_MIXN = WS_XN;
constexpr int LDS_BYTES = 147456;
constexpr int NPHASE = 14;

__device__ __forceinline__ float wave_sum(float v) {
#pragma unroll
    for (int o = 1; o < 64; o <<= 1) v += __shfl_xor(v, o);
    return v;
}
__device__ __forceinline__ float bf2f(unsigned short b) { return __uint_as_float(((unsigned)b) << 16); }
__device__ __forceinline__ f32x16 mfma32(bf16x8 a, bf16x8 b, f32x16 c) { return __builtin_amdgcn_mfma_f32_32x32x16_bf16(a, b, c, 0, 0, 0); }
__device__ __forceinline__ void sincos_rr(float x, float& sn, float& cs) {
    const float n = rintf(x * 0.15915494309189535f);
    float r = fmaf(-n, 6.2831854820251465f, x); r = fmaf(-n, -1.7484555314695172e-7f, r);
    sn = __sinf(r); cs = __cosf(r);
}
#define LDS_WAIT() asm volatile("s_waitcnt lgkmcnt(0)" ::: "memory")

struct Params { const float* in[27]; float* out; unsigned char* ws; int ph_lo, ph_hi; };

__device__ __forceinline__ void tr_item(const float* src, int ldsrc, int scol0, int k0, bool valid, bf16_t* dst, int lddst, int drow0, LAS float* scr, int lane) {
    if (valid) {
#pragma unroll 8
        for (int i = 0; i < 32; ++i) { const int kk = 2 * i + (lane >> 5); scr[kk * 33 + (lane & 31)] = src[(size_t)(k0 + kk) * ldsrc + scol0 + (lane & 31)]; }
    } else {
#pragma unroll 8
        for (int i = 0; i < 32; ++i) { const int kk = 2 * i + (lane >> 5); scr[kk * 33 + (lane & 31)] = 0.f; }
    }
    LDS_WAIT();
    const int c = lane & 7;
#pragma unroll
    for (int j = 0; j < 4; ++j) { const int n = (lane >> 3) + 8 * j; const LAS float* s = scr + (8 * c) * 33 + n;
        u32x4 o; o.x = pk2(s[0 * 33], s[1 * 33]); o.y = pk2(s[2 * 33], s[3 * 33]); o.z = pk2(s[4 * 33], s[5 * 33]); o.w = pk2(s[6 * 33], s[7 * 33]);
        *(u32x4*)(dst + (size_t)(drow0 + n) * lddst + k0 + 8 * c) = o; }
    LDS_WAIT();
}

__device__ __forceinline__ void rms_rows2_bf16(const float* xa, const float* xb, const float* g, bf16_t* oa, bf16_t* ob, int lane) {
    const f32x4* ra = (const f32x4*)xa + lane; const f32x4* rb = (const f32x4*)xb + lane; const f32x4* gr = (const f32x4*)g + lane;
    f32x4 va[4], vb[4]; float sa = 0.f, sb = 0.f;
#pragma unroll
    for (int j = 0; j < 4; ++j) { va[j] = ra[64 * j]; vb[j] = rb[64 * j]; }
#pragma unroll
    for (int j = 0; j < 4; ++j) { sa += (va[j].x * va[j].x + va[j].y * va[j].y) + (va[j].z * va[j].z + va[j].w * va[j].w); sb += (vb[j].x * vb[j].x + vb[j].y * vb[j].y) + (vb[j].z * vb[j].z + vb[j].w * vb[j].w); }
    const float rsa = 1.0f / sqrtf(wave_sum(sa) * (1.0f / DM) + EPSN), rsb = 1.0f / sqrtf(wave_sum(sb) * (1.0f / DM) + EPSN);
    u32x2* pa = (u32x2*)oa + lane; u32x2* pb = (u32x2*)ob + lane;
#pragma unroll
    for (int j = 0; j < 4; ++j) { const f32x4 gv = gr[64 * j]; u32x2 w;
        w.x = pk2(va[j].x * rsa * gv.x, va[j].y * rsa * gv.y); w.y = pk2(va[j].z * rsa * gv.z, va[j].w * rsa * gv.w); pa[64 * j] = w;
        w.x = pk2(vb[j].x * rsb * gv.x, vb[j].y * rsb * gv.y); w.y = pk2(vb[j].z * rsb * gv.z, vb[j].w * rsb * gv.w); pb[64 * j] = w; }
}
__device__ __forceinline__ void rms_row_bf16(const float* xrow, const float* g, bf16_t* orow, int lane) {
    const f32x4* xr = (const f32x4*)xrow + lane; const f32x4* gr = (const f32x4*)g + lane;
    f32x4 v[4]; float s = 0.f;
#pragma unroll
    for (int j = 0; j < 4; ++j) { v[j] = xr[64 * j]; s += (v[j].x * v[j].x + v[j].y * v[j].y) + (v[j].z * v[j].z + v[j].w * v[j].w); }
    const float rstd = 1.0f / sqrtf(wave_sum(s) * (1.0f / DM) + EPSN);
    u32x2* o8 = (u32x2*)orow + lane;
#pragma unroll
    for (int j = 0; j < 4; ++j) { const f32x4 gv = gr[64 * j]; u32x2 w; w.x = pk2(v[j].x * rstd * gv.x, v[j].y * rstd * gv.y); w.y = pk2(v[j].z * rstd * gv.z, v[j].w * rstd * gv.w); o8[64 * j] = w; }
}

__device__ __forceinline__ void filter_block(const Params& p, LAS unsigned char* lds, int pb, int tid) {
    LAS float* z = (LAS float*)(lds + 131072); LAS float* h1 = z + 528; LAS float* h2 = h1 + 1024;
    const float *w1 = p.in[13], *b1 = p.in[14], *w2 = p.in[15], *b2 = p.in[16], *w3 = p.in[17], *fr = p.in[18];
    float* FILT = (float*)(p.ws + WS_FILT); float* NORM = (float*)(p.ws + WS_CTL);
    for (int idx = tid; idx < 528; idx += 512) { const int pp = idx / 33, e = idx - pp * 33; const float t = (float)(pb * 16 + pp);
        float v;
        if (e == 0) v = t / 4095.0f;
        else { const int j = (e - 1) & 15; const float band = 1e-4f + (float)j * ((15.0f - 1e-4f) / 15.0f); const float ang = (6.283185307179586f * t / 4096.0f) * band; float sn, cs; sincos_rr(ang, sn, cs); v = (e <= 16) ? cs : -sn; }
        z[idx] = v; }
    __syncthreads();
    for (int idx = tid; idx < 1024; idx += 512) { const int pp = idx >> 6, j = idx & 63; float a = b1[j];
#pragma unroll 3
        for (int e = 0; e < 33; ++e) a += z[pp * 33 + e] * w1[e * 64 + j];
        float sn, cs; sincos_rr(fr[j] * a, sn, cs); h1[idx] = sn; }
    __syncthreads();
    for (int idx = tid; idx < 1024; idx += 512) { const int pp = idx >> 6, j = idx & 63; float a = b2[j];
#pragma unroll 4
        for (int i = 0; i < 64; ++i) a += h1[pp * 64 + i] * w2[i * 64 + j];
        float sn, cs; sincos_rr(fr[j] * a, sn, cs); h2[idx] = sn; }
    __syncthreads();
    const float dmin = 3.0701134573253945f, dmax = 15.350567286626973f;
#pragma unroll 1
    for (int m = 0; m < 4; ++m) { const int q = tid + 512 * m;
        float acc[16];
#pragma unroll
        for (int pp = 0; pp < 16; ++pp) acc[pp] = 0.f;
#pragma unroll 2
        for (int i = 0; i < 64; ++i) { const float w = w3[i * 2048 + q];
#pragma unroll
            for (int pp = 0; pp < 16; ++pp) acc[pp] += h2[pp * 64 + i] * w; }
        const int o = q >> 10, dir = (q >> 9) & 1, c = q & 511; const float delta = dmin + (float)c * ((dmax - dmin) / 511.0f);
        float sabs = 0.f;
#pragma unroll
        for (int pp = 0; pp < 16; ++pp) { const int t = pb * 16 + pp; const float v = acc[pp] * __expf(-((float)t / 4095.0f) * delta); acc[pp] = v; if (!(dir == 1 && t == 0)) sabs += fabsf(v); }
        float* dst = FILT + ((size_t)((o * 2 + dir) * 512 + c)) * 4096 + pb * 16;
#pragma unroll
        for (int k = 0; k < 4; ++k) *(f32x4*)(dst + 4 * k) = (f32x4){acc[4 * k], acc[4 * k + 1], acc[4 * k + 2], acc[4 * k + 3]};
        atomicAdd(&NORM[o * 512 + c], sabs); }
    __syncthreads();
}

constexpr int KL_STRIDE = 208, VL_STRIDE = 144, KL_BYTES = 64 * KL_STRIDE, VL_BYTES = 64 * VL_STRIDE, ATT_BUF = KL_BYTES + VL_BYTES;
__device__ __forceinline__ bf16x8 pack8(const f32x16& x, int s) {
    u32x4 p; p.x = pk2(x[8 * s], x[8 * s + 1]); p.y = pk2(x[8 * s + 2], x[8 * s + 3]); p.z = pk2(x[8 * s + 4], x[8 * s + 5]); p.w = pk2(x[8 * s + 6], x[8 * s + 7]);
    return __builtin_bit_cast(bf16x8, p);
}
__device__ __forceinline__ void attn_unit(const Params& p, LAS unsigned char* lds, int unit, int tid, int lane, int wave) {
    const int bh = unit >> 4, qb = unit & 15, b = bh >> 3, h = bh & 7, r = lane & 31, hh = lane >> 5;
    const float* Q = (const float*)(p.ws + WS_Q); const bf16_t* KN = (const bf16_t*)(p.ws + WS_KN); const bf16_t* KPE = (const bf16_t*)(p.ws + WS_KPE); const bf16_t* VT = (const bf16_t*)(p.ws + WS_VT);
    bf16_t* MIXN = (bf16_t*)(p.ws + WS_MIXN);
    const size_t tok0 = (size_t)b * SEQ, qrow = tok0 + qb * 256 + wave * 32 + r;
    bf16x8 qf[6];
    { const float QS = 0.14724352f;
      const float* qp = Q + qrow * 768 + 96 * h + 8 * hh;
#pragma unroll
      for (int ks = 0; ks < 4; ++ks) { const f32x4 a = *(const f32x4*)(qp + 16 * ks), b = *(const f32x4*)(qp + 16 * ks + 4);
          u32x4 w; w.x = pk2(a.x * QS, a.y * QS); w.y = pk2(a.z * QS, a.w * QS); w.z = pk2(b.x * QS, b.y * QS); w.w = pk2(b.z * QS, b.w * QS); qf[ks] = __builtin_bit_cast(bf16x8, w); }
      const f32x2_t* tab = (const f32x2_t*)(p.ws + WS_ROPE) + (size_t)((int)(qrow & 4095)) * 16 + 8 * hh;
      float x1[8], x2[8];
      { const f32x4 a = *(const f32x4*)(qp + 64), b = *(const f32x4*)(qp + 68), c = *(const f32x4*)(qp + 80), d = *(const f32x4*)(qp + 84);
        x1[0] = a.x; x1[1] = a.y; x1[2] = a.z; x1[3] = a.w; x1[4] = b.x; x1[5] = b.y; x1[6] = b.z; x1[7] = b.w;
        x2[0] = c.x; x2[1] = c.y; x2[2] = c.z; x2[3] = c.w; x2[4] = d.x; x2[5] = d.y; x2[6] = d.z; x2[7] = d.w; }
      float y1[8], y2[8];
#pragma unroll
      for (int j = 0; j < 8; ++j) { const f32x2_t cs = tab[j]; y1[j] = (x1[j] * cs.x - x2[j] * cs.y) * QS; y2[j] = (x1[j] * cs.y + x2[j] * cs.x) * QS; }
      u32x4 w; w.x = pk2(y1[0], y1[1]); w.y = pk2(y1[2], y1[3]); w.z = pk2(y1[4], y1[5]); w.w = pk2(y1[6], y1[7]); qf[4] = __builtin_bit_cast(bf16x8, w);
      w.x = pk2(y2[0], y2[1]); w.y = pk2(y2[2], y2[3]); w.z = pk2(y2[4], y2[5]); w.w = pk2(y2[6], y2[7]); qf[5] = __builtin_bit_cast(bf16x8, w); }
    const int kc1 = tid + 512; const bool has1 = tid < 256;
    const int key0 = tid / 12, part0 = tid - key0 * 12, key1 = kc1 / 12, part1 = kc1 - key1 * 12;
    const bf16_t* ks0 = part0 < 8 ? KN + (tok0 + key0) * 512 + 64 * h + 8 * part0 : KPE + (tok0 + key0) * 32 + 8 * (part0 - 8);
    const bf16_t* ks1 = part1 < 8 ? KN + (tok0 + key1) * 512 + 64 * h + 8 * part1 : KPE + (tok0 + key1) * 32 + 8 * (part1 - 8);
    const int kst0 = part0 < 8 ? 64 * 512 : 64 * 32, kst1 = part1 < 8 ? 64 * 512 : 64 * 32;
    const bf16_t* vs = VT + (size_t)(64 * h + (tid >> 3)) * MTOK + tok0 + 8 * (tid & 7);
    const int kd0 = key0 * KL_STRIDE + part0 * 16, kd1 = key1 * KL_STRIDE + part1 * 16, vd = KL_BYTES + (tid >> 3) * VL_STRIDE + (tid & 7) * 16;
    u32x4 rk0, rk1 = (u32x4){0u, 0u, 0u, 0u}, rv;
    rk0 = *(const u32x4*)ks0; if (has1) rk1 = *(const u32x4*)ks1; rv = *(const u32x4*)vs;
    *(LAS u32x4*)(lds + kd0) = rk0; if (has1) *(LAS u32x4*)(lds + kd1) = rk1; *(LAS u32x4*)(lds + vd) = rv;
    __syncthreads();
    f32x16 o0, o1;
#pragma unroll
    for (int i = 0; i < 16; ++i) { o0[i] = 0.f; o1[i] = 0.f; }
    f32x2_t lsum2 = {0.f, 0.f};
    for (int kt = 0; kt < 64; ++kt) {
        const int buf = kt & 1; const bool more = kt + 1 < 64;
        if (more) { rk0 = *(const u32x4*)(ks0 + (size_t)(kt + 1) * kst0); if (has1) rk1 = *(const u32x4*)(ks1 + (size_t)(kt + 1) * kst1); rv = *(const u32x4*)(vs + (kt + 1) * 64); }
        const LAS unsigned char* KLb = lds + buf * ATT_BUF; const LAS unsigned char* VLb = KLb + KL_BYTES;
        f32x16 s0, s1;
        { const f32x16 zero16 = {0.f, 0.f, 0.f, 0.f, 0.f, 0.f, 0.f, 0.f, 0.f, 0.f, 0.f, 0.f, 0.f, 0.f, 0.f, 0.f};
          const bf16x8 ka = *(const LAS bf16x8*)(KLb + r * KL_STRIDE + 16 * hh);
          const bf16x8 kb = *(const LAS bf16x8*)(KLb + (32 + r) * KL_STRIDE + 16 * hh);
          s0 = mfma32(ka, qf[0], zero16); s1 = mfma32(kb, qf[0], zero16); }
#pragma unroll
        for (int ks = 1; ks < 6; ++ks) {
            const bf16x8 ka = *(const LAS bf16x8*)(KLb + r * KL_STRIDE + 32 * ks + 16 * hh);
            const bf16x8 kb = *(const LAS bf16x8*)(KLb + (32 + r) * KL_STRIDE + 32 * ks + 16 * hh);
            s0 = mfma32(ka, qf[ks], s0); s1 = mfma32(kb, qf[ks], s1); }
#pragma unroll
        for (int i = 0; i < 16; ++i) { s0[i] = __builtin_amdgcn_exp2f(s0[i]); s1[i] = __builtin_amdgcn_exp2f(s1[i]); }
#pragma unroll
        for (int i = 0; i < 16; i += 2) { lsum2 += (f32x2_t){s0[i], s0[i + 1]}; lsum2 += (f32x2_t){s1[i], s1[i + 1]}; }
        bf16x8 pf[2][2];
        pf[0][0] = pack8(s0, 0); pf[0][1] = pack8(s0, 1); pf[1][0] = pack8(s1, 0); pf[1][1] = pack8(s1, 1);
#pragma unroll
        for (int sub = 0; sub < 2; ++sub)
#pragma unroll
            for (int s = 0; s < 2; ++s) {
                const LAS unsigned char* vp = VLb + r * VL_STRIDE + (32 * sub + 16 * s + 4 * hh) * 2;
                const u32x2 lo0 = *(const LAS u32x2*)vp, hi0 = *(const LAS u32x2*)(vp + 16);
                const u32x2 lo1 = *(const LAS u32x2*)(vp + 32 * VL_STRIDE), hi1 = *(const LAS u32x2*)(vp + 32 * VL_STRIDE + 16);
                const bf16x8 va0 = __builtin_bit_cast(bf16x8, ((u32x4){lo0.x, lo0.y, hi0.x, hi0.y}));
                const bf16x8 va1 = __builtin_bit_cast(bf16x8, ((u32x4){lo1.x, lo1.y, hi1.x, hi1.y}));
                o0 = mfma32(va0, pf[sub][s], o0); o1 = mfma32(va1, pf[sub][s], o1); }
        if (more) { LAS unsigned char* nb = lds + (buf ^ 1) * ATT_BUF; *(LAS u32x4*)(nb + kd0) = rk0; if (has1) *(LAS u32x4*)(nb + kd1) = rk1; *(LAS u32x4*)(nb + vd) = rv; }
        __syncthreads();
    }
    const float lsum = lsum2.x + lsum2.y; const float l = lsum + __shfl_xor(lsum, 32); const float inv = 1.0f / l;
    float ss = 0.f;
#pragma unroll
    for (int i = 0; i < 16; ++i) { o0[i] *= inv; o1[i] *= inv; ss += o0[i] * o0[i] + o1[i] * o1[i]; }
    ss += __shfl_xor(ss, 32);
    const float rstd = 1.0f / sqrtf(ss * (1.0f / 64.0f) + EPSN);
    const float* hg = p.in[20] + 64 * h;
#pragma unroll
    for (int g = 0; g < 4; ++g) {
        const int dv0 = 8 * g + 4 * hh, dv1 = 32 + dv0;
        const f32x4 g0 = *(const f32x4*)(hg + dv0), g1 = *(const f32x4*)(hg + dv1);
        u32x2 w0, w1;
        w0.x = pk2(o0[4 * g] * rstd * g0.x, o0[4 * g + 1] * rstd * g0.y); w0.y = pk2(o0[4 * g + 2] * rstd * g0.z, o0[4 * g + 3] * rstd * g0.w);
        w1.x = pk2(o1[4 * g] * rstd * g1.x, o1[4 * g + 1] * rstd * g1.y); w1.y = pk2(o1[4 * g + 2] * rstd * g1.z, o1[4 * g + 3] * rstd * g1.w);
        *(u32x2*)(MIXN + qrow * 1024 + 64 * h + dv0) = w0; *(u32x2*)(MIXN + qrow * 1024 + 64 * h + dv1) = w1; }
}

constexpr int UT_STRIDE = 8192 + 16, UTL_BYTES = 8 * UT_STRIDE, RL_OFF = UTL_BYTES, RL1_OFF = 16384 + 64  , ZR_OFF = RL_OFF + 32768 + 128;
typedef short bf16x8_a4 __attribute__((ext_vector_type(8), aligned(4)));
__device__ __forceinline__ void hy_load_filter(const Params& p, LAS unsigned char* lds, int o, int c, int tid) {
    LAS bf16_t* RL = (LAS bf16_t*)(lds + RL_OFF);
    const float* FILT = (const float*)(p.ws + WS_FILT); const float* NORM = (const float*)(p.ws + WS_CTL);
    const float invn = 1.0f / NORM[o * 512 + c];
    const float* hf = FILT + (size_t)((o * 2 + 0) * 512 + c) * 4096; const float* hb = FILT + (size_t)((o * 2 + 1) * 512 + c) * 4096;
    float fv[16];
#pragma unroll
    for (int k = 0; k < 16; ++k) { const int i = tid + 512 * k; const int j = i - 4095; fv[k] = (k < 8) ? hf[4095 - i] : hb[j > 4095 ? 4095 : j]; }
#pragma unroll
    for (int k = 0; k < 16; ++k) { const int i = tid + 512 * k; const float v = (i < 8191) ? fv[k] * invn : 0.f;
        const bf16_t hv = (bf16_t)(pk2(v, 0.f) & 0xffffu); RL[i] = hv; if (i > 0) RL[RL1_OFF / 2 + i - 1] = hv; }
    if (tid == 0) RL[RL1_OFF / 2 + 8191] = 0;
}
#define HY_RD2(lo, hi, addr, o0, o1, o2, o3) asm volatile("ds_read2_b32 %0, %2 offset0:" #o0 " offset1:" #o1 "\n\tds_read2_b32 %1, %2 offset0:" #o2 " offset1:" #o3 : "=&v"(lo), "=&v"(hi) : "v"(addr))
#define HY_RDB(dst, addr, off) asm volatile("ds_read_b128 %0, %1 offset:" #off : "=&v"(dst) : "v"(addr))
__device__ __forceinline__ void hy_conv(LAS unsigned char* lds, f32x16 (&acc)[2][2], int lane, int wave) {
    const int r = lane & 31, hh = lane >> 5, bb = r & 7, t1o = r >> 3;
#pragma unroll
    for (int a = 0; a < 2; ++a)
#pragma unroll
        for (int b = 0; b < 2; ++b)
#pragma unroll
            for (int i = 0; i < 16; ++i) acc[a][b][i] = 0.f;
    const unsigned lbase = (unsigned)(size_t)lds;
    const int e00 = 4095 + 8 * hh - r;
    const unsigned a_cst = lbase + RL_OFF + ((e00 & 1) ? (RL1_OFF + 2 * (e00 - 1)) : 2 * e00) - 64;
    const unsigned b_cst = lbase + bb * UT_STRIDE + 16 * hh, z_addr = lbase + ZR_OFF;
    u32x2 wl[6], wh[6]; u32x4 Bq[2][4];
    { const unsigned a0 = a_cst - 128 * (8 * wave - 63);
      asm volatile("" ::: "memory");
      HY_RD2(wl[4], wh[4], a0, 32, 33, 34, 35); HY_RD2(wl[5], wh[5], a0, 40, 41, 42, 43); }
    for (int q = 0; q < 71; ++q) {
        const int d1 = 8 * wave - 63 + q;
        const unsigned aa = a_cst - 128 * d1;
        HY_RD2(wl[0], wh[0], aa, 0, 1, 2, 3); HY_RD2(wl[1], wh[1], aa, 8, 9, 10, 11); HY_RD2(wl[2], wh[2], aa, 16, 17, 18, 19); HY_RD2(wl[3], wh[3], aa, 24, 25, 26, 27);
#pragma unroll
        for (int nt = 0; nt < 2; ++nt) { const int s1 = 8 * wave + 4 * nt + t1o - d1; const unsigned ba = ((unsigned)s1 < 64u) ? b_cst + 128 * s1 : z_addr;
            HY_RDB(Bq[nt][0], ba, 0); HY_RDB(Bq[nt][1], ba, 32); HY_RDB(Bq[nt][2], ba, 64); HY_RDB(Bq[nt][3], ba, 96); }
        asm volatile("s_waitcnt lgkmcnt(0)" : "+v"(wl[0]), "+v"(wh[0]), "+v"(wl[1]), "+v"(wh[1]), "+v"(wl[2]), "+v"(wh[2]), "+v"(wl[3]), "+v"(wh[3]), "+v"(wl[4]), "+v"(wh[4]), "+v"(wl[5]), "+v"(wh[5]));
        asm volatile("" : "+v"(Bq[0][0]), "+v"(Bq[0][1]), "+v"(Bq[0][2]), "+v"(Bq[0][3]), "+v"(Bq[1][0]), "+v"(Bq[1][1]), "+v"(Bq[1][2]), "+v"(Bq[1][3]));
        bf16x8 W6[6];
#pragma unroll
        for (int k = 0; k < 6; ++k) W6[k] = __builtin_bit_cast(bf16x8, ((u32x4){wl[k].x, wl[k].y, wh[k].x, wh[k].y}));
#pragma unroll
        for (int ks = 0; ks < 4; ++ks)
#pragma unroll
            for (int mt = 0; mt < 2; ++mt)
#pragma unroll
                for (int nt = 0; nt < 2; ++nt) acc[mt][nt] = mfma32(W6[ks - 2 * mt + 2], __builtin_bit_cast(bf16x8, Bq[nt][ks]), acc[mt][nt]);
        wl[4] = wl[0]; wh[4] = wh[0]; wl[5] = wl[1]; wh[5] = wh[1];
    }
}
__device__ __forceinline__ void hy_stage_col(const Params& p, LAS unsigned char* lds, int gc, int tid) {
    const bf16_t* UTg = (const bf16_t*)(p.ws + WS_UT);
    const float* cw = p.in[11]; const float w0 = cw[gc], w1 = cw[1536 + gc], w2 = cw[3072 + gc], cbv = p.in[12][gc];
    u32x4 raw[8]; unsigned pv[8], nx[8];
#pragma unroll
    for (int i = 0; i < 8; ++i) { const int ch = tid + 512 * i, b = ch >> 9, s0 = (ch & 511) * 8;
        const bf16_t* src = UTg + (size_t)gc * MTOK + b * SEQ + s0;
        raw[i] = *(const u32x4*)src; pv[i] = src[s0 > 0 ? -1 : 0]; nx[i] = src[s0 + 8 < SEQ ? 8 : 7]; }
#pragma unroll
    for (int i = 0; i < 8; ++i) { const int ch = tid + 512 * i, b = ch >> 9, s0 = (ch & 511) * 8;
        float f[10];
        f[0] = s0 > 0 ? __uint_as_float(pv[i] << 16) : 0.f; f[9] = s0 + 8 < SEQ ? __uint_as_float(nx[i] << 16) : 0.f;
        f[1] = __uint_as_float(raw[i].x << 16); f[2] = __uint_as_float(raw[i].x & 0xffff0000u); f[3] = __uint_as_float(raw[i].y << 16); f[4] = __uint_as_float(raw[i].y & 0xffff0000u);
        f[5] = __uint_as_float(raw[i].z << 16); f[6] = __uint_as_float(raw[i].z & 0xffff0000u); f[7] = __uint_as_float(raw[i].w << 16); f[8] = __uint_as_float(raw[i].w & 0xffff0000u);
        float v[8];
#pragma unroll
        for (int j = 0; j < 8; ++j) v[j] = cbv + w0 * f[j] + w1 * f[j + 1] + w2 * f[j + 2];
        u32x4 w; w.x = pk2(v[0], v[1]); w.y = pk2(v[2], v[3]); w.z = pk2(v[4], v[5]); w.w = pk2(v[6], v[7]);
        *(LAS u32x4*)(lds + b * UT_STRIDE + s0 * 2) = w; }
}
template <int MODE>
__device__ __forceinline__ void hy_own(LAS unsigned char* lds, f32x16 (&acc)[2][2], float dsk, int lane, int wave) {
    const int r = lane & 31, hh = lane >> 5, bb = r & 7, t1o = r >> 3;
#pragma unroll
    for (int mt = 0; mt < 2; ++mt)
#pragma unroll
        for (int nt = 0; nt < 2; ++nt)
#pragma unroll
            for (int g = 0; g < 4; ++g) {
                const int t = 64 * (8 * wave + 4 * nt + t1o) + 32 * mt + 8 * g + 4 * hh;
                LAS unsigned char* up = lds + bb * UT_STRIDE + t * 2;
                const u32x2 ur = *(const LAS u32x2*)up;
                float uv[4]; uv[0] = __uint_as_float(ur.x << 16); uv[1] = __uint_as_float(ur.x & 0xffff0000u); uv[2] = __uint_as_float(ur.y << 16); uv[3] = __uint_as_float(ur.y & 0xffff0000u);
                if (MODE == 0) {
#pragma unroll
                    for (int j = 0; j < 4; ++j) acc[mt][nt][4 * g + j] += uv[j] * dsk;
                } else { u32x2 w; w.x = pk2(acc[mt][nt][4 * g] * uv[0], acc[mt][nt][4 * g + 1] * uv[1]); w.y = pk2(acc[mt][nt][4 * g + 2] * uv[2], acc[mt][nt][4 * g + 3] * uv[3]); *(LAS u32x2*)up = w; }
            }
}
__device__ __forceinline__ void hy_copy_out(const Params& p, LAS unsigned char* lds, int c, int tid) {
    bf16_t* HYT = (bf16_t*)(p.ws + WS_HYT);
#pragma unroll
    for (int i = 0; i < 8; ++i) { const int ch = tid + 512 * i, b = ch >> 9, s0 = (ch & 511) * 8;
        *(u32x4*)(HYT + (size_t)c * MTOK + b * SEQ + s0) = *(const LAS u32x4*)(lds + b * UT_STRIDE + s0 * 2); }
}
__device__ __forceinline__ void hyena_channel(const Params& p, LAS unsigned char* lds, int c, int tid, int lane, int wave) {
    const float d0 = p.in[19][c], d1 = p.in[19][512 + c];
    hy_stage_col(p, lds, c, tid);
    if (tid < 32) *(LAS unsigned*)(lds + ZR_OFF + 4 * tid) = 0u;
    hy_load_filter(p, lds, 0, c, tid);
    __syncthreads();
    f32x16 acc[2][2];
    hy_conv(lds, acc, lane, wave);
    __syncthreads();
    hy_own<0>(lds, acc, d0, lane, wave);
    __syncthreads();
    hy_stage_col(p, lds, 512 + c, tid);
    hy_load_filter(p, lds, 1, c, tid);
    __syncthreads();
    hy_own<1>(lds, acc, 0.f, lane, wave);
    __syncthreads();
    hy_conv(lds, acc, lane, wave);
    __syncthreads();
    hy_own<0>(lds, acc, d1, lane, wave);
    __syncthreads();
    hy_stage_col(p, lds, 1024 + c, tid);
    __syncthreads();
    hy_own<1>(lds, acc, 0.f, lane, wave);
    __syncthreads();
    hy_copy_out(p, lds, c, tid);
    __syncthreads();
}

#define XB_TMO      128
#define XB_XCNT(j)  (256  + 64 * (j))
#define XB_XSUB(j)  (1280 + 64 * (j))
#define XB_XGEN(j)  (2304 + 64 * (j))
#define XB_TOP      3328
#define XB_TOPGEN   3392
#define XCD_BAR_WORDS 3456
#define XB_SPIN_CAP (1u << 18)

__device__ __forceinline__ unsigned xb_ld(unsigned* p)              { return __hip_atomic_load(p, __ATOMIC_RELAXED, __HIP_MEMORY_SCOPE_AGENT); }
__device__ __forceinline__ unsigned xb_add(unsigned* p, unsigned v) { return __hip_atomic_fetch_add(p, v, __ATOMIC_RELAXED, __HIP_MEMORY_SCOPE_AGENT); }
__device__ __forceinline__ unsigned xb_xcc_id() { return (unsigned)__builtin_amdgcn_s_getreg((3 << 11) | 20) & 0xFu; }
#define XB_SPIN(cond, bar) do { unsigned _sp = 0; while (cond) { __builtin_amdgcn_s_sleep(1); \
    if ((++_sp & 255u) == 0u) { if (xb_ld(&(bar)[XB_TMO])) break; if (_sp > XB_SPIN_CAP) { atomicAdd(&(bar)[XB_TMO], 1u); break; } } } } while (0)

struct XcdBarrier {
    unsigned* bar; unsigned x;
    volatile LAS unsigned* st;
};

__device__ __forceinline__ XcdBarrier xcd_barrier_post(unsigned* bar, volatile LAS unsigned* st) {
    XcdBarrier b; b.bar = bar; b.x = xb_xcc_id(); b.st = st;
    if (threadIdx.x == 0) (void)xb_add(&bar[XB_XCNT(b.x)], 1u);
    return b;
}
__device__ __forceinline__ void xcd_barrier_complete(unsigned* bar, unsigned x, unsigned& nloc, unsigned& nx) {
    const unsigned G = gridDim.x * gridDim.y * gridDim.z;
    unsigned sum, cnt, mine, sp = 0u;
    for (;;) {
        sum = 0u; cnt = 0u; mine = 0u;
#pragma unroll
        for (unsigned j = 0; j < 16; ++j) { const unsigned c = xb_ld(&bar[XB_XCNT(j)]); sum += c; cnt += (c > 0u) ? 1u : 0u; mine = (j == x) ? c : mine; }
        if (sum == G) break;
        __builtin_amdgcn_s_sleep(1);
        if ((++sp & 255u) == 0u) { if (xb_ld(&bar[XB_TMO])) break; if (sp > XB_SPIN_CAP) { atomicAdd(&bar[XB_TMO], 1u); break; } }
    }
    nloc = mine > 0u ? mine : 1u; nx = cnt > 0u ? cnt : 1u;
}

__device__ __forceinline__ void xcd_barrier(const XcdBarrier& b) {
    asm volatile("s_waitcnt vmcnt(0)" ::: "memory");
    __syncthreads();
    if (threadIdx.x == 0) {
        unsigned* bar = b.bar;
        __builtin_amdgcn_s_waitcnt(0);
        unsigned nloc = b.st[0], nx = b.st[1];
        if (nloc == 0u) { xcd_barrier_complete(bar, b.x, nloc, nx); b.st[0] = nloc; b.st[1] = nx; }
        const unsigned old = xb_add(&bar[XB_XSUB(b.x)], 1u);
        const unsigned gen = old / nloc;
        if (old + 1u == (gen + 1u) * nloc) {
            __builtin_amdgcn_fence(__ATOMIC_RELEASE, "agent");
            asm volatile("s_waitcnt vmcnt(0)" ::: "memory");
            const unsigned og = xb_add(&bar[XB_TOP], 1u);
            const unsigned tg = og / nx;
            if (og + 1u == (tg + 1u) * nx) xb_add(&bar[XB_TOPGEN], 1u);
            else XB_SPIN(xb_ld(&bar[XB_TOPGEN]) == tg, bar);
            __builtin_amdgcn_fence(__ATOMIC_ACQUIRE, "agent");
            xb_add(&bar[XB_XGEN(b.x)], 1u);
            asm volatile("s_waitcnt vmcnt(0)" ::: "memory");
        } else {
            XB_SPIN(xb_ld(&bar[XB_XGEN(b.x)]) == gen, bar);
            __builtin_amdgcn_fence(__ATOMIC_ACQUIRE, "agent");
            asm volatile("s_waitcnt vmcnt(0)" ::: "memory");
        }
    }
    __syncthreads();
}

__global__ void __launch_bounds__(512) fwd_megakernel(Params p) {
    extern __shared__ __attribute__((aligned(16))) unsigned char lds_raw[];
    LAS unsigned char* lds = (LAS unsigned char*)lds_raw;
    cg::grid_group grid = cg::this_grid();
    const int tid = threadIdx.x, lane = tid & 63, wave = __builtin_amdgcn_readfirstlane(tid >> 6);
    const int G = gridDim.x, bx = blockIdx.x;
    const int vcu = (G % 8 == 0) ? (bx % 8) * (G / 8) + bx / 8 : bx;
    const int gw = vcu * 8 + wave, NGW = G * 8;
    unsigned char* ws = p.ws;
    const int lo = p.ph_lo, hi = p.ph_hi;
    const bool fuse5 = (G == 256) && (lo <= 4 && 5 < hi);
    volatile LAS unsigned* bst = (volatile LAS unsigned*)(lds + LDS_BYTES - 64);
    if (tid < 2) bst[tid] = 0u;
    __syncthreads();
    const XcdBarrier xbar = xcd_barrier_post((unsigned*)(ws + WS_BAR), bst);
#ifndef P0SEL
#define P0SEL 15
#endif
#ifndef REPMASK
#define REPMASK 0
#endif
#define NREP(k) ((((REPMASK) >> (k)) & 1) ? 2 : 1)
#ifndef P6SEL
#define P6SEL 7
#endif
#ifndef PHMASK
#define PHMASK 0xffff
#endif
#define IN(k) (((PHMASK >> (k)) & 1) && lo <= (k) && (k) < hi)
#define SEAM(k) do { if (IN(k) && IN((k) + 1)) { if ((k) == 0) grid.sync(); else xcd_barrier(xbar); if ((REPMASK >> 15) & 1) xcd_barrier(xbar); } } while (0)
    bf16_t* XN = (bf16_t*)(ws + WS_XN); bf16_t* HB = (bf16_t*)(ws + WS_H);

    if (IN(0)) {
        LAS float* scr = (LAS float*)(lds + wave * 16384);
        constexpr int I_GU = 16 * 176, I_D = 44 * 32, I_INA = 16 * 16, I_INB = 16 * 48, I_UQ = 4 * 24, I_UK = 4 * 16, I_OUT = 16 * 32;
        constexpr int NITEMS = 2 * (I_GU + I_D) + I_INA + I_INB + I_UQ + 2 * I_UK + I_OUT;
        for (int rep = 0; rep < NREP(0); ++rep) if (P0SEL & 1) for (int it = gw; it < NITEMS; it += NGW) {
            int r = it;
            bool done = false;
#pragma unroll
            for (int f = 0; f < 2; ++f) {
                if (done) break;
                const float* wg = p.in[f ? 23 : 2]; const float* wu = p.in[f ? 24 : 3]; const float* wd = p.in[f ? 25 : 4];
                bf16_t* GU = (bf16_t*)(ws + (f ? WS_W2GU : WS_W1GU)); bf16_t* DD = (bf16_t*)(ws + (f ? WS_W2D : WS_W1D));
                if (r < I_GU) { const int kb = r / 176, nb = r - kb * 176, pn = nb >> 3, rb = nb & 7;
                    tr_item(rb < 4 ? wg : wu, FFH, 128 * pn + 32 * (rb & 3), 64 * kb, true, GU, DM, 32 * nb, scr, lane); done = true; break; }
                r -= I_GU;
                if (r < I_D) { const int kb = r / 32, nb = r - kb * 32; tr_item(wd, DM, 32 * nb, 64 * kb, true, DD, FFH, 32 * nb, scr, lane); done = true; break; }
                r -= I_D;
            }
            if (done) continue;
            if (r < I_INA) { const int kb = r / 16, nb = r - kb * 16; tr_item(p.in[6], 1952, 32 * nb, 64 * kb, nb < 13, (bf16_t*)(ws + WS_WINA), DM, 32 * nb, scr, lane); continue; } r -= I_INA;
            if (r < I_INB) { const int kb = r / 48, nb = r - kb * 48; tr_item(p.in[6], 1952, 416 + 32 * nb, 64 * kb, true, (bf16_t*)(ws + WS_WINB), DM, 32 * nb, scr, lane); continue; } r -= I_INB;
            if (r < I_UQ) { const int kb = r / 24, nb = r - kb * 24; tr_item(p.in[8], 768, 32 * nb, 64 * kb, true, (bf16_t*)(ws + WS_WUQ), 256, 32 * nb, scr, lane); continue; } r -= I_UQ;
            if (r < I_UK) { const int kb = r / 16, nb = r - kb * 16; tr_item(p.in[10], 1024, 128 * (nb >> 1) + 32 * (nb & 1), 64 * kb, kb < 2, (bf16_t*)(ws + WS_WUK), 256, 32 * nb, scr, lane); continue; } r -= I_UK;
            if (r < I_UK) { const int kb = r / 16, nb = r - kb * 16; tr_item(p.in[10], 1024, 128 * (nb >> 1) + 64 + 32 * (nb & 1), 64 * kb, kb < 2, (bf16_t*)(ws + WS_WUV), 256, 32 * nb, scr, lane); continue; } r -= I_UK;
            { const int kb = r / 32, nb = r - kb * 32; tr_item(p.in[21], DM, 32 * nb, 64 * kb, true, (bf16_t*)(ws + WS_WOUT), DM, 32 * nb, scr, lane); }
        }
        if (P0SEL & 2) { f32x2_t* tab = (f32x2_t*)(ws + WS_ROPE);
          for (int idx = gw * 64 + lane; idx < SEQ * 16; idx += NGW * 64) { const int s = idx >> 4, i = idx & 15;
              const float inv = exp2f(-(float)i * 0.8304820237218406f); const float ang = (float)s * inv; float sn, cs; sincos_rr(ang, sn, cs); tab[idx] = (f32x2_t){cs, sn}; } }
        __syncthreads();
        if (P0SEL & 4) for (int pb = bx; pb < 256; pb += G) filter_block(p, lds, pb, tid);
        for (int rep = 0; rep < NREP(13); ++rep) if (P0SEL & 8) for (int m = gw; m + NGW < MTOK; m += 2 * NGW) rms_rows2_bf16(p.in[0] + (size_t)m * DM, p.in[0] + (size_t)(m + NGW) * DM, p.in[1], XN + (size_t)m * DM, XN + (size_t)(m + NGW) * DM, lane);
    }
    SEAM(0);
    if (IN(1)) for (int rep = 0; rep < NREP(1); ++rep) { __syncthreads(); pg8::Gemm g{XN, (const bf16_t*)(ws + WS_W1GU), MTOK, 2 * FFH, DM}; pg8::StaticOrder S; S.init(MTOK, 2 * FFH, G, bx);
        pg8::EpiSwiGLU E{HB, FFH}; pg8::gemm_phase<pg8::EpiSwiGLU, pg8::StaticOrder>(lds, g, S, E); }
    SEAM(1);
    if (IN(2)) for (int rep = 0; rep < NREP(2); ++rep) { __syncthreads(); pg8::Gemm g{HB, (const bf16_t*)(ws + WS_W1D), MTOK, DM, FFH, 1}; pg8::StaticOrder S; S.init(MTOK, DM, G, bx);
        pg8::EpiResid E{p.in[0], p.out, DM, 0.5f}; pg8::gemm_phase<pg8::EpiResid, pg8::StaticOrder>(lds, g, S, E); }
    SEAM(2);
    if (IN(3)) for (int rep = 0; rep < NREP(3); ++rep) { for (int m = gw; m + NGW < MTOK; m += 2 * NGW) rms_rows2_bf16(p.out + (size_t)m * DM, p.out + (size_t)(m + NGW) * DM, p.in[5], XN + (size_t)m * DM, XN + (size_t)(m + NGW) * DM, lane); }
    SEAM(3);
    if (IN(4)) for (int rep = 0; rep < NREP(4); ++rep) { __syncthreads();
        if (fuse5) { pg8::Gemm g{XN, (const bf16_t*)(ws + WS_WINA), MTOK, 512, DM}; pg8::StaticOrder S; S.init(MTOK, 512, G, bx);
          pg8::EpiUA E{(bf16_t*)(ws + WS_CQN), (bf16_t*)(ws + WS_CKVN), (bf16_t*)(ws + WS_KPE), p.in[7], p.in[9], (const f32x2_t*)(ws + WS_ROPE)};
          pg8::gemm_phase<pg8::EpiUA, pg8::StaticOrder>(lds, g, S, E); }
        else { pg8::Gemm g{XN, (const bf16_t*)(ws + WS_WINA), MTOK, 512, DM}; pg8::StaticOrder S; S.init(MTOK, 512, G, bx);
          pg8::EpiF32 E{(float*)(ws + WS_UA), 512}; pg8::gemm_phase<pg8::EpiF32, pg8::StaticOrder>(lds, g, S, E); }
        { pg8::Gemm g{(const bf16_t*)(ws + WS_WINB), XN, 1536, MTOK, DM}; pg8::StaticOrder S; S.init(1536, MTOK, G, bx);
          pg8::EpiBf16P E{(bf16_t*)(ws + WS_UT), (size_t)MTOK}; pg8::gemm_phase<pg8::EpiBf16P, pg8::StaticOrder>(lds, g, S, E); } }
    SEAM(4);
    if (IN(5) && !fuse5) for (int rep = 0; rep < NREP(5); ++rep) {
        const float* UA = (const float*)(ws + WS_UA); bf16_t* CQN = (bf16_t*)(ws + WS_CQN); bf16_t* CKVN = (bf16_t*)(ws + WS_CKVN); bf16_t* KPE = (bf16_t*)(ws + WS_KPE);
        const f32x2_t* tab = (const f32x2_t*)(ws + WS_ROPE);
        const f32x4 gq = ((const f32x4*)p.in[7])[lane]; const f32x4 gk = lane < 32 ? ((const f32x4*)p.in[9])[lane] : (f32x4){0.f, 0.f, 0.f, 0.f};
        for (int row = gw; row < MTOK; row += NGW) {
            const f32x4* ur = (const f32x4*)(UA + (size_t)row * 512);
            const f32x4 a = ur[lane], bq = ur[64 + lane];
            const float rq = 1.0f / sqrtf(wave_sum((a.x * a.x + a.y * a.y) + (a.z * a.z + a.w * a.w)) * (1.0f / 256.0f) + EPSN);
            u32x2 w; w.x = pk2(a.x * rq * gq.x, a.y * rq * gq.y); w.y = pk2(a.z * rq * gq.z, a.w * rq * gq.w);
            *((u32x2*)(CQN + (size_t)row * 256) + lane) = w;
            const float skv = lane < 32 ? (bq.x * bq.x + bq.y * bq.y) + (bq.z * bq.z + bq.w * bq.w) : 0.f;
            const float rkv = 1.0f / sqrtf(wave_sum(skv) * (1.0f / 128.0f) + EPSN);
            u32x2 wk = (u32x2){0u, 0u};
            if (lane < 32) { wk.x = pk2(bq.x * rkv * gk.x, bq.y * rkv * gk.y); wk.y = pk2(bq.z * rkv * gk.z, bq.w * rkv * gk.w); }
            *((u32x2*)(CKVN + (size_t)row * 256) + lane) = wk;
            f32x4 pr; pr.x = __shfl_xor(bq.x, 4); pr.y = __shfl_xor(bq.y, 4); pr.z = __shfl_xor(bq.z, 4); pr.w = __shfl_xor(bq.w, 4);
            if (lane >= 32 && lane < 40) { const int pos = row & 4095; const bool first = lane < 36; const int i0 = 4 * ((lane - 32) & 3);
                float ov[4];
#pragma unroll
                for (int e = 0; e < 4; ++e) { const f32x2_t cs = tab[pos * 16 + i0 + e]; const float x1 = first ? bq[e] : pr[e], x2 = first ? pr[e] : bq[e]; ov[e] = first ? x1 * cs.x - x2 * cs.y : x1 * cs.y + x2 * cs.x; }
                u32x2 wo; wo.x = pk2(ov[0], ov[1]); wo.y = pk2(ov[2], ov[3]);
                *(u32x2*)(KPE + (size_t)row * 32 + 4 * (lane - 32)) = wo; }
        }
    }
    if (!fuse5) SEAM(5);
    if (IN(6)) for (int rep = 0; rep < NREP(6); ++rep) { __syncthreads();
        if (P6SEL & 1) { pg8::Gemm g{(const bf16_t*)(ws + WS_CQN), (const bf16_t*)(ws + WS_WUQ), MTOK, 768, 256}; pg8::StaticOrder S; S.init(MTOK, 768, G, bx);
          pg8::EpiF32 E{(float*)(ws + WS_Q), 768}; pg8::gemm_phase<pg8::EpiF32, pg8::StaticOrder>(lds, g, S, E); }
        if (P6SEL & 2) { pg8::Gemm g{(const bf16_t*)(ws + WS_CKVN), (const bf16_t*)(ws + WS_WUK), MTOK, 512, 256}; pg8::StaticOrder S; S.init(MTOK, 512, G, bx);
          pg8::EpiBf16P E{(bf16_t*)(ws + WS_KN), (size_t)512}; pg8::gemm_phase<pg8::EpiBf16P, pg8::StaticOrder>(lds, g, S, E); }
        if (P6SEL & 4) { pg8::Gemm g{(const bf16_t*)(ws + WS_WUV), (const bf16_t*)(ws + WS_CKVN), 512, MTOK, 256}; pg8::StaticOrder S; S.init(512, MTOK, G, bx);
          pg8::EpiBf16P E{(bf16_t*)(ws + WS_VT), (size_t)MTOK}; pg8::gemm_phase<pg8::EpiBf16P, pg8::StaticOrder>(lds, g, S, E); } }
    SEAM(6);
    if (IN(7)) { __syncthreads();
        for (int rep = 0; rep < NREP(7); ++rep) for (int u = vcu; u < 1024; u += G) attn_unit(p, lds, u, tid, lane, wave);
        __syncthreads();
        for (int rep = 0; rep < NREP(14); ++rep) for (int c = bx; c < 512; c += G) hyena_channel(p, lds, c, tid, lane, wave);
    }
    SEAM(7);
    if (IN(8)) for (int rep = 0; rep < NREP(8); ++rep) {
        const bf16_t* HYT = (const bf16_t*)(ws + WS_HYT); bf16_t* MIXN = (bf16_t*)(ws + WS_MIXN); const float* hg = p.in[20] + 512;
        for (int it = gw; it < 8 * (MTOK / 64); it += NGW) { const int grp = it & 7, row = (it >> 3) * 64 + lane;
            float v[64]; float ss = 0.f;
#pragma unroll
            for (int cc = 0; cc < 64; ++cc) { v[cc] = bf2f(HYT[(size_t)(64 * grp + cc) * MTOK + row]); ss += v[cc] * v[cc]; }
            const float rstd = 1.0f / sqrtf(ss * (1.0f / 64.0f) + EPSN);
            bf16_t* dst = MIXN + (size_t)row * 1024 + 512 + 64 * grp;
#pragma unroll
            for (int k = 0; k < 8; ++k) { const float* gp = hg + 64 * grp + 8 * k;
                u32x4 w; w.x = pk2(v[8 * k] * rstd * gp[0], v[8 * k + 1] * rstd * gp[1]); w.y = pk2(v[8 * k + 2] * rstd * gp[2], v[8 * k + 3] * rstd * gp[3]);
                w.z = pk2(v[8 * k + 4] * rstd * gp[4], v[8 * k + 5] * rstd * gp[5]); w.w = pk2(v[8 * k + 6] * rstd * gp[6], v[8 * k + 7] * rstd * gp[7]);
                *(u32x4*)(dst + 8 * k) = w; } }
    }
    SEAM(8);
    if (IN(9)) { __syncthreads(); pg8::Gemm g{(const bf16_t*)(ws + WS_MIXN), (const bf16_t*)(ws + WS_WOUT), MTOK, DM, DM}; pg8::StaticOrder S; S.init(MTOK, DM, G, bx);
        pg8::EpiResid E{p.out, p.out, DM, 1.0f}; pg8::gemm_phase<pg8::EpiResid, pg8::StaticOrder>(lds, g, S, E); }
    SEAM(9);
    if (IN(10)) for (int rep = 0; rep < NREP(10); ++rep) { for (int m = gw; m + NGW < MTOK; m += 2 * NGW) rms_rows2_bf16(p.out + (size_t)m * DM, p.out + (size_t)(m + NGW) * DM, p.in[22], XN + (size_t)m * DM, XN + (size_t)(m + NGW) * DM, lane); }
    SEAM(10);
    if (IN(11)) for (int rep = 0; rep < NREP(11); ++rep) { __syncthreads(); pg8::Gemm g{XN, (const bf16_t*)(ws + WS_W2GU), MTOK, 2 * FFH, DM}; pg8::StaticOrder S; S.init(MTOK, 2 * FFH, G, bx);
        pg8::EpiSwiGLU E{HB, FFH}; pg8::gemm_phase<pg8::EpiSwiGLU, pg8::StaticOrder>(lds, g, S, E); }
    SEAM(11);
    if (IN(12)) { __syncthreads(); pg8::Gemm g{HB, (const bf16_t*)(ws + WS_W2D), MTOK, DM, FFH, 1}; pg8::StaticOrder S; S.init(MTOK, DM, G, bx);
        pg8::EpiResid E{p.out, p.out, DM, 0.5f}; pg8::gemm_phase<pg8::EpiResid, pg8::StaticOrder>(lds, g, S, E); }
    SEAM(12);
    if (IN(13)) {
        const f32x4* gr = (const f32x4*)p.in[26] + lane;
        for (int m = gw; m + NGW < MTOK; m += 2 * NGW) { f32x4* xr = (f32x4*)(p.out + (size_t)m * DM) + lane; f32x4* yr = (f32x4*)(p.out + (size_t)(m + NGW) * DM) + lane; f32x4 v[4], w[4]; float s = 0.f, t = 0.f;
#pragma unroll
            for (int j = 0; j < 4; ++j) { v[j] = xr[64 * j]; w[j] = yr[64 * j]; }
#pragma unroll
            for (int j = 0; j < 4; ++j) { s += (v[j].x * v[j].x + v[j].y * v[j].y) + (v[j].z * v[j].z + v[j].w * v[j].w); t += (w[j].x * w[j].x + w[j].y * w[j].y) + (w[j].z * w[j].z + w[j].w * w[j].w); }
            const float rs = 1.0f / sqrtf(wave_sum(s) * (1.0f / DM) + EPSN), rt = 1.0f / sqrtf(wave_sum(t) * (1.0f / DM) + EPSN);
#pragma unroll
            for (int j = 0; j < 4; ++j) { const f32x4 gv = gr[64 * j]; xr[64 * j] = v[j] * rs * gv; yr[64 * j] = w[j] * rt * gv; } }
    }
#undef IN
#undef SEAM
}

#ifndef ONE_LAUNCH
#define ONE_LAUNCH 1
#endif
extern "C" void kernel_launch(void* const* d_in, const int* in_sizes, int n_in, void* d_out, int out_size, void* d_ws, size_t ws_size, hipStream_t stream) {
    static int grid = 0;
    if (grid == 0) {
        if (n_in != 27 || ws_size < WS_END) { fprintf(stderr, "kernel_launch: unexpected n_in %d or ws_size %zu\n", n_in, ws_size); grid = -1; return; }
        int dev = 0, cus = 0, per_cu = 0;
        (void)hipGetDevice(&dev); (void)hipDeviceGetAttribute(&cus, hipDeviceAttributeMultiprocessorCount, dev);
        if (hipFuncSetAttribute((const void*)fwd_megakernel, hipFuncAttributeMaxDynamicSharedMemorySize, LDS_BYTES) != hipSuccess) { fprintf(stderr, "kernel_launch: hipFuncSetAttribute failed\n"); grid = -1; return; }
        if (hipOccupancyMaxActiveBlocksPerMultiprocessor(&per_cu, (const void*)fwd_megakernel, 512, LDS_BYTES) != hipSuccess || per_cu < 1) { fprintf(stderr, "kernel_launch: occupancy query says %d\n", per_cu); (void)hipGetLastError(); grid = -1; return; }
        grid = cus;
    }
    if (grid < 0) return;
    (void)hipMemsetAsync((char*)d_ws + WS_CTL, 0, CTL_ZERO, stream);
    Params p{};
    for (int i = 0; i < 27; ++i) p.in[i] = (const float*)d_in[i];
    p.out = (float*)d_out; p.ws = (unsigned char*)d_ws;
#if ONE_LAUNCH
    p.ph_lo = 0; p.ph_hi = NPHASE;
    void* args[] = {&p};
    hipError_t e = hipLaunchCooperativeKernel((const void*)fwd_megakernel, dim3(grid), dim3(512), args, LDS_BYTES, stream);
    if (e != hipSuccess) fprintf(stderr, "cooperative launch failed: %s (grid %d)\n", hipGetErrorString(e), grid);
#else
    for (int k = 0; k < NPHASE; ++k) { p.ph_lo = k; p.ph_hi = k + 1; hipLaunchKernelGGL(fwd_megakernel, dim3(grid), dim3(512), LDS_BYTES, stream, p); }
#endif
}
```
